# Optimizing an MI355X kernel written in HIP

```python
import math
import jax
import jax.numpy as jnp
from jax import lax
import numpy as np

D_MODEL = 1024
BATCH = 1
SEQ = 16384
DEPTH = 2

GRID_W = 64
CTX_LEN = 256
EPS = 1e-6
POOL_GROUPS = 4
POOL_WINDOWS = (2, 4, 8, 16)
POOL_WIDTH = D_MODEL // 4
POOL_GROUP_DIM = POOL_WIDTH // POOL_GROUPS
HEAD_DIM = 128
N_Q_HEADS = (D_MODEL - POOL_WIDTH) // HEAD_DIM
N_KV_HEADS = 2
ATT_WIDTH = N_Q_HEADS * HEAD_DIM
KV_WIDTH = N_KV_HEADS * HEAD_DIM
Q_BLOCK = 128
ROPE_THETA = 10000.0
ROPE_FREQS = HEAD_DIM // 4
EVEN_SPLITS = (POOL_WIDTH, 2 * POOL_WIDTH, 2 * POOL_WIDTH + ATT_WIDTH,
               2 * POOL_WIDTH + ATT_WIDTH + KV_WIDTH, 2 * POOL_WIDTH + ATT_WIDTH + 2 * KV_WIDTH)
EVEN_IN = 2 * POOL_WIDTH + 2 * ATT_WIDTH + 2 * KV_WIDTH
EVEN_MIX = POOL_WIDTH + ATT_WIDTH
HY_ORDER = 2
HY_WIDTH = 3 * D_MODEL // 4
HY_EMB = 33
HY_BANDS = (HY_EMB - 1) // 2
HY_HIDDEN = 64
HY_DECAY_TARGET = 1e-2
HY_FAST_DECAY = 0.3
HY_SLOW_DECAY = 1.5
FN_WIDTH = D_MODEL - HY_WIDTH
ODD_SPLITS = ((HY_ORDER + 1) * HY_WIDTH, (HY_ORDER + 2) * HY_WIDTH,
              (HY_ORDER + 2) * HY_WIDTH + FN_WIDTH)
ODD_IN = (HY_ORDER + 2) * HY_WIDTH + 2 * FN_WIDTH
ODD_MIX = HY_WIDTH + FN_WIDTH
N_EVEN = (DEPTH + 1) // 2
N_ODD = DEPTH // 2

kernel_name = "hybrid_pool_attn_hyena_fourier_dit"


def rmsnorm(x, g):
    xf = x.astype(jnp.float32)
    y = xf * lax.rsqrt(jnp.mean(xf * xf, axis=-1, keepdims=True) + EPS)
    return y.astype(x.dtype) * g


def modulation(cond, w_mod, b_mod):
    m = jax.nn.silu(cond) @ w_mod + b_mod
    return jnp.split(m, 3, axis=-1)


def to_heads(t, n_heads):
    return t.reshape(t.shape[:2] + (n_heads, HEAD_DIM))


def axial_rope_tables(row_idx, col_idx):
    inv_freq = ROPE_THETA ** (-jnp.arange(ROPE_FREQS, dtype=jnp.float32) / ROPE_FREQS)
    ang = jnp.stack([row_idx[:, None] * inv_freq, col_idx[:, None] * inv_freq], axis=1)
    ang = ang[:, None, :, None, :]
    return jnp.cos(ang), jnp.sin(ang)


def apply_rope(x, cos, sin):
    xr = x.reshape(x.shape[:-1] + (2, 2, ROPE_FREQS)).astype(jnp.float32)
    rot = jnp.concatenate([-xr[..., 1:, :], xr[..., :1, :]], axis=-2)
    return (xr * cos + rot * sin).astype(x.dtype).reshape(x.shape)


def blocked_attention(q, k, v):
    b, lq, hq, dh = q.shape
    hkv = k.shape[2]
    grp = hq // hkv
    nb = lq // Q_BLOCK
    qb = q.reshape(b, nb, Q_BLOCK, hkv, grp, dh).transpose(1, 0, 2, 3, 4, 5)
    scale = dh ** -0.5

    def one_block(qblk):
        s = jnp.einsum('bqhgd,bkhd->bhgqk', qblk, k, preferred_element_type=jnp.float32) * scale
        p = jax.nn.softmax(s, axis=-1).astype(v.dtype)
        return jnp.einsum('bhgqk,bkhd->bqhgd', p, v)

    o = lax.map(one_block, qb)
    return o.transpose(1, 0, 2, 3, 4, 5).reshape(b, lq, hq * dh)


def pool_mixer(u, w_grp, scale):
    b, L, _ = u.shape
    ug = u.reshape(b, L, POOL_GROUPS, POOL_GROUP_DIM).astype(jnp.float32)
    cs = jnp.concatenate([jnp.zeros((b, 1, POOL_GROUPS, POOL_GROUP_DIM), jnp.float32),
                          jnp.cumsum(ug, axis=1)], axis=1)
    t = jnp.arange(L)
    outs = []
    for gi, w in enumerate(POOL_WINDOWS):
        lo = jnp.clip(t - w // 2, 0, L)
        hi = jnp.clip(t + w // 2, 0, L)
        csg = cs[:, :, gi]
        win_sum = jnp.take(csg, hi, axis=1) - jnp.take(csg, lo, axis=1)
        cnt = (hi - lo).astype(jnp.float32)[None, :, None]
        outs.append(win_sum / cnt - ug[:, :, gi])
    d = jnp.stack(outs, axis=2).astype(u.dtype)
    y = jnp.einsum('blgc,gcd->blgd', d, w_grp)
    return y.reshape(b, L, POOL_WIDTH) * scale


def even_mix(a_val, a_gate, q, b_gate, k_all, v_all, pool_w, pool_scale, w_out):
    ya = pool_mixer(a_val, pool_w, pool_scale)
    yb = blocked_attention(q, k_all, v_all)
    y = jnp.concatenate([ya * jax.nn.silu(a_gate), yb * jax.nn.silu(b_gate)], axis=-1)
    return y @ w_out


def short_conv3(u, w, b):
    up = jnp.pad(u, ((0, 0), (1, 1), (0, 0)))
    return up[:, :-2] * w[0] + up[:, 1:-1] * w[1] + up[:, 2:] * w[2] + b


def hyena_filters(L, w1, b1, w2, b2, w3, freq):
    f32 = jnp.float32
    t = jnp.linspace(0.0, 1.0, L, dtype=f32)[:, None]
    w = 2.0 * math.pi * jnp.arange(L, dtype=f32)[:, None] / L
    f = jnp.linspace(1e-4, HY_BANDS - 1, HY_BANDS, dtype=f32)[None, :]
    emb = jnp.concatenate([t, jnp.cos(f * w), -jnp.sin(f * w)], axis=-1)
    fr = freq.astype(f32)
    hdn = jnp.sin(fr * (emb @ w1.astype(f32) + b1.astype(f32)))
    hdn = jnp.sin(fr * (hdn @ w2.astype(f32) + b2.astype(f32)))
    h = (hdn @ w3.astype(f32)).reshape(L, HY_ORDER, 2, HY_WIDTH)
    max_decay = math.log(HY_DECAY_TARGET) / HY_FAST_DECAY
    min_decay = math.log(HY_DECAY_TARGET) / HY_SLOW_DECAY
    deltas = jnp.linspace(min_decay, max_decay, HY_WIDTH, dtype=f32)
    decay = jnp.exp(-t * jnp.abs(deltas))
    h = h * decay[:, None, None, :]
    h = h / (jnp.sum(jnp.abs(h), axis=(0, 2), keepdims=True) + EPS)
    zero = jnp.zeros((1, HY_ORDER, HY_WIDTH), f32)
    return jnp.concatenate([h[:, :, 0], zero, h[:0:-1, :, 1]], axis=0)


def fft_long_conv(z, kfull):
    L = z.shape[1]
    zf = jnp.fft.rfft(z, n=2 * L, axis=1)
    kf = jnp.fft.rfft(kfull, n=2 * L, axis=0)
    return jnp.fft.irfft(zf * kf[None], n=2 * L, axis=1)[:, :L]


def hyena_mixer(u, conv_w, conv_b, w1, b1, w2, b2, w3, freq, skip):
    L = u.shape[1]
    uc = short_conv3(u, conv_w, conv_b)
    v, x1, x2 = jnp.split(uc, HY_ORDER + 1, axis=-1)
    k = hyena_filters(L, w1, b1, w2, b2, w3, freq)
    z = v.astype(jnp.float32)
    for o, gate_o in enumerate((x1, x2)):
        z = gate_o.astype(jnp.float32) * (fft_long_conv(z, k[:, o]) + skip[o].astype(jnp.float32) * z)
    return z.astype(u.dtype)


def fourier_mixer(u, w):
    y = jnp.fft.fft2(u.astype(jnp.float32), axes=(1, 2), norm='ortho').real
    return y.astype(u.dtype) @ w


def odd_mix(h, w_in, w_out, fn_w, conv_w, conv_b, w1, b1, w2, b2, w3, freq, skip):
    hy_in, hy_gate, fn_in, fn_gate = jnp.split(h @ w_in, ODD_SPLITS, axis=-1)
    yc = hyena_mixer(hy_in, conv_w, conv_b, w1, b1, w2, b2, w3, freq, skip)
    yd = fourier_mixer(fn_in, fn_w)
    y = jnp.concatenate([yc * jax.nn.silu(hy_gate), yd * jax.nn.silu(fn_gate)], axis=-1)
    return y @ w_out


def setup_inputs(seed: int = 0) -> dict:
    key = jax.random.key(seed)
    ks = jax.random.split(key, 26)

    def nrm(k, shape, s):
        return jax.random.normal(k, shape, jnp.float32) * s

    return {
        'x': nrm(ks[0], (BATCH, SEQ, D_MODEL), 1.0),
        'c': nrm(ks[1], (BATCH, D_MODEL), 1.0),
        'ctx': nrm(ks[2], (BATCH, CTX_LEN, D_MODEL), 1.0),
        'c_ctx': nrm(ks[3], (D_MODEL,), 1.0),
        'w_mod': nrm(ks[4], (DEPTH, D_MODEL, 3 * D_MODEL), 0.5 * D_MODEL ** -0.5),
        'b_mod': nrm(ks[5], (DEPTH, 3 * D_MODEL), 0.01),
        'norm_g': 1.0 + nrm(ks[6], (DEPTH, D_MODEL), 0.05),
        'ev_w_in': nrm(ks[7], (N_EVEN, D_MODEL, EVEN_IN), D_MODEL ** -0.5),
        'ev_w_out': nrm(ks[8], (N_EVEN, EVEN_MIX, D_MODEL), EVEN_MIX ** -0.5),
        'pool_w': nrm(ks[9], (N_EVEN, POOL_GROUPS, POOL_GROUP_DIM, POOL_GROUP_DIM), POOL_GROUP_DIM ** -0.5),
        'pool_scale': 1.0 + nrm(ks[10], (N_EVEN, POOL_WIDTH), 0.1),
        'q_norm_g': 1.0 + nrm(ks[11], (N_EVEN, HEAD_DIM), 0.05),
        'k_norm_g': 1.0 + nrm(ks[12], (N_EVEN, HEAD_DIM), 0.05),
        'od_w_in': nrm(ks[13], (N_ODD, D_MODEL, ODD_IN), D_MODEL ** -0.5),
        'od_w_out': nrm(ks[14], (N_ODD, ODD_MIX, D_MODEL), ODD_MIX ** -0.5),
        'hy_conv_w': nrm(ks[15], (N_ODD, 3, (HY_ORDER + 1) * HY_WIDTH), 3 ** -0.5),
        'hy_conv_b': nrm(ks[16], (N_ODD, (HY_ORDER + 1) * HY_WIDTH), 0.01),
        'hy_w1': nrm(ks[17], (N_ODD, HY_EMB, HY_HIDDEN), HY_EMB ** -0.5),
        'hy_b1': nrm(ks[18], (N_ODD, HY_HIDDEN), 0.1),
        'hy_w2': nrm(ks[19], (N_ODD, HY_HIDDEN, HY_HIDDEN), HY_HIDDEN ** -0.5),
        'hy_b2': nrm(ks[20], (N_ODD, HY_HIDDEN), 0.1),
        'hy_w3': nrm(ks[21], (N_ODD, HY_HIDDEN, HY_ORDER * 2 * HY_WIDTH), HY_HIDDEN ** -0.5),
        'hy_freq': 1.0 + nrm(ks[22], (N_ODD, HY_HIDDEN), 0.1),
        'hy_skip': nrm(ks[23], (N_ODD, HY_ORDER, HY_WIDTH), 1.0),
        'fn_w': nrm(ks[24], (N_ODD, FN_WIDTH, FN_WIDTH), FN_WIDTH ** -0.5),
        'final_g': 1.0 + nrm(ks[25], (D_MODEL,), 0.05),
    }


def reference(x, c, ctx, c_ctx, w_mod, b_mod, norm_g, ev_w_in, ev_w_out, pool_w, pool_scale,
              q_norm_g, k_norm_g, od_w_in, od_w_out, hy_conv_w, hy_conv_b, hy_w1, hy_b1, hy_w2, hy_b2,
              hy_w3, hy_freq, hy_skip, fn_w, final_g):
    n_tok = x.shape[1]
    rows = n_tok // GRID_W
    row_idx = jnp.broadcast_to(jnp.arange(rows, dtype=jnp.float32)[:, None], (rows, GRID_W)).reshape(-1)
    col_idx = jnp.broadcast_to(jnp.arange(GRID_W, dtype=jnp.float32)[None, :], (rows, GRID_W)).reshape(-1)
    cos, sin = axial_rope_tables(row_idx, col_idx)

    for i in range(DEPTH):
        li = i // 2
        is_even = i % 2 == 0
        ctx_needed = any(j % 2 == 0 for j in range(i + 1, DEPTH))
        shift, scale, gate = modulation(c[:, None, :], w_mod[i], b_mod[i])
        h = rmsnorm(x, norm_g[i]) * (1 + scale) + shift
        if is_even or ctx_needed:
            cshift, cscale, cgate = modulation(c_ctx[None, None, :], w_mod[i], b_mod[i])
            hc = rmsnorm(ctx, norm_g[i]) * (1 + cscale) + cshift
        if is_even:
            w_in = ev_w_in[li]
            a_val, a_gate, q, k, v, b_gate = jnp.split(h @ w_in, EVEN_SPLITS, axis=-1)
            q = apply_rope(rmsnorm(to_heads(q, N_Q_HEADS), q_norm_g[li]), cos, sin)
            k = apply_rope(rmsnorm(to_heads(k, N_KV_HEADS), k_norm_g[li]), cos, sin)
            if ctx_needed:
                ca_val, ca_gate, cq, ck, cv, cb_gate = jnp.split(hc @ w_in, EVEN_SPLITS, axis=-1)
            else:
                ck, cv = jnp.split(hc @ w_in[:, EVEN_SPLITS[2]:EVEN_SPLITS[4]], 2, axis=-1)
            ck = rmsnorm(to_heads(ck, N_KV_HEADS), k_norm_g[li])
            cv = to_heads(cv, N_KV_HEADS)
            k_all = jnp.concatenate([ck, k], axis=1)
            v_all = jnp.concatenate([cv, to_heads(v, N_KV_HEADS)], axis=1)
            y = even_mix(a_val, a_gate, q, b_gate, k_all, v_all, pool_w[li], pool_scale[li], ev_w_out[li])
            if ctx_needed:
                cq = rmsnorm(to_heads(cq, N_Q_HEADS), q_norm_g[li])
                yc = even_mix(ca_val, ca_gate, cq, cb_gate, ck, cv, pool_w[li], pool_scale[li], ev_w_out[li])
                ctx = ctx + cgate * yc
            x = x + gate * y
        else:
            y = odd_mix(h, od_w_in[li], od_w_out[li], fn_w[li], hy_conv_w[li], hy_conv_b[li],
                        hy_w1[li], hy_b1[li], hy_w2[li], hy_b2[li], hy_w3[li], hy_freq[li], hy_skip[li])
            if ctx_needed:
                yc = odd_mix(hc, od_w_in[li], od_w_out[li], fn_w[li], hy_conv_w[li], hy_conv_b[li],
                             hy_w1[li], hy_b1[li], hy_w2[li], hy_b2[li], hy_w3[li], hy_freq[li], hy_skip[li])
                ctx = ctx + cgate * yc
            x = x + gate * y
    return rmsnorm(x, final_g)
```

```cpp
#include <hip/hip_runtime.h>
#include <hip/hip_bf16.h>
#include <hip/hip_cooperative_groups.h>
#include <cstdio>
#include <cstdint>
namespace cg = cooperative_groups;

#ifndef MK_FUSE_NORM
#define MK_FUSE_NORM 0
#endif
#ifndef MK_MULTI
#define MK_MULTI 0
#endif

constexpr int L = 16384, DM = 1024, CTX = 256, LK = L + CTX;
constexpr int NPH = 12;
constexpr float EPS = 1e-6f;
constexpr size_t MiB = (size_t)1 << 20, KiB = 1024;
constexpr size_t WS_MOD = 0, WS_ROPE = 64 * KiB, WS_TW2 = 128 * KiB, WS_T = 256 * KiB, WS_PART = 768 * KiB;
constexpr size_t WS_WIN0 = 2 * MiB, WS_WOUT0 = 7 * MiB, WS_WIN1 = 9 * MiB, WS_WOUT1 = 17 * MiB, WS_W3T = 19 * MiB, WS_HD2B = 21 * MiB;
constexpr size_t WS_H = 30 * MiB, WS_AV = 63 * MiB, WS_AG = 79 * MiB, WS_Q = 87 * MiB, WS_K = 111 * MiB, WS_V = 120 * MiB, WS_BG = 129 * MiB;
constexpr size_t WS_BAR = 1600 * KiB; constexpr size_t WS_CNT = 1536 * KiB, WS_PARTIAL = 160 * MiB; constexpr size_t PARTIAL_FLOATS = 256 * 128 + 512;
constexpr size_t WS_H2 = MK_FUSE_NORM ? 63 * MiB : 94 * MiB;
constexpr size_t WS_P1T = 136 * MiB, WS_HT = 30 * MiB, WS_END = 256 * MiB;
constexpr int LDS_BYTES = 155648;
constexpr int XS_OFF = 131072;

typedef unsigned short bf16_t;
typedef float f32x4 __attribute__((ext_vector_type(4)));
typedef unsigned u32x4 __attribute__((ext_vector_type(4)));
typedef unsigned u32x2 __attribute__((ext_vector_type(2)));

struct Args { const float* in[26]; float* out; unsigned char* ws; int ph_lo, ph_hi; };

__device__ __forceinline__ float bf2f(bf16_t v) { return __uint_as_float((unsigned)v << 16); }
__device__ __forceinline__ unsigned f2bf(float f) { unsigned u = __float_as_uint(f); return (u + 0x7fffu + ((u >> 16) & 1u)) >> 16; }
__device__ __forceinline__ unsigned pk2(float lo, float hi) { return f2bf(lo) | (f2bf(hi) << 16); }
__device__ __forceinline__ float siluf(float v) { return v / (1.f + __expf(-v)); }
__device__ __forceinline__ float wave_sum(float v) {
#pragma unroll
  for (int o = 32; o >= 1; o >>= 1) v += __shfl_xor(v, o);
  return v;
}

__device__ __forceinline__ int qk_srccol(int j) {
  if (j < 512 || j >= 1536) return j;
  const int base = j & ~127, p = j & 127, g = p >> 3, e = p & 7;
  const int axis = g >> 3, f = 4 * (g & 7) + (e & 3), half = e >> 2;
  return base + axis * 64 + half * 32 + f;
}
template <int MODE>
__device__ __forceinline__ void wt_tile(const float* __restrict__ src, int ldn, int off, bf16_t* __restrict__ dst, int j0, int k0, float* tl, int tid) {
  const int cc = tid & 63, r0 = tid >> 6;
  const int sc = (MODE == 1) ? qk_srccol(j0 + cc) : (off + j0 + cc);
#pragma unroll
  for (int i = 0; i < 8; ++i) { const int r = r0 + 8 * i; tl[r * 65 + cc] = src[(size_t)(k0 + r) * ldn + sc]; }
  __syncthreads();
  const int n = tid >> 3, kq = (tid & 7) * 8;
  u32x4 w;
  w.x = pk2(tl[(kq + 0) * 65 + n], tl[(kq + 1) * 65 + n]); w.y = pk2(tl[(kq + 2) * 65 + n], tl[(kq + 3) * 65 + n]);
  w.z = pk2(tl[(kq + 4) * 65 + n], tl[(kq + 5) * 65 + n]); w.w = pk2(tl[(kq + 6) * 65 + n], tl[(kq + 7) * 65 + n]);
  *(u32x4*)(dst + (size_t)(j0 + n) * 1024 + k0 + kq) = w;
  __syncthreads();
}
template <int MODE>
__device__ __forceinline__ void wt_quad(const float* __restrict__ src, int ldn, int off, bf16_t* __restrict__ dst, int j0, int k0, float* tl, int tid) {
  const int cc = tid & 63, r0 = tid >> 6;
  const int sc = (MODE == 1) ? qk_srccol(j0 + cc) : (off + j0 + cc);
  float v[32];
#pragma unroll
  for (int i = 0; i < 32; ++i) v[i] = src[(size_t)(k0 + r0 + 8 * i) * ldn + sc];
#pragma unroll
  for (int i = 0; i < 32; ++i) tl[(r0 + 8 * i) * 65 + cc] = v[i];
  __syncthreads();
  const int n = tid >> 3, kq = (tid & 7) * 8;
#pragma unroll
  for (int s = 0; s < 4; ++s) { const float* t = tl + (s * 64 + kq) * 65 + n; u32x4 w;
    w.x = pk2(t[0], t[65]); w.y = pk2(t[130], t[195]); w.z = pk2(t[260], t[325]); w.w = pk2(t[390], t[455]);
    *(u32x4*)(dst + (size_t)(j0 + n) * 1024 + k0 + s * 64 + kq) = w; }
  __syncthreads();
}
__device__ __forceinline__ void wt_pool_tile(const float* __restrict__ src, const float* __restrict__ pw, const float* __restrict__ pscale, bf16_t* __restrict__ dst, int j0, int k0, float* lds, int tid) {
  float* A = lds; float* Bm = lds + 64 * 65; float* tl = lds + 2 * 64 * 65;
  const int cc = tid & 63, r0 = tid >> 6, g = j0 >> 6;
#pragma unroll
  for (int i = 0; i < 8; ++i) { const int r = r0 + 8 * i; A[r * 65 + cc] = src[(size_t)(k0 + r) * 2560 + g * 64 + cc]; Bm[r * 65 + cc] = pw[(g * 64 + r) * 64 + cc]; }
  __syncthreads();
  const float sc = pscale[j0 + cc];
#pragma unroll
  for (int i = 0; i < 8; ++i) { const int r = r0 + 8 * i; float s = 0.f;
    for (int q = 0; q < 64; ++q) s += A[r * 65 + q] * Bm[q * 65 + cc];
    tl[r * 65 + cc] = s * sc; }
  __syncthreads();
  const int n = tid >> 3, kq = (tid & 7) * 8;
  u32x4 w;
  w.x = pk2(tl[(kq + 0) * 65 + n], tl[(kq + 1) * 65 + n]); w.y = pk2(tl[(kq + 2) * 65 + n], tl[(kq + 3) * 65 + n]);
  w.z = pk2(tl[(kq + 4) * 65 + n], tl[(kq + 5) * 65 + n]); w.w = pk2(tl[(kq + 6) * 65 + n], tl[(kq + 7) * 65 + n]);
  *(u32x4*)(dst + (size_t)(j0 + n) * 1024 + k0 + kq) = w;
  __syncthreads();
}

namespace prep {
constexpr int N_MOD = 192, N_WIN0 = 208, N_WOUT = 64, N_WIN1A = 192, N_WIN1B = 16, N_T = 256, N_HD2 = 256, N_W3T = 48, N_ROPE = 16, N_TW2 = 32;
constexpr int O_WIN0 = N_MOD, O_WOUT0 = O_WIN0 + N_WIN0, O_WOUT1 = O_WOUT0 + N_WOUT, O_WIN1A = O_WOUT1 + N_WOUT, O_WIN1B = O_WIN1A + N_WIN1A,
                O_T = O_WIN1B + N_WIN1B, O_HD2 = O_T + N_T, O_W3T = O_HD2 + N_HD2, O_ROPE = O_W3T + N_W3T, O_TW2 = O_ROPE + N_ROPE, O_END = O_TW2 + N_TW2;
constexpr int N_EARLY = O_WOUT1 + N_T + N_ROPE + N_TW2, N_LATE = (O_T - O_WOUT1) + (O_ROPE - O_HD2);
__host__ __device__ constexpr int early_item(int e) { return e < O_WOUT1 ? e : (e < O_WOUT1 + N_T ? O_T + (e - O_WOUT1) : O_ROPE + (e - O_WOUT1 - N_T)); }
__host__ __device__ constexpr int late_item(int q) { return q < O_T - O_WOUT1 ? O_WOUT1 + q : O_HD2 + (q - (O_T - O_WOUT1)); }
}
__device__ __forceinline__ void prep_item(const Args& a, int item, float* lds, int tid) {
  using namespace prep;
  unsigned char* ws = a.ws;
  {
    asm volatile("" : "+v"(tid));
    if (item < O_WIN0) {
      const int layer = item / 96, chunk = item % 96, col = chunk * 32 + (tid & 31), rg = tid >> 5;
      const float* wm = a.in[4] + (size_t)layer * 1024 * 3072; const float* cv = a.in[1]; const float* cc = a.in[3];
      float s0 = 0.f, s1 = 0.f;
      for (int r = rg; r < 1024; r += 16) { const float w = wm[(size_t)r * 3072 + col]; s0 += siluf(cv[r]) * w; if (layer == 0) s1 += siluf(cc[r]) * w; }
      lds[tid] = s0; lds[512 + tid] = s1; __syncthreads();
      if (tid < 32) { float t0 = 0.f, t1 = 0.f; for (int q = 0; q < 16; ++q) { t0 += lds[q * 32 + tid]; t1 += lds[512 + q * 32 + tid]; }
        const float bm = a.in[5][layer * 3072 + col]; float* MOD = (float*)(ws + WS_MOD);
        if (layer == 0) { MOD[col] = t0 + bm; MOD[3072 + col] = t1 + bm; } else MOD[2 * 3072 + col] = t0 + bm; }
      __syncthreads();
    } else if (item < O_WOUT0) {
      const int ti = item - O_WIN0;
      if (ti < 64) wt_pool_tile(a.in[7], a.in[9], a.in[10], (bf16_t*)(ws + WS_WIN0), (ti / 16) * 64, (ti % 16) * 64, lds, tid);
      else { const int tq = ti - 64; wt_quad<1>(a.in[7], 2560, 0, (bf16_t*)(ws + WS_WIN0), (4 + tq / 4) * 64, (tq % 4) * 256, lds, tid); }
    } else if (item < O_WOUT1) { const int ti = item - O_WOUT0; wt_quad<0>(a.in[8], 1024, 0, (bf16_t*)(ws + WS_WOUT0), (ti / 4) * 64, (ti % 4) * 256, lds, tid);
    } else if (item < O_WIN1A) { const int ti = item - O_WOUT1; wt_quad<0>(a.in[14], 1024, 0, (bf16_t*)(ws + WS_WOUT1), (ti / 4) * 64, (ti % 4) * 256, lds, tid);
    } else if (item < O_WIN1B) { const int ti = item - O_WIN1A; wt_quad<0>(a.in[13], 3584, 0, (bf16_t*)(ws + WS_WIN1), (ti / 4) * 64, (ti % 4) * 256, lds, tid);
    } else if (item < O_T) {     const int ti = item - O_WIN1B; wt_quad<0>(a.in[13], 3584, 3328 - 3584, (bf16_t*)(ws + WS_WIN1), 3584 + (ti / 4) * 64, (ti % 4) * 256, lds, tid);
    } else if (item < O_HD2) {
      const int i = item - O_T;
      if (tid < 256) lds[tid] = cospif((float)tid / 128.f);
      __syncthreads();
      const int n = tid & 255, part = tid >> 8; const float* fw = a.in[24];
      float s = 0.f;
      for (int j = 0; j < 256; ++j) { const int m = (i * j) & 255; const float tr = part ? lds[(m - 64) & 255] : lds[m]; s += tr * fw[j * 256 + n]; }
      ((float*)(ws + WS_T))[(part * 256 + i) * 256 + n] = (part ? -s : s) * (1.f / 2048.f);
      __syncthreads();
    } else if (item < O_W3T) {
      const int t0 = (item - O_HD2) * 64;
      float* e = lds; float* h1 = lds + 64 * 34;
      for (int idx = tid; idx < 64 * 33; idx += 512) { const int tl = idx / 33, q = idx % 33, t = t0 + tl; float v;
        if (q == 0) v = (float)t / 16383.f;
        else { const int b = (q - 1) & 15; const float f = 1e-4f + (float)b * ((15.f - 1e-4f) / 15.f); const float w = 6.2831855f * (float)t / 16384.f; const float ar = f * w;
          v = (q <= 16) ? cosf(ar) : -sinf(ar); }
        e[tl * 34 + q] = v; }
      __syncthreads();
      const int j = tid & 63, r0 = tid >> 6; const float fr = a.in[22][j];
#pragma unroll
      for (int i = 0; i < 8; ++i) { const int tl = r0 + 8 * i; float s = a.in[18][j];
        for (int q = 0; q < 33; ++q) s += e[tl * 34 + q] * a.in[17][q * 64 + j];
        h1[tl * 65 + j] = sinf(fr * s); }
      __syncthreads();
      bf16_t* HD = (bf16_t*)(ws + WS_HD2B);
#pragma unroll
      for (int i = 0; i < 8; ++i) { const int tl = r0 + 8 * i; float s = a.in[20][j];
        for (int q = 0; q < 64; ++q) s += h1[tl * 65 + q] * a.in[19][q * 64 + j];
        HD[(size_t)(t0 + tl) * 64 + j] = (bf16_t)f2bf(sinf(fr * s)); }
      __syncthreads();
    } else if (item < O_ROPE) {
      const int row = (item - O_W3T) * 64 + (tid >> 3), kg = (tid & 7) * 8; u32x4 w = {0u, 0u, 0u, 0u};
      { const float* w3 = a.in[21]; float v[8];
#pragma unroll
        for (int q = 0; q < 8; ++q) v[q] = w3[(size_t)(kg + q) * 3072 + row];
        w.x = pk2(v[0], v[1]); w.y = pk2(v[2], v[3]); w.z = pk2(v[4], v[5]); w.w = pk2(v[6], v[7]); }
      *(u32x4*)((bf16_t*)(ws + WS_W3T) + (size_t)row * 64 + kg) = w;
    } else if (item < O_TW2) {
      const int idx = (item - O_ROPE) * 512 + tid, pos = idx >> 5, f = idx & 31;
      const float inv = powf(10000.f, -(float)f / 32.f), ang = (float)pos * inv;
      ((float2*)(ws + WS_ROPE))[idx] = make_float2(cosf(ang), sinf(ang));
    } else {
      if (item == O_TW2 && tid < 400) ((unsigned*)(ws + WS_CNT))[tid] = 0u;
      const int n = (item - O_TW2) * 512 + tid; float s, c; sincospif((float)n / 16384.f, &s, &c);
      ((float2*)(ws + WS_TW2))[n] = make_float2(c, -s);
    }
  }
}
__device__ __forceinline__ void p0_prep(const Args& a, float* lds, int tid) {
  for (int e = blockIdx.x; e < prep::N_EARLY; e += gridDim.x) prep_item(a, prep::early_item(e), lds, tid);
}

__device__ __forceinline__ void rows_norm_mod(const float* __restrict__ X, const float* __restrict__ C, int nctx, int nrows, const float* __restrict__ g,
                                              const float* __restrict__ modx, const float* __restrict__ modc, bf16_t* __restrict__ H, int tid) {
  const int lane = tid & 63, wid = tid >> 6;
  for (int row = blockIdx.x * 8 + wid; row < nrows; row += gridDim.x * 8) {
    const float* src = row < nctx ? C + (size_t)row * 1024 : X + (size_t)(row - nctx) * 1024; const float* md = row < nctx ? modc : modx;
    f32x4 v[4]; float ss = 0.f;
#pragma unroll
    for (int i = 0; i < 4; ++i) { v[i] = *(const f32x4*)(src + (lane + 64 * i) * 4); ss += v[i].x * v[i].x + v[i].y * v[i].y + v[i].z * v[i].z + v[i].w * v[i].w; }
    ss = wave_sum(ss); const float rinv = rsqrtf(ss * (1.f / 1024.f) + EPS);
#pragma unroll
    for (int i = 0; i < 4; ++i) { const int c = (lane + 64 * i) * 4; const f32x4 gg = *(const f32x4*)(g + c), sh = *(const f32x4*)(md + c), sc = *(const f32x4*)(md + 1024 + c);
      const f32x4 y = v[i] * rinv * gg * (sc + 1.f) + sh;
      u32x2 w; w.x = pk2(y.x, y.y); w.y = pk2(y.z, y.w); *(u32x2*)(H + (size_t)row * 1024 + c) = w; }
  }
}
__device__ __forceinline__ void rows_final(float* __restrict__ X, const float* __restrict__ g, int tid) {
  const int lane = tid & 63, wid = tid >> 6;
  for (int row = blockIdx.x * 8 + wid; row < L; row += gridDim.x * 8) {
    float* src = X + (size_t)row * 1024; f32x4 v[4]; float ss = 0.f;
#pragma unroll
    for (int i = 0; i < 4; ++i) { v[i] = *(const f32x4*)(src + (lane + 64 * i) * 4); ss += v[i].x * v[i].x + v[i].y * v[i].y + v[i].z * v[i].z + v[i].w * v[i].w; }
    ss = wave_sum(ss); const float rinv = rsqrtf(ss * (1.f / 1024.f) + EPS);
#pragma unroll
    for (int i = 0; i < 4; ++i) { const int c = (lane + 64 * i) * 4; const f32x4 gg = *(const f32x4*)(g + c); *(f32x4*)(src + c) = v[i] * rinv * gg; }
  }
}
__device__ __forceinline__ void fold_item(const Args& a, int item, float* lds, int tid) {
  float* A = lds; float* Bm = lds + 64 * 257; const float* T = (const float*)(a.ws + WS_T); bf16_t* W = (bf16_t*)(a.ws + WS_WIN1);
  {
    const int kt = item >> 3, nt = item & 7, part = nt >> 2, n0 = (nt & 3) * 64, k0 = kt * 64;
    for (int idx = tid; idx < 64 * 256; idx += 512) { const int k = idx >> 8, i = idx & 255; A[k * 257 + i] = a.in[13][(size_t)(k0 + k) * 3584 + 3072 + i]; }
    for (int idx = tid; idx < 256 * 64; idx += 512) { const int i = idx >> 6, n = idx & 63; Bm[i * 64 + n] = T[(part * 256 + i) * 256 + n0 + n]; }
    __syncthreads();
    const int n = tid & 63, r0 = tid >> 6; float s[8];
#pragma unroll
    for (int q = 0; q < 8; ++q) s[q] = 0.f;
    for (int i = 0; i < 256; ++i) { const float b = Bm[i * 64 + n];
#pragma unroll
      for (int q = 0; q < 8; ++q) s[q] += A[(r0 + 8 * q) * 257 + i] * b; }
#pragma unroll
    for (int q = 0; q < 8; ++q) W[(size_t)(3072 + part * 256 + n0 + n) * 1024 + k0 + r0 + 8 * q] = (bf16_t)f2bf(s[q]);
    __syncthreads();
  }
}

namespace pg8 {
#define PG8_LAS __attribute__((address_space(3)))
typedef unsigned short bf16_t;
typedef short bf16x8 __attribute__((ext_vector_type(8)));
typedef float f32x4 __attribute__((ext_vector_type(4)));
typedef unsigned u32x4 __attribute__((ext_vector_type(4)));
constexpr int BM = 256, BK = 64, HALF = 128, HTB = HALF * BK * 2  , STAGE_BYTES = 8 * HTB, NXCD = 8, WGM = 8;

__host__ __device__ __forceinline__ int lds_byte(int r, int c) { const int st = (r >> 4) * 2 + (c >> 5), rr = r & 15, cc = c & 31, ob = rr * 64 + cc * 2; return st * 1024 + (ob ^ (((ob >> 9) & 1) << 5)); }
__host__ __device__ __forceinline__ void stage_rc(int b, int& R, int& C) { const int st = b / 1024, sb = b % 1024, swz = sb ^ (((sb >> 9) & 1) << 5); R = (st >> 1) * 16 + swz / 64; C = (st & 1) * 32 + (swz % 64) / 2; }
__host__ __device__ __forceinline__ int perm32(int rho) { const int n = rho >> 4, i = rho & 15; return 8 * (i >> 2) + 4 * n + (i & 3); }

struct Unit { int pm, pn; };
struct Gemm { const bf16_t* A; const bf16_t* Bt; int M, N, K; };
__device__ __forceinline__ unsigned cvt_pk_bf16(float lo, float hi) { unsigned r; asm volatile("v_cvt_pk_bf16_f32 %0, %1, %2" : "=v"(r) : "v"(lo), "v"(hi)); return r; }
}

namespace pg8 {

struct StaticOrder {
    int nM, nN, nwg, G, c;
    __host__ __device__ void init(int M, int N, int G_, int c_) { nM = M / BM; nN = N / BM; nwg = nM * nN; G = G_; c = c_; }
    __host__ __device__ bool next(int i, Unit& u) const {
        const long L = (long)i * G + c; if (L >= nwg) return false;
        int wgid = (int)L; { const int q = nwg / NXCD, r = nwg % NXCD, xcd = wgid % NXCD, off = wgid / NXCD; wgid = (xcd < r ? xcd * (q + 1) : r * (q + 1) + (xcd - r) * q) + off; }
        const int nig = WGM * nN, gid = wgid / nig, fm = gid * WGM, gsz = (nM - fm) < WGM ? (nM - fm) : WGM;
        u.pm = fm + ((wgid % nig) % gsz); u.pn = (wgid % nig) / gsz; return true;
    }
    __device__ __forceinline__ void a_ready(const Unit&) const {}
    __device__ __forceinline__ void done(const Unit&) const {}
};

struct SchedIn0 {
  int G, c;
  __device__ __forceinline__ bool next(int i, Unit& u) const { const int l = i * G + c; if (l >= 642) return false;
    if (l < 2) { u.pm = 0; u.pn = 5 + l; } else { const int v = l - 2; u.pm = 1 + v / 10; u.pn = v % 10; } return true; }
  __device__ __forceinline__ void a_ready(const Unit&) const {}
  __device__ __forceinline__ void done(const Unit&) const {}
};
struct SchedRow {
  int nN, total, G, c;
  __device__ __forceinline__ bool next(int i, Unit& u) const { const int l = i * G + c; if (l >= total) return false; u.pm = l / nN; u.pn = l % nN; return true; }
  __device__ __forceinline__ void a_ready(const Unit&) const {}
  __device__ __forceinline__ void done(const Unit&) const {}
};
struct SchedCol {
  int nM, total, G, c;
  __device__ __forceinline__ bool next(int i, Unit& u) const { const int l = i * G + c; if (l >= total) return false; u.pn = l / nM; u.pm = l % nM; return true; }
  __device__ __forceinline__ void a_ready(const Unit&) const {}
  __device__ __forceinline__ void done(const Unit&) const {}
};
struct EpiIn0 {
  static constexpr bool PERM = true, AFTER_DRAIN = false;
  float* AV; bf16_t *AG, *Q, *K, *V, *BG; const float *qg, *kg; const float2* rope; float* xs;
  __device__ __forceinline__ void operator()(const f32x4 (&acc)[2][2][4][2], const Unit& u, int wr, int wc, int fr, int fq) const {
    const int pn = u.pn, rl0 = wr * 64 + fr, row0 = u.pm * 256 + rl0, cl = wc * 32 + 8 * fq;
    if (u.pm == 0 && pn != 5 && pn != 6) return;
    if (pn == 0) {
#pragma unroll
      for (int ai = 0; ai < 2; ++ai)
#pragma unroll
        for (int m = 0; m < 4; ++m) { float* p = AV + (size_t)(row0 + ai * 128 + m * 16 - 256) * 256 + cl;
#pragma unroll
          for (int bj = 0; bj < 2; ++bj) { *(f32x4*)(p + bj * 128) = acc[ai][bj][m][0]; *(f32x4*)(p + bj * 128 + 4) = acc[ai][bj][m][1]; } }
    } else if (pn == 1 || pn >= 6) {
      bf16_t* dst; int ld, roff = 256, coff = 0; bool act = true;
      size_t hstride = 128;
      if (pn == 1) { dst = AG; ld = 256; } else if (pn == 6) { dst = V; ld = 128; roff = 0; act = false; hstride = (size_t)LK * 128; } else { dst = BG; ld = 768; coff = (pn - 7) * 256; }
#pragma unroll
      for (int ai = 0; ai < 2; ++ai)
#pragma unroll
        for (int m = 0; m < 4; ++m) { bf16_t* p = dst + (size_t)(row0 + ai * 128 + m * 16 - roff) * ld + coff + cl;
#pragma unroll
          for (int bj = 0; bj < 2; ++bj) { f32x4 v0 = acc[ai][bj][m][0], v1 = acc[ai][bj][m][1];
            if (act) { v0.x = siluf(v0.x); v0.y = siluf(v0.y); v0.z = siluf(v0.z); v0.w = siluf(v0.w); v1.x = siluf(v1.x); v1.y = siluf(v1.y); v1.z = siluf(v1.z); v1.w = siluf(v1.w); }
            u32x4 w; w.x = pk2(v0.x, v0.y); w.y = pk2(v0.z, v0.w); w.z = pk2(v1.x, v1.y); w.w = pk2(v1.z, v1.w);
            *(u32x4*)(p + bj * hstride) = w; } }
    } else {
#pragma unroll
      for (int ai = 0; ai < 2; ++ai)
#pragma unroll
        for (int m = 0; m < 4; ++m)
#pragma unroll
          for (int bj = 0; bj < 2; ++bj) { const f32x4 x0 = acc[ai][bj][m][0], x1 = acc[ai][bj][m][1];
            float s = x0.x * x0.x + x0.y * x0.y + x0.z * x0.z + x0.w * x0.w + x1.x * x1.x + x1.y * x1.y + x1.z * x1.z + x1.w * x1.w;
            s += __shfl_xor(s, 16); s += __shfl_xor(s, 32);
            if (fq == 0) xs[(bj * 256 + ai * 128 + m * 16 + rl0) * 4 + wc] = s; }
      __syncthreads();
      const bool isk = (pn == 5); const float* gw = isk ? kg : qg;
      const int axis = wc >> 1, f0 = 4 * ((4 * wc + fq) & 7);
      const f32x4 g0 = *(const f32x4*)(gw + axis * 64 + f0), g1 = *(const f32x4*)(gw + axis * 64 + 32 + f0);
      bf16_t* dst = isk ? K : Q; const int ld = isk ? 128 : 768, coff = isk ? 0 : (pn - 2) * 256, roff = isk ? 0 : 256; const size_t hstride = isk ? (size_t)LK * 128 : 128;
#pragma unroll
      for (int ai = 0; ai < 2; ++ai)
#pragma unroll
        for (int m = 0; m < 4; ++m) { const int row = row0 + ai * 128 + m * 16, tok = row - 256;
          f32x4 cs0 = {1.f, 0.f, 1.f, 0.f}, cs1 = {1.f, 0.f, 1.f, 0.f};
          if (tok >= 0) { const int pos = axis ? (tok & 63) : (tok >> 6); const float* rp = (const float*)(rope + pos * 32 + f0); cs0 = *(const f32x4*)rp; cs1 = *(const f32x4*)(rp + 4); }
#pragma unroll
          for (int bj = 0; bj < 2; ++bj) { const f32x4 t = *(const f32x4*)(xs + (bj * 256 + ai * 128 + m * 16 + rl0) * 4);
            const float rinv = rsqrtf((t.x + t.y + t.z + t.w) * (1.f / 128.f) + EPS);
            const f32x4 av = acc[ai][bj][m][0] * rinv * g0, bv = acc[ai][bj][m][1] * rinv * g1;
            const float o00 = av.x * cs0.x - bv.x * cs0.y, o10 = bv.x * cs0.x + av.x * cs0.y;
            const float o01 = av.y * cs0.z - bv.y * cs0.w, o11 = bv.y * cs0.z + av.y * cs0.w;
            const float o02 = av.z * cs1.x - bv.z * cs1.y, o12 = bv.z * cs1.x + av.z * cs1.y;
            const float o03 = av.w * cs1.z - bv.w * cs1.w, o13 = bv.w * cs1.z + av.w * cs1.w;
            u32x4 w; w.x = pk2(o00, o01); w.y = pk2(o02, o03); w.z = pk2(o10, o11); w.w = pk2(o12, o13);
            *(u32x4*)(dst + (size_t)(row - roff) * ld + coff + bj * hstride + cl) = w; } }
    }
  }
};
struct EpiRes {
  static constexpr bool PERM = true, AFTER_DRAIN = false;
  const float* base; float* out; const float* gate;
  __device__ __forceinline__ void operator()(const f32x4 (&acc)[2][2][4][2], const Unit& u, int wr, int wc, int fr, int fq) const {
    const int row0 = u.pm * 256 + wr * 64 + fr, col0 = u.pn * 256 + wc * 32 + 8 * fq;
#pragma unroll
    for (int bj = 0; bj < 2; ++bj) { const f32x4 g0 = *(const f32x4*)(gate + col0 + bj * 128), g1 = *(const f32x4*)(gate + col0 + bj * 128 + 4);
#pragma unroll
      for (int ai = 0; ai < 2; ++ai)
#pragma unroll
        for (int m = 0; m < 4; ++m) { const size_t o = (size_t)(row0 + ai * 128 + m * 16) * 1024 + col0 + bj * 128;
          const f32x4 b0 = *(const f32x4*)(base + o), b1 = *(const f32x4*)(base + o + 4);
          *(f32x4*)(out + o) = b0 + g0 * acc[ai][bj][m][0]; *(f32x4*)(out + o + 4) = b1 + g1 * acc[ai][bj][m][1]; } }
  }
};
template <int MODE> struct EpiResNorm {
  static constexpr bool PERM = true, AFTER_DRAIN = false; static constexpr int mode = MODE;
  const float* base; float* out; const float* gate; const float* g; const float* mod; bf16_t* H; float* psq; unsigned* cnt; float* xs;
  __device__ __forceinline__ void operator()(const f32x4 (&acc)[2][2][4][2], const Unit& u, int wr, int wc, int fr, int fq) const {
    const int rl0 = wr * 64 + fr, row0 = u.pm * 256 + rl0, col0 = u.pn * 256 + wc * 32 + 8 * fq, tid = (wr * 4 + wc) * 64 + fq * 16 + fr;
#pragma unroll
    for (int ai = 0; ai < 2; ++ai)
#pragma unroll
      for (int m = 0; m < 4; ++m) { float s = 0.f;
#pragma unroll
        for (int bj = 0; bj < 2; ++bj) { int cc = col0 + bj * 128; asm volatile("" : "+v"(cc)); const size_t o = (size_t)(row0 + ai * 128 + m * 16) * 1024 + cc;
          const f32x4 x0 = *(const f32x4*)(base + o) + *(const f32x4*)(gate + cc) * acc[ai][bj][m][0], x1 = *(const f32x4*)(base + o + 4) + *(const f32x4*)(gate + cc + 4) * acc[ai][bj][m][1];
          if (mode == 2) { *(f32x4*)(out + o) = x0; *(f32x4*)(out + o + 4) = x1; }
          s += x0.x * x0.x + x0.y * x0.y + x0.z * x0.z + x0.w * x0.w + x1.x * x1.x + x1.y * x1.y + x1.z * x1.z + x1.w * x1.w; }
        s += __shfl_xor(s, 16); s += __shfl_xor(s, 32); if (fq == 0) xs[(ai * 128 + m * 16 + rl0) * 4 + wc] = s;
        __builtin_amdgcn_sched_barrier(0); }
    __syncthreads();
    if (tid < 256) { const f32x4 t = *(const f32x4*)(xs + tid * 4); psq[(size_t)(u.pm * 256 + tid) * 4 + u.pn] = (t.x + t.y) + (t.z + t.w); }
    __threadfence(); __syncthreads();
    if (tid == 0) { __hip_atomic_fetch_add(cnt + u.pm, 1u, __ATOMIC_RELAXED, __HIP_MEMORY_SCOPE_AGENT);
      for (int it = 0; it < (1 << 22) && __hip_atomic_load(cnt + u.pm, __ATOMIC_RELAXED, __HIP_MEMORY_SCOPE_AGENT) < 4u; ++it) __builtin_amdgcn_s_sleep(1);
      __threadfence(); }
    __syncthreads();
#pragma unroll
    for (int ai = 0; ai < 2; ++ai)
#pragma unroll
      for (int m = 0; m < 4; ++m) { const float* pq = psq + (size_t)(row0 + ai * 128 + m * 16) * 4;
        const float t = (__builtin_nontemporal_load(pq) + __builtin_nontemporal_load(pq + 1)) + (__builtin_nontemporal_load(pq + 2) + __builtin_nontemporal_load(pq + 3));
        const float ri = rsqrtf(t * (1.f / 1024.f) + EPS);
#pragma unroll
        for (int bj = 0; bj < 2; ++bj) { int cc = col0 + bj * 128; asm volatile("" : "+v"(cc)); const size_t o = (size_t)(row0 + ai * 128 + m * 16) * 1024 + cc;
          const f32x4 x0 = *(const f32x4*)(base + o) + *(const f32x4*)(gate + cc) * acc[ai][bj][m][0], x1 = *(const f32x4*)(base + o + 4) + *(const f32x4*)(gate + cc + 4) * acc[ai][bj][m][1];
          f32x4 y0 = x0 * ri * *(const f32x4*)(g + cc), y1 = x1 * ri * *(const f32x4*)(g + cc + 4);
          if (mode == 2) { y0 = y0 * (*(const f32x4*)(mod + 1024 + cc) + 1.f) + *(const f32x4*)(mod + cc); y1 = y1 * (*(const f32x4*)(mod + 1024 + cc + 4) + 1.f) + *(const f32x4*)(mod + cc + 4);
            u32x4 w; w.x = pk2(y0.x, y0.y); w.y = pk2(y0.z, y0.w); w.z = pk2(y1.x, y1.y); w.w = pk2(y1.z, y1.w); *(u32x4*)(H + o) = w; }
          else { *(f32x4*)(out + o) = y0; *(f32x4*)(out + o + 4) = y1; } }
        __builtin_amdgcn_sched_barrier(0); }
  }
};
struct EpiT {
  static constexpr bool PERM = true, AFTER_DRAIN = false;
  bf16_t* O; int gated;
  __device__ __forceinline__ void operator()(const f32x4 (&acc)[2][2][4][2], const Unit& u, int wr, int wc, int fr, int fq) const {
    const int row0 = u.pm * 256 + wr * 64 + fr, col0 = u.pn * 256 + wc * 32 + 8 * fq; const bool act = gated && ((u.pm >= 9 && u.pm <= 11) || u.pm == 14);
#pragma unroll
    for (int ai = 0; ai < 2; ++ai)
#pragma unroll
      for (int m = 0; m < 4; ++m) { bf16_t* p = O + (size_t)(row0 + ai * 128 + m * 16) * L + col0;
#pragma unroll
        for (int bj = 0; bj < 2; ++bj) { f32x4 v0 = acc[ai][bj][m][0], v1 = acc[ai][bj][m][1];
          if (act) { v0.x = siluf(v0.x); v0.y = siluf(v0.y); v0.z = siluf(v0.z); v0.w = siluf(v0.w); v1.x = siluf(v1.x); v1.y = siluf(v1.y); v1.z = siluf(v1.z); v1.w = siluf(v1.w); }
          u32x4 w; w.x = pk2(v0.x, v0.y); w.y = pk2(v0.z, v0.w); w.z = pk2(v1.x, v1.y); w.w = pk2(v1.z, v1.w);
          *(u32x4*)(p + bj * 128) = w; } }
  }
};
}
namespace pg8 {
template <class Epi, class Sched, bool ALIGN_EPI = false, bool SP2 = false>
__device__ __forceinline__ void gemm_phase(PG8_LAS unsigned char* lds, const Gemm g, const Sched& S, const Epi& E, int tid_in) {
    const int tid = tid_in, wid = __builtin_amdgcn_readfirstlane(tid >> 6), lane = tid & 63, wr = wid >> 2, wc = wid & 3, fr = lane & 15, fq = lane >> 4;
    const int K = g.K, nt = K / BK;
    unsigned voffA[2], voffB[2];
#pragma unroll
    for (int i = 0; i < 2; ++i) { int R, C; stage_rc(tid * 16 + i * 8192, R, C); const int Rb = Epi::PERM ? ((R & ~31) + perm32(R & 31)) : R;
        voffA[i] = (unsigned)(R * K + C) * 2u; voffB[i] = (unsigned)(Rb * K + C) * 2u; }
    const size_t kstep = (size_t)(BK * 2);
    const size_t hstep = (size_t)HALF * K * 2;
    const size_t tstep = 2 * hstep;
    const unsigned ldsw = (unsigned)wid * 1024u;
    const int aoff = lds_byte(wr * 64 + fr, fq * 8), boff = lds_byte(wc * 32 + fr, fq * 8);
#define PG8_SA(b, h) (((b) * 2 + (h)) * HTB)
#define PG8_SB(b, h) ((4 + (b) * 2 + (h)) * HTB)
#define PG8_STAGE(bufoff, gbase, voff) do { _Pragma("unroll") for (int _i = 0; _i < 2; ++_i) \
        __builtin_amdgcn_global_load_lds((const unsigned*)((const char*)(gbase) + (voff)[_i]), (PG8_LAS unsigned*)(lds + (bufoff) + ldsw + _i * 8192), 16, 0, 0); } while (0)
#define PG8_LDA(dst, b, h) do { _Pragma("unroll") for (int m = 0; m < 4; ++m) _Pragma("unroll") for (int k = 0; k < 2; ++k) dst[m][k] = *(const PG8_LAS bf16x8*)(lds + PG8_SA(b, h) + aoff + m * 2048 + k * 1024); } while (0)
#define PG8_LDB(dst, b, h) do { _Pragma("unroll") for (int n = 0; n < 2; ++n) _Pragma("unroll") for (int k = 0; k < 2; ++k) dst[n][k] = *(const PG8_LAS bf16x8*)(lds + PG8_SB(b, h) + boff + n * 2048 + k * 1024); } while (0)
#define PG8_MMA(ai, bj, At, Bt) do { __builtin_amdgcn_s_setprio(1); _Pragma("unroll") for (int m = 0; m < 4; ++m) _Pragma("unroll") for (int n = 0; n < 2; ++n) _Pragma("unroll") for (int k = 0; k < 2; ++k) \
        acc[ai][bj][m][n] = __builtin_amdgcn_mfma_f32_16x16x32_bf16(Bt[n][k], At[m][k], acc[ai][bj][m][n], 0, 0, 0); __builtin_amdgcn_s_setprio(0); } while (0)
#define PG8_WAIT_V(n) asm volatile("s_waitcnt vmcnt(" #n ")" ::: "memory")
#define PG8_WAIT_L(n) asm volatile("s_waitcnt lgkmcnt(" #n ")" ::: "memory")
#define PG8_BAR __builtin_amdgcn_s_barrier()
#define PG8_SCHED __builtin_amdgcn_sched_barrier(0)
    Unit cur, nxt; int ui = 0;
    if (!S.next(0, cur)) return;
    f32x4 acc[2][2][4][2];
#pragma unroll
    for (int a = 0; a < 2; ++a)
#pragma unroll
        for (int b = 0; b < 2; ++b)
#pragma unroll
            for (int m = 0; m < 4; ++m)
#pragma unroll
                for (int n = 0; n < 2; ++n) acc[a][b][m][n] = (f32x4){0.f, 0.f, 0.f, 0.f};
    bf16x8 At[4][2], B0[2][2], B1[2][2];
    const char* cA = (const char*)g.A + (size_t)cur.pm * tstep; const char* cB = (const char*)g.Bt + (size_t)cur.pn * tstep;
    S.a_ready(cur);
    if constexpr (SP2) {
        PG8_STAGE(PG8_SB(0, 0), cB, voffB); PG8_STAGE(PG8_SB(0, 1), cB + hstep, voffB); PG8_STAGE(PG8_SA(0, 0), cA, voffA); PG8_STAGE(PG8_SA(0, 1), cA + hstep, voffA);
        if (wr == 1) PG8_BAR;
        PG8_WAIT_V(2); PG8_BAR;
        PG8_STAGE(PG8_SB(1, 0), cB + kstep, voffB); PG8_STAGE(PG8_SA(1, 0), cA + kstep, voffA); PG8_STAGE(PG8_SB(1, 1), cB + hstep + kstep, voffB);
        PG8_WAIT_V(6); PG8_BAR;
    } else {
        PG8_STAGE(PG8_SB(0, 0), cB, voffB); PG8_STAGE(PG8_SA(0, 0), cA, voffA); PG8_STAGE(PG8_SB(0, 1), cB + hstep, voffB); PG8_STAGE(PG8_SA(0, 1), cA + hstep, voffA);
        if (wr == 1) PG8_BAR;
        PG8_WAIT_V(4); PG8_BAR;
        PG8_STAGE(PG8_SB(1, 0), cB + kstep, voffB); PG8_STAGE(PG8_SA(1, 0), cA + kstep, voffA); PG8_STAGE(PG8_SB(1, 1), cB + hstep + kstep, voffB);
        PG8_WAIT_V(6); PG8_BAR;
    }
    for (;;) {
        const bool has_next = S.next(ui + 1, nxt);
        const char* nA = has_next ? (const char*)g.A + (size_t)nxt.pm * tstep : cA; const char* nB = has_next ? (const char*)g.Bt + (size_t)nxt.pn * tstep : cB;
        for (int t = 0; t < nt; t += 2) {
            const bool last = (t == nt - 2);
            const char* a1 = cA + (size_t)(t + 1) * kstep;
            const char* a2 = last ? nA : cA + (size_t)(t + 2) * kstep; const char* b2 = last ? nB : cB + (size_t)(t + 2) * kstep;
            const char* a3 = a2 + kstep; const char* b3 = b2 + kstep;
            if (last && has_next) S.a_ready(nxt);
            if constexpr (SP2) {
            PG8_LDB(B0, 0, 0); PG8_LDB(B1, 0, 1); PG8_SCHED; PG8_LDA(At, 0, 0); PG8_STAGE(PG8_SA(1, 1), a1 + hstep, voffA);
            PG8_WAIT_V(8); PG8_WAIT_L(0); PG8_BAR; PG8_MMA(0, 0, At, B0); PG8_MMA(0, 1, At, B1); PG8_BAR; PG8_SCHED;
            PG8_LDA(At, 0, 1); PG8_STAGE(PG8_SB(0, 0), b2, voffB); PG8_STAGE(PG8_SB(0, 1), b2 + hstep, voffB); PG8_STAGE(PG8_SA(0, 0), a2, voffA);
            PG8_WAIT_V(8); PG8_WAIT_L(0); PG8_BAR; PG8_MMA(1, 0, At, B0); PG8_MMA(1, 1, At, B1); PG8_BAR; PG8_SCHED;
            PG8_LDB(B0, 1, 0); PG8_LDB(B1, 1, 1); PG8_SCHED; PG8_LDA(At, 1, 0); PG8_STAGE(PG8_SA(0, 1), a2 + hstep, voffA);
            PG8_WAIT_V(8); PG8_WAIT_L(0); PG8_BAR; PG8_MMA(0, 0, At, B0); PG8_MMA(0, 1, At, B1); PG8_BAR; PG8_SCHED;
            PG8_LDA(At, 1, 1); PG8_STAGE(PG8_SB(1, 0), b3, voffB); PG8_STAGE(PG8_SB(1, 1), b3 + hstep, voffB); PG8_STAGE(PG8_SA(1, 0), a3, voffA);
            PG8_WAIT_V(8); PG8_WAIT_L(0); PG8_BAR; PG8_MMA(1, 0, At, B0); PG8_MMA(1, 1, At, B1); PG8_BAR; PG8_SCHED;
            } else {
            PG8_LDB(B0, 0, 0); PG8_SCHED; PG8_LDA(At, 0, 0); PG8_STAGE(PG8_SA(1, 1), a1 + hstep, voffA);
            PG8_WAIT_L(8); PG8_BAR; PG8_WAIT_L(0); PG8_MMA(0, 0, At, B0); PG8_BAR; PG8_SCHED;
            PG8_LDB(B1, 0, 1); PG8_STAGE(PG8_SB(0, 0), b2, voffB);
            PG8_BAR; PG8_WAIT_L(0); PG8_MMA(0, 1, At, B1); PG8_BAR;
            PG8_LDA(At, 0, 1); PG8_STAGE(PG8_SA(0, 0), a2, voffA);
            PG8_BAR; PG8_WAIT_L(0); PG8_MMA(1, 0, At, B0); PG8_BAR; PG8_SCHED;
            PG8_STAGE(PG8_SB(0, 1), b2 + hstep, voffB);
            PG8_WAIT_V(6); PG8_BAR; PG8_MMA(1, 1, At, B1); PG8_BAR;
            PG8_LDB(B0, 1, 0); PG8_SCHED; PG8_LDA(At, 1, 0); PG8_STAGE(PG8_SA(0, 1), a2 + hstep, voffA);
            PG8_WAIT_L(8); PG8_BAR; PG8_WAIT_L(0); PG8_MMA(0, 0, At, B0); PG8_BAR; PG8_SCHED;
            PG8_LDB(B1, 1, 1); PG8_STAGE(PG8_SB(1, 0), b3, voffB);
            PG8_BAR; PG8_WAIT_L(0); PG8_MMA(0, 1, At, B1); PG8_BAR;
            PG8_LDA(At, 1, 1); PG8_STAGE(PG8_SA(1, 0), a3, voffA);
            PG8_BAR; PG8_WAIT_L(0); PG8_MMA(1, 0, At, B0); PG8_BAR; PG8_SCHED;
            PG8_STAGE(PG8_SB(1, 1), b3 + hstep, voffB);
            PG8_WAIT_V(6); PG8_BAR; PG8_MMA(1, 1, At, B1); PG8_BAR;
            }
        }
        if constexpr (ALIGN_EPI) { if (wr == 0) PG8_BAR; }
        if constexpr (!Epi::AFTER_DRAIN) { E(acc, cur, wr, wc, fr, fq); S.done(cur); }
        if (!has_next) break;
#pragma unroll
        for (int a = 0; a < 2; ++a)
#pragma unroll
            for (int b = 0; b < 2; ++b)
#pragma unroll
                for (int m = 0; m < 4; ++m)
#pragma unroll
                    for (int n = 0; n < 2; ++n) acc[a][b][m][n] = (f32x4){0.f, 0.f, 0.f, 0.f};
        cur = nxt; cA = nA; cB = nB; ++ui;
        if constexpr (ALIGN_EPI) { if (wr == 1) PG8_BAR; }
    }
    PG8_WAIT_V(0);
    if constexpr (!ALIGN_EPI) { if (wr == 0) PG8_BAR; }
    PG8_BAR;
    if constexpr (Epi::AFTER_DRAIN) { E.fused(acc, cur, wr, wc, fr, fq, lds, wid, lane); S.done(cur); }
#undef PG8_SA
#undef PG8_SB
#undef PG8_STAGE
#undef PG8_LDA
#undef PG8_LDB
#undef PG8_MMA
#undef PG8_WAIT_V
#undef PG8_WAIT_L
#undef PG8_BAR
#undef PG8_SCHED
}
}

namespace attn {
using bf16 = __hip_bfloat16;
constexpr int   D = 128, NW = 8, QBLK = 32, KVBLK = 64;
constexpr float SCALE = 0.088388347648318440f;
constexpr float THR = 8.f;
constexpr int SDEPTH = 2;
constexpr int LDQ = 768, LDK = 128, LDO = 1024, LDG = 768;
constexpr size_t SHM_V = KVBLK * D * 2, SHM_K = KVBLK * D * 2, SHM_ATTN = 2 * SHM_V + 2 * SHM_K + NW * 64 * 4;
using bf16x8 = __attribute__((ext_vector_type(8))) short;
using s16x4  = __attribute__((ext_vector_type(4))) short;
using f32x16 = __attribute__((ext_vector_type(16))) float;
using f32x8  = __attribute__((ext_vector_type(8))) float;
using u32x4  = __attribute__((ext_vector_type(4))) unsigned;
#define KSWZ(row, colB) ((row) * 256 + ((colB) ^ (((row) & 7) << 4)))
#define SBAR() __builtin_amdgcn_sched_barrier(0)
__device__ __forceinline__ int crow(int r, int hi) { return (r & 3) + 8 * (r >> 2) + 4 * hi; }
__device__ __forceinline__ unsigned cvtpk(float lo, float hi) {
  unsigned r; asm volatile("v_cvt_pk_bf16_f32 %0, %1, %2" : "=v"(r) : "v"(lo), "v"(hi)); return r;
}
template <typename TIn> struct Stage;
template <> struct Stage<bf16>  { using T = bf16x8;
  __device__ static __forceinline__ T ld8(const bf16* p) { return *reinterpret_cast<const bf16x8*>(p); }
  __device__ static __forceinline__ bf16x8 tobf(T x) { return x; } };
template <> struct Stage<float> { using T = f32x8;
  __device__ static __forceinline__ T ld8(const float* p) { return *reinterpret_cast<const f32x8*>(p); }
  __device__ static __forceinline__ bf16x8 tobf(T x) {
    u32x4 w = {cvtpk(x[0], x[1]), cvtpk(x[2], x[3]), cvtpk(x[4], x[5]), cvtpk(x[6], x[7])}; return *reinterpret_cast<bf16x8*>(&w); } };

__device__ __forceinline__ void partialSM(f32x16& p0, f32x16& p1, float& m_reg, float& mn, float& alpha) {
  constexpr float C = SCALE * 1.4426950408889634f;
  float pmax = p0[0]; for (int r = 1; r < 16; ++r) pmax = fmaxf(pmax, p0[r]); for (int r = 0; r < 16; ++r) pmax = fmaxf(pmax, p1[r]);
  { auto rr = __builtin_amdgcn_permlane32_swap(__float_as_uint(pmax), __float_as_uint(pmax), false, false);
    pmax = fmaxf(__uint_as_float(rr[0]), __uint_as_float(rr[1])); }
  if (__builtin_expect(__all(pmax - m_reg <= THR / SCALE), 1)) { mn = m_reg; alpha = 1.f; }
  else { mn = fmaxf(m_reg, pmax); alpha = __builtin_amdgcn_exp2f((m_reg - mn) * C); m_reg = mn; }
  float mnC = -mn * C;
  for (int r = 0; r < 16; ++r) p0[r] = fmaf(p0[r], C, mnC); for (int r = 0; r < 16; ++r) p1[r] = fmaf(p1[r], C, mnC);
  for (int r = 0; r < 16; ++r) p0[r] = __builtin_amdgcn_exp2f(p0[r]);
}
__device__ __forceinline__ void finishSM(f32x16& p0, f32x16& p1, float alpha, float& l_reg, bf16x8& pa0, bf16x8& pa1, bf16x8& pa2, bf16x8& pa3) {
  for (int r = 0; r < 16; ++r) p1[r] = __builtin_amdgcn_exp2f(p1[r]);
  float ps = 0; for (int r = 0; r < 16; ++r) ps += p0[r]; for (int r = 0; r < 16; ++r) ps += p1[r];
  { auto rr = __builtin_amdgcn_permlane32_swap(__float_as_uint(ps), __float_as_uint(ps), false, false);
    ps = __uint_as_float(rr[0]) + __uint_as_float(rr[1]); }
  l_reg = l_reg * alpha + ps;
#define PK4(P, BASE, OUT) do { unsigned a0 = cvtpk(P[BASE + 0], P[BASE + 1]), a1 = cvtpk(P[BASE + 2], P[BASE + 3]);   \
    unsigned b0 = cvtpk(P[BASE + 4], P[BASE + 5]), b1 = cvtpk(P[BASE + 6], P[BASE + 7]);                              \
    auto r0 = __builtin_amdgcn_permlane32_swap(a0, b0, false, false); auto r1 = __builtin_amdgcn_permlane32_swap(a1, b1, false, false); \
    u32x4 w = {r0[0], r1[0], r0[1], r1[1]}; OUT = *reinterpret_cast<bf16x8*>(&w); } while (0)
  PK4(p0, 0, pa0); PK4(p0, 8, pa1); PK4(p1, 0, pa2); PK4(p1, 8, pa3);
#undef PK4
}
__device__ __forceinline__ void qkt(f32x16& p0, f32x16& p1, const bf16* Ks, const bf16x8* qr, int r32, int hi) {
  p0 = f32x16{}; p1 = f32x16{};
  for (int d0 = 0; d0 < 8; ++d0) { int cb = (d0 * 16 + hi * 8) * 2;
    bf16x8 b0 = *reinterpret_cast<const bf16x8*>((const char*)Ks + KSWZ(r32, cb));
    bf16x8 b1 = *reinterpret_cast<const bf16x8*>((const char*)Ks + KSWZ(32 + r32, cb));
    p0 = __builtin_amdgcn_mfma_f32_32x32x16_bf16(b0, qr[d0], p0, 0, 0, 0);
    p1 = __builtin_amdgcn_mfma_f32_32x32x16_bf16(b1, qr[d0], p1, 0, 0, 0); }
}
__device__ __forceinline__ int v_st(int k, int c) { const int kk = (k & ~0xC) | ((k & 4) << 1) | ((k & 8) >> 1); return ((kk >> 3) * 4 + (c >> 5)) * 512 + ((kk & 7) * 32 + (c & 31)) * 2; }
__device__ __forceinline__ int v_rd_base(int lane) { return ((lane & 3) << 3) | (((lane >> 2) & 3) << 6) | (((lane >> 4) & 1) << 5) | (((lane >> 5) & 1) << 8); }
constexpr int v_rd_off(int d0, int ks, int half) { return d0 * 512 + ks * 4096 + half * 2048; }
template <int OFF> __device__ __forceinline__ s16x4 tr_read(int vb) {
  s16x4 r; asm volatile("ds_read_b64_tr_b16 %0, %1 offset:%2" : "=&v"(r) : "v"(vb), "i"(OFF) : "memory"); return r;
}
template <int D0> __device__ __forceinline__ void pv_one(f32x16& od, int vb, bf16x8 pa0, bf16x8 pa1, bf16x8 pa2, bf16x8 pa3) {
  const s16x4 l0 = tr_read<v_rd_off(D0, 0, 0)>(vb), h0 = tr_read<v_rd_off(D0, 0, 1)>(vb), l1 = tr_read<v_rd_off(D0, 1, 0)>(vb), h1 = tr_read<v_rd_off(D0, 1, 1)>(vb);
  const s16x4 l2 = tr_read<v_rd_off(D0, 2, 0)>(vb), h2 = tr_read<v_rd_off(D0, 2, 1)>(vb), l3 = tr_read<v_rd_off(D0, 3, 0)>(vb), h3 = tr_read<v_rd_off(D0, 3, 1)>(vb);
  asm volatile("s_waitcnt lgkmcnt(0)" ::: "memory"); SBAR();
#define PK(L, H) (bf16x8){L[0], L[1], L[2], L[3], H[0], H[1], H[2], H[3]}
  od = __builtin_amdgcn_mfma_f32_32x32x16_bf16(pa0, PK(l0, h0), od, 0, 0, 0);
  od = __builtin_amdgcn_mfma_f32_32x32x16_bf16(pa1, PK(l1, h1), od, 0, 0, 0);
  od = __builtin_amdgcn_mfma_f32_32x32x16_bf16(pa2, PK(l2, h2), od, 0, 0, 0);
  od = __builtin_amdgcn_mfma_f32_32x32x16_bf16(pa3, PK(l3, h3), od, 0, 0, 0);
#undef PK
}
__device__ __forceinline__ void pv_d0(f32x16* o, int vb, bf16x8 pa0, bf16x8 pa1, bf16x8 pa2, bf16x8 pa3) {
  pv_one<0>(o[0], vb, pa0, pa1, pa2, pa3); pv_one<1>(o[1], vb, pa0, pa1, pa2, pa3); pv_one<2>(o[2], vb, pa0, pa1, pa2, pa3); pv_one<3>(o[3], vb, pa0, pa1, pa2, pa3);
}

template <bool PARTIAL>
__device__ __forceinline__ void attn_dense_body(const bf16* __restrict__ Qb, const bf16* __restrict__ Kh, const bf16* __restrict__ Vh,
                                                const bf16_t* __restrict__ Gb, bf16_t* __restrict__ Ob, int seq, char* lds,
                                                float* Pself, const float* Pother, unsigned* cnt, int tid_) {
  using TQ = bf16;
  using St = Stage<bf16>; using SQ = Stage<TQ>;
  asm volatile("" : "+v"(tid_));
  const int tid = tid_, wid = tid >> 6, lane = tid & 63, r32 = lane & 31, hi = lane >> 5;
  bf16* V_lds = (bf16*)lds; bf16* K_lds = (bf16*)(lds + 2 * SHM_V);
  float* ws = (float*)(lds + 2 * SHM_V + 2 * SHM_K) + wid * 64; float* li_l = ws; float* al_l = ws + 32;
  float m_reg = -1e30f, l_reg = 0; f32x16 o[4] = {}; bf16x8 qr[8];
  const TQ* Qw = Qb + (long)(wid * QBLK + r32) * LDQ + hi * 8;
#pragma unroll
  for (int d0 = 0; d0 < 8; ++d0) qr[d0] = SQ::tobf(SQ::ld8(Qw + d0 * 16));
  const int sr = tid >> 4, sc = (tid & 15) * 8, vst0 = v_st(sr, sc), vst1 = v_st(32 + sr, sc);
  const int vb0 = (int)(uintptr_t)V_lds + v_rd_base(lane);
  struct { typename St::T vs0, vs1, ks0, ks1; } sr_[SDEPTH];
  const unsigned so0 = (unsigned)(sr * LDK + sc), so1 = (unsigned)((32 + sr) * LDK + sc);
#define SLOAD(i, k0) do { const bf16* Vt_ = Vh + (long)(k0) * LDK; const bf16* Kt_ = Kh + (long)(k0) * LDK; \
    sr_[i].vs0 = St::ld8(Vt_ + so0); sr_[i].vs1 = St::ld8(Vt_ + so1); sr_[i].ks0 = St::ld8(Kt_ + so0); sr_[i].ks1 = St::ld8(Kt_ + so1); } while (0)
#define SWRITE(b, i) do { *(bf16x8*)((char*)V_lds + (b) * SHM_V + vst0) = St::tobf(sr_[i].vs0);          \
    *(bf16x8*)((char*)V_lds + (b) * SHM_V + vst1) = St::tobf(sr_[i].vs1); int kc = sc * 2;               \
    *(bf16x8*)((char*)K_lds + (b) * SHM_K + KSWZ(sr, kc)) = St::tobf(sr_[i].ks0);                       \
    *(bf16x8*)((char*)K_lds + (b) * SHM_K + KSWZ(32 + sr, kc)) = St::tobf(sr_[i].ks1); } while (0)
#define SWAIT() do { if constexpr (SDEPTH == 2) asm volatile("s_waitcnt vmcnt(4)" ::: "memory"); else asm volatile("s_waitcnt vmcnt(0)" ::: "memory"); } while (0)
#define RESC(a) do { if (__any((a) < 1.f)) { if (hi == 0) al_l[r32] = (a); asm volatile("s_waitcnt lgkmcnt(0)" ::: "memory"); \
    for (int d = 0; d < 4; ++d) for (int r = 0; r < 16; ++r) o[d][r] *= al_l[crow(r, hi)]; } } while (0)
  f32x16 pA0, pA1, pB0, pB1; float mnA, mnB, alA, alB; bf16x8 pa0, pa1, pa2, pa3; const int NT = seq / KVBLK;
  constexpr int SE = 0, SO = SDEPTH - 1;
  SLOAD(SE, 0); asm volatile("s_waitcnt vmcnt(0)" ::: "memory"); SWRITE(0, SE); __syncthreads();
  qkt(pA0, pA1, K_lds, qr, r32, hi); partialSM(pA0, pA1, m_reg, mnA, alA);
  SLOAD(SO, KVBLK); if constexpr (SDEPTH == 2) { if (2 < NT) SLOAD(SE, 2 * KVBLK); }
  SWAIT(); SWRITE(1, SO); __syncthreads();
  for (int j = 1; j + 1 < NT; j += 2) {
    SBAR(); qkt(pB0, pB1, (bf16*)((char*)K_lds + SHM_K), qr, r32, hi);
    finishSM(pA0, pA1, alA, l_reg, pa0, pa1, pa2, pa3); SBAR();
    SLOAD(SO, (j + SDEPTH) * KVBLK); SBAR();
    pv_d0(o, vb0, pa0, pa1, pa2, pa3); partialSM(pB0, pB1, m_reg, mnB, alB);
    __syncthreads(); SWAIT(); SWRITE(0, SE);
    RESC(alB); __syncthreads();
    SBAR(); qkt(pA0, pA1, K_lds, qr, r32, hi);
    finishSM(pB0, pB1, alB, l_reg, pa0, pa1, pa2, pa3); SBAR();
    if (SDEPTH == 1 || j + 3 < NT) SLOAD(SE, (j + 1 + SDEPTH) * KVBLK); SBAR();
    pv_d0(o, vb0 + (int)SHM_V, pa0, pa1, pa2, pa3); partialSM(pA0, pA1, m_reg, mnA, alA);
    __syncthreads(); SWAIT(); SWRITE(1, SO);
    RESC(alA); __syncthreads();
  }
  SBAR(); qkt(pB0, pB1, (bf16*)((char*)K_lds + SHM_K), qr, r32, hi);
  finishSM(pA0, pA1, alA, l_reg, pa0, pa1, pa2, pa3); SBAR();
  pv_d0(o, vb0, pa0, pa1, pa2, pa3); partialSM(pB0, pB1, m_reg, mnB, alB);
  __syncthreads(); RESC(alB);
  finishSM(pB0, pB1, alB, l_reg, pa0, pa1, pa2, pa3); SBAR();
  pv_d0(o, vb0 + (int)SHM_V, pa0, pa1, pa2, pa3);
  if constexpr (!PARTIAL) {
  if (hi == 0) li_l[r32] = l_reg; asm volatile("s_waitcnt lgkmcnt(0)" ::: "memory");
  float rli[16];
#pragma unroll
  for (int r = 0; r < 16; ++r) rli[r] = __builtin_amdgcn_rcpf(li_l[crow(r, hi)]);
  const bf16_t* Gw = Gb + (long)(wid * QBLK) * LDG; bf16_t* Ow = Ob + (long)(wid * QBLK) * LDO;
#pragma unroll
  for (int r = 0; r < 16; ++r) { int orow = crow(r, hi);
    for (int d0 = 0; d0 < 4; ++d0) { const float gt = bf2f(Gw[(long)orow * LDG + d0 * 32 + r32]); Ow[(long)orow * LDO + d0 * 32 + r32] = (bf16_t)f2bf(o[d0][r] * rli[r] * gt); }
    if ((r & 3) == 3) __builtin_amdgcn_sched_barrier(0); }
  } else {
    constexpr float C = SCALE * 1.4426950408889634f;
    { float* Pw = Pself + (long)(wid * QBLK) * 128;
#pragma unroll
      for (int r = 0; r < 16; ++r) { const int orow = crow(r, hi);
        for (int d0 = 0; d0 < 4; ++d0) Pw[orow * 128 + d0 * 32 + r32] = o[d0][r];
        if ((r & 3) == 3) __builtin_amdgcn_sched_barrier(0); }
      if (hi == 0) { Pself[256 * 128 + wid * QBLK + r32] = m_reg; Pself[256 * 128 + 256 + wid * QBLK + r32] = l_reg; } }
    __threadfence(); __syncthreads();
    volatile unsigned* flag = (volatile unsigned*)(lds + SHM_ATTN);
    if (tid == 0) *flag = atomicAdd(cnt, 1u);
    __syncthreads();
    if (*flag == 1u) {
      __threadfence();
      const float m2 = __builtin_nontemporal_load(Pother + 256 * 128 + wid * QBLK + r32), l2 = __builtin_nontemporal_load(Pother + 256 * 128 + 256 + wid * QBLK + r32);
      const float M = fmaxf(m_reg, m2), a1 = __builtin_amdgcn_exp2f((m_reg - M) * C), a2 = __builtin_amdgcn_exp2f((m2 - M) * C), inv = __builtin_amdgcn_rcpf(l_reg * a1 + l2 * a2);
      if (hi == 0) { li_l[r32] = a1 * inv; al_l[r32] = a2 * inv; } asm volatile("s_waitcnt lgkmcnt(0)" ::: "memory");
      const float* Po = Pother + (long)(wid * QBLK) * 128; const bf16_t* Gw = Gb + (long)(wid * QBLK) * LDG; bf16_t* Ow = Ob + (long)(wid * QBLK) * LDO;
#pragma unroll
      for (int r = 0; r < 16; ++r) { const int orow = crow(r, hi); const float w1 = li_l[orow], w2 = al_l[orow];
        for (int d0 = 0; d0 < 4; ++d0) { const float gt = bf2f(Gw[(long)orow * LDG + d0 * 32 + r32]); const float ov = __builtin_nontemporal_load(Po + orow * 128 + d0 * 32 + r32);
          Ow[(long)orow * LDO + d0 * 32 + r32] = (bf16_t)f2bf((o[d0][r] * w1 + ov * w2) * gt); }
        if ((r & 3) == 3) __builtin_amdgcn_sched_barrier(0); }
    }
    __syncthreads();
  }
#undef SLOAD
#undef SWRITE
#undef SWAIT
#undef RESC
}

#undef KSWZ
#undef SBAR
}

__device__ __forceinline__ void pool_phase(const float* __restrict__ AV, const bf16_t* __restrict__ AG, bf16_t* __restrict__ MIX, unsigned* ctr, volatile unsigned* slot, int tid) {
  const int c4 = (tid & 63) * 4, tg = tid >> 6, w2 = 1 << (c4 >> 6);
  for (;;) {
    __syncthreads();
    if (tid == 0) *slot = atomicAdd(ctr, 1u);
    __syncthreads();
    const int item = (int)*slot;
    if (item >= L / 32) break;
#pragma unroll 1
    for (int q = 0; q < 4; ++q) { const int t = item * 32 + tg * 4 + q;
      const int lo = max(t - w2, 0), hi = min(t + w2, L);
      f32x4 s = {0.f, 0.f, 0.f, 0.f};
      for (int u = lo; u < hi; ++u) s += *(const f32x4*)(AV + (size_t)u * 256 + c4);
      const f32x4 me = *(const f32x4*)(AV + (size_t)t * 256 + c4); const float ic = 1.f / (float)(hi - lo);
      const u32x2 gw = *(const u32x2*)(AG + (size_t)t * 256 + c4);
      const float g0 = __uint_as_float(gw.x << 16), g1 = __uint_as_float(gw.x & 0xffff0000u), g2 = __uint_as_float(gw.y << 16), g3 = __uint_as_float(gw.y & 0xffff0000u);
      u32x2 w; w.x = pk2((s.x * ic - me.x) * g0, (s.y * ic - me.y) * g1); w.y = pk2((s.z * ic - me.z) * g2, (s.w * ic - me.w) * g3);
      *(u32x2*)(MIX + (size_t)t * 1024 + c4) = w; }
  }
}

__device__ __forceinline__ void prep_queue(const Args& a, unsigned* ctr, volatile unsigned* slot, float* lds, int tid) {
  for (;;) {
    __syncthreads();
    if (tid == 0) *slot = atomicAdd(ctr, 1u);
    __syncthreads();
    int item = (int)*slot;
    if (item < 128) { fold_item(a, item, lds, tid); continue; }
    item -= 128;
    if (item >= prep::N_LATE) break;
    prep_item(a, prep::late_item(item), lds, tid);
  }
}

#define PADI(i) ((i) + ((i) >> 5))
__device__ __forceinline__ float2 cadd(float2 a, float2 b) { return make_float2(a.x + b.x, a.y + b.y); }
__device__ __forceinline__ float2 csub(float2 a, float2 b) { return make_float2(a.x - b.x, a.y - b.y); }
__device__ __forceinline__ float2 cmul(float2 a, float2 b) { return make_float2(a.x * b.x - a.y * b.y, a.x * b.y + a.y * b.x); }
__device__ constexpr float W32C[16] = {1.f, 0.98078528040323043f, 0.92387953251128674f, 0.83146961230254524f, 0.70710678118654752f, 0.55557023301960218f, 0.38268343236508977f, 0.19509032201612825f,
                                       0.f, -0.19509032201612825f, -0.38268343236508977f, -0.55557023301960218f, -0.70710678118654752f, -0.83146961230254524f, -0.92387953251128674f, -0.98078528040323043f};
__device__ constexpr float W32S[16] = {0.f, 0.19509032201612825f, 0.38268343236508977f, 0.55557023301960218f, 0.70710678118654752f, 0.83146961230254524f, 0.92387953251128674f, 0.98078528040323043f,
                                       1.f, 0.98078528040323043f, 0.92387953251128674f, 0.83146961230254524f, 0.70710678118654752f, 0.55557023301960218f, 0.38268343236508977f, 0.19509032201612825f};
template <int S, bool INV>
__device__ __forceinline__ void fft_pass8(float2* cb, const float2* twL, int tid) {
  static_assert(S % 32 == 0, "constant LDS offsets need S % 32 == 0");
  constexpr float R = 0.70710678118654752f;
  constexpr int ES = S + S / 32;
#pragma unroll 2
  for (int it = 0; it < 4; ++it) {
    const int u = it * 512 + tid, j = u & (S - 1), base = ((u & ~(S - 1)) << 3) + j;
    float2* p = cb + PADI(base);
    float2 x[8];
#pragma unroll
    for (int e = 0; e < 8; ++e) x[e] = p[e * ES];
    float2 t1 = twL[j * (2048 / S)]; if (INV) t1.y = -t1.y;
    const float2 t2 = cmul(t1, t1), t3 = cmul(t2, t2);
    float2 w8[4]; w8[0] = t1;
    if (!INV) { w8[1] = cmul(t1, make_float2(R, -R)); w8[2] = make_float2(t1.y, -t1.x); w8[3] = cmul(t1, make_float2(-R, -R)); }
    else      { w8[1] = cmul(t1, make_float2(R, R));  w8[2] = make_float2(-t1.y, t1.x); w8[3] = cmul(t1, make_float2(-R, R)); }
    float2 w4[2]; w4[0] = t2; w4[1] = INV ? make_float2(-t2.y, t2.x) : make_float2(t2.y, -t2.x);
    if (!INV) {
#pragma unroll
      for (int e = 0; e < 4; ++e) { const float2 a = x[e], c = x[e + 4]; x[e] = cadd(a, c); x[e + 4] = cmul(csub(a, c), w8[e]); }
#pragma unroll
      for (int q = 0; q < 8; q += 4)
#pragma unroll
        for (int e = 0; e < 2; ++e) { const float2 a = x[q + e], c = x[q + e + 2]; x[q + e] = cadd(a, c); x[q + e + 2] = cmul(csub(a, c), w4[e]); }
#pragma unroll
      for (int q = 0; q < 8; q += 2) { const float2 a = x[q], c = x[q + 1]; x[q] = cadd(a, c); x[q + 1] = cmul(csub(a, c), t3); }
    } else {
#pragma unroll
      for (int q = 0; q < 8; q += 2) { const float2 a = x[q], c = cmul(x[q + 1], t3); x[q] = cadd(a, c); x[q + 1] = csub(a, c); }
#pragma unroll
      for (int q = 0; q < 8; q += 4)
#pragma unroll
        for (int e = 0; e < 2; ++e) { const float2 a = x[q + e], c = cmul(x[q + e + 2], w4[e]); x[q + e] = cadd(a, c); x[q + e + 2] = csub(a, c); }
#pragma unroll
      for (int e = 0; e < 4; ++e) { const float2 a = x[e], c = cmul(x[e + 4], w8[e]); x[e] = cadd(a, c); x[e + 4] = csub(a, c); }
    }
#pragma unroll
    for (int e = 0; e < 8; ++e) p[e * ES] = x[e];
  }
  __syncthreads();
}
template <bool INV>
__device__ __forceinline__ void fft_pass32(float2* cb, int tid) {
  float2* p = cb + 33 * tid;
  float2 x[32];
#pragma unroll
  for (int e = 0; e < 32; ++e) x[e] = p[e];
  if (!INV) {
#pragma unroll
    for (int h = 16; h >= 1; h >>= 1)
#pragma unroll
      for (int b = 0; b < 32; b += 2 * h)
#pragma unroll
        for (int q = 0; q < h; ++q) { const float2 a = x[b + q], c = x[b + q + h], d = csub(a, c); x[b + q] = cadd(a, c);
          const int k = q * (16 / h);
          if (k == 0) x[b + q + h] = d; else if (k == 8) x[b + q + h] = make_float2(d.y, -d.x); else x[b + q + h] = cmul(d, make_float2(W32C[k], -W32S[k])); }
  } else {
#pragma unroll
    for (int h = 1; h <= 16; h <<= 1)
#pragma unroll
      for (int b = 0; b < 32; b += 2 * h)
#pragma unroll
        for (int q = 0; q < h; ++q) { const float2 a = x[b + q], c0 = x[b + q + h]; float2 c;
          const int k = q * (16 / h);
          if (k == 0) c = c0; else if (k == 8) c = make_float2(-c0.y, c0.x); else c = cmul(c0, make_float2(W32C[k], W32S[k]));
          x[b + q] = cadd(a, c); x[b + q + h] = csub(a, c); }
  }
#pragma unroll
  for (int e = 0; e < 32; ++e) p[e] = x[e];
  __syncthreads();
}
__device__ __forceinline__ void fft_fwd(float2* cb, const float2* twL, int tid) {
  fft_pass8<2048, false>(cb, twL, tid); fft_pass8<256, false>(cb, twL, tid); fft_pass8<32, false>(cb, twL, tid); fft_pass32<false>(cb, tid);
}
__device__ __forceinline__ void fft_inv(float2* cb, const float2* twL, int tid) {
  fft_pass32<true>(cb, tid); fft_pass8<32, true>(cb, twL, tid); fft_pass8<256, true>(cb, twL, tid); fft_pass8<2048, true>(cb, twL, tid);
}
template <bool ODD>
__device__ __forceinline__ void fft_pointwise(float2* cb, int tid) {
#pragma unroll 1
  for (int j = 0; j < (ODD ? 16 : 32); ++j) {
    const int p = j * 512 + tid;
    int pp;
    if (ODD) pp = 16383 - p; else pp = (p < 2) ? p : (p ^ ((1 << (31 - __clz(p))) - 1));
    if (p <= pp) {
      const float2 C = cb[PADI(p)], C2 = cb[PADI(pp)];
      const float2 Z = make_float2(0.5f * (C.x + C2.x), 0.5f * (C.y - C2.y)), K = make_float2(0.5f * (C.y + C2.y), -0.5f * (C.x - C2.x));
      const float2 Y = cmul(Z, K);
      cb[PADI(p)] = Y; cb[PADI(pp)] = make_float2(Y.x, -Y.y);
    }
  }
  __syncthreads();
}
__device__ __forceinline__ float conv3_at(const bf16_t* __restrict__ row, int t, float w0, float w1, float w2, float b) {
  const unsigned tm = (unsigned)max(t - 1, 0), tp = (unsigned)min(t + 1, L - 1); float um = bf2f(row[tm]), up = bf2f(row[tp]); const float u0 = bf2f(row[(unsigned)t]);
  um = t > 0 ? um : 0.f; up = t < L - 1 ? up : 0.f;
  return w0 * um + w1 * u0 + w2 * up + b;
}


namespace mf {
typedef short bf16x8 __attribute__((ext_vector_type(8)));
typedef short bf16x4 __attribute__((ext_vector_type(4)));
constexpr int RS = 272, PL = 128 * RS;
constexpr int O_DRE = 0, O_DIM = PL, O_FRE = 2 * PL, O_FIM = 3 * PL, O_TWA = 4 * PL, O_TWB = 4 * PL + 1024, O_RED = 4 * PL + 2048;
__device__ __forceinline__ bf16x4 tr_rd(unsigned addr) { bf16x4 r; asm volatile("ds_read_b64_tr_b16 %0, %1" : "=&v"(r) : "v"(addr) : "memory"); return r; }
__device__ __forceinline__ bf16x8 negv(bf16x8 v) { u32x4 t = __builtin_bit_cast(u32x4, v); t.x ^= 0x80008000u; t.y ^= 0x80008000u; t.z ^= 0x80008000u; t.w ^= 0x80008000u; return __builtin_bit_cast(bf16x8, t); }
__device__ __forceinline__ bf16x8 cat(bf16x4 a, bf16x4 b) { return (bf16x8){a[0], a[1], a[2], a[3], b[0], b[1], b[2], b[3]}; }
__device__ __forceinline__ float2 twid(const char* lds, int idx, bool inv) {
  const float2 ta = ((const float2*)(lds + O_TWA))[idx >> 7], tb = ((const float2*)(lds + O_TWB))[idx & 127];
  float2 w = make_float2(ta.x * tb.x - ta.y * tb.y, ta.x * tb.y + ta.y * tb.x); if (inv) w.y = -w.y; return w;
}
template <bool INV, bool TW, int OUT>
__device__ __forceinline__ void dft_cols(char* lds, const float2* __restrict__ TW2, int tid) {
  const int lane = tid & 63, w = tid >> 6, g = lane >> 4, n16 = lane & 15, q = n16 >> 2, p = lane & 3;
  const unsigned base = (unsigned)(uintptr_t)lds;
  bf16x8 bre[4], bim[4];
  { bf16x4 t0[4], t1[4], u0[4], u1[4];
#pragma unroll
    for (int ks = 0; ks < 4; ++ks) { const unsigned a0 = base + RS * (32 * ks + 8 * g + q) + 16 * (2 * w + (p >> 1)) + 8 * (p & 1), a1 = a0 + 4 * RS;
      t0[ks] = tr_rd(a0 + O_DRE); t1[ks] = tr_rd(a1 + O_DRE); u0[ks] = tr_rd(a0 + O_DIM); u1[ks] = tr_rd(a1 + O_DIM); }
    asm volatile("s_waitcnt lgkmcnt(0)" ::: "memory"); __builtin_amdgcn_sched_barrier(0);
#pragma unroll
    for (int ks = 0; ks < 4; ++ks) { bre[ks] = cat(t0[ks], t1[ks]); bim[ks] = cat(u0[ks], u1[ks]); } }
  if (OUT != 0) __syncthreads();
  bf16x8 x2[4], x3[4];
#pragma unroll
  for (int ks = 0; ks < 4; ++ks) { x2[ks] = INV ? bim[ks] : negv(bim[ks]); x3[ks] = INV ? negv(bre[ks]) : bre[ks]; }
#pragma unroll 2
  for (int rb = 0; rb < 8; ++rb) {
    f32x4 dre = {0.f, 0.f, 0.f, 0.f}, dim = {0.f, 0.f, 0.f, 0.f};
    const char* fr = lds + O_FRE + RS * (n16 + 16 * rb) + 16 * g; const char* fi = fr + PL;
#pragma unroll
    for (int ks = 0; ks < 4; ++ks) { const bf16x8 afr = *(const bf16x8*)(fr + 64 * ks), afi = *(const bf16x8*)(fi + 64 * ks);
      dre = __builtin_amdgcn_mfma_f32_16x16x32_bf16(bre[ks], afr, dre, 0, 0, 0); dre = __builtin_amdgcn_mfma_f32_16x16x32_bf16(x2[ks], afi, dre, 0, 0, 0);
      if (OUT != 1) { dim = __builtin_amdgcn_mfma_f32_16x16x32_bf16(bim[ks], afr, dim, 0, 0, 0); dim = __builtin_amdgcn_mfma_f32_16x16x32_bf16(x3[ks], afi, dim, 0, 0, 0); } }
    const int row = 16 * rb + n16, c0 = 16 * w + 4 * g;
    float vr[4], vi[4];
#pragma unroll
    for (int r = 0; r < 4; ++r) { vr[r] = dre[r]; vi[r] = dim[r];
      if (TW) { const float2 t = twid(lds, row * (c0 + r), INV); const float a = vr[r] * t.x - vi[r] * t.y, b = vr[r] * t.y + vi[r] * t.x; vr[r] = a; vi[r] = b; } }
    if (OUT == 0) { u32x2 wr_, wi_; wr_.x = pk2(vr[0], vr[1]); wr_.y = pk2(vr[2], vr[3]); wi_.x = pk2(vi[0], vi[1]); wi_.y = pk2(vi[2], vi[3]);
      *(u32x2*)(lds + O_DRE + RS * row + 2 * c0) = wr_; *(u32x2*)(lds + O_DIM + RS * row + 2 * c0) = wi_; }
    else if (OUT == 1) { *(f32x4*)((float*)lds + 128 * row + c0) = (f32x4){vr[0], vr[1], vr[2], vr[3]}; }
    else { const f32x4 ta = *(const f32x4*)(TW2 + 128 * row + c0), tb = *(const f32x4*)(TW2 + 128 * row + c0 + 2);
      *(f32x4*)((float*)lds + 128 * row + c0) = (f32x4){vr[0] * ta.x + vi[0] * ta.y, vr[1] * ta.z + vi[1] * ta.w, vr[2] * tb.x + vi[2] * tb.y, vr[3] * tb.z + vi[3] * tb.w}; }
  }
  __syncthreads();
}
template <bool INV, bool TW>
__device__ __forceinline__ void dft_rows(char* lds, int tid) {
  const int lane = tid & 63, w = tid >> 6, g = lane >> 4, n16 = lane & 15;
  bf16x8 are[4], aim[4], x2[4], x3[4];
  { const char* pr = lds + O_DRE + RS * (n16 + 16 * w) + 16 * g; const char* pi = pr + PL;
#pragma unroll
    for (int ks = 0; ks < 4; ++ks) { are[ks] = *(const bf16x8*)(pr + 64 * ks); aim[ks] = *(const bf16x8*)(pi + 64 * ks); x2[ks] = INV ? aim[ks] : negv(aim[ks]); x3[ks] = INV ? negv(are[ks]) : are[ks]; } }
#pragma unroll 2
  for (int cbk = 0; cbk < 8; ++cbk) {
    f32x4 dre = {0.f, 0.f, 0.f, 0.f}, dim = {0.f, 0.f, 0.f, 0.f};
    const char* fr = lds + O_FRE + RS * (n16 + 16 * cbk) + 16 * g; const char* fi = fr + PL;
#pragma unroll
    for (int ks = 0; ks < 4; ++ks) { const bf16x8 bfr = *(const bf16x8*)(fr + 64 * ks), bfi = *(const bf16x8*)(fi + 64 * ks);
      dre = __builtin_amdgcn_mfma_f32_16x16x32_bf16(bfr, are[ks], dre, 0, 0, 0); dre = __builtin_amdgcn_mfma_f32_16x16x32_bf16(bfi, x2[ks], dre, 0, 0, 0);
      dim = __builtin_amdgcn_mfma_f32_16x16x32_bf16(bfi, x3[ks], dim, 0, 0, 0); dim = __builtin_amdgcn_mfma_f32_16x16x32_bf16(bfr, aim[ks], dim, 0, 0, 0); }
    const int row = 16 * w + n16, c0 = 16 * cbk + 4 * g;
    float vr[4], vi[4];
#pragma unroll
    for (int r = 0; r < 4; ++r) { vr[r] = dre[r]; vi[r] = dim[r];
      if (TW) { const float2 t = twid(lds, row * (c0 + r), INV); const float a = vr[r] * t.x - vi[r] * t.y, b = vr[r] * t.y + vi[r] * t.x; vr[r] = a; vi[r] = b; } }
    u32x2 wr_, wi_; wr_.x = pk2(vr[0], vr[1]); wr_.y = pk2(vr[2], vr[3]); wi_.x = pk2(vi[0], vi[1]); wi_.y = pk2(vi[2], vi[3]);
    *(u32x2*)(lds + O_DRE + RS * row + 2 * c0) = wr_; *(u32x2*)(lds + O_DIM + RS * row + 2 * c0) = wi_;
  }
  __syncthreads();
}
template <bool ODD>
__device__ __forceinline__ void pointwise(char* lds, int tid) {
#pragma unroll 1
  for (int j = 0; j < (ODD ? 16 : 17); ++j) {
    const int pq = j * 512 + tid;
    int k1, k2, q1, q2; bool act = true;
    if (ODD) { k1 = pq >> 7; k2 = pq & 127; q1 = 127 - k1; q2 = 127 - k2; }
    else if (pq < 8064) { k1 = 1 + (pq >> 7); k2 = pq & 127; q1 = 128 - k1; q2 = 127 - k2; }
    else if (pq < 8192) { k1 = 0; k2 = pq - 8064; q1 = 0; q2 = (128 - k2) & 127; act = k2 <= q2; }
    else if (pq < 8320) { k1 = 64; k2 = pq - 8192; q1 = 64; q2 = 127 - k2; act = k2 <= q2; }
    else { k1 = k2 = q1 = q2 = 0; act = false; }
    if (act) {
      bf16_t* r0 = (bf16_t*)(lds + O_DRE + RS * k1 + 2 * k2); bf16_t* i0 = (bf16_t*)(lds + O_DIM + RS * k1 + 2 * k2);
      bf16_t* r1 = (bf16_t*)(lds + O_DRE + RS * q1 + 2 * q2); bf16_t* i1 = (bf16_t*)(lds + O_DIM + RS * q1 + 2 * q2);
      const float cx = bf2f(*r0), cy = bf2f(*i0), dx = bf2f(*r1), dy = bf2f(*i1);
      const float zx = 0.5f * (cx + dx), zy = 0.5f * (cy - dy), kx = 0.5f * (cy + dy), ky = -0.5f * (cx - dx);
      const float yx = zx * kx - zy * ky, yy = zx * ky + zy * kx;
      *r0 = (bf16_t)f2bf(yx); *i0 = (bf16_t)f2bf(yy); *r1 = (bf16_t)f2bf(yx); *i1 = (bf16_t)f2bf(-yy);
    }
  }
  __syncthreads();
}
}

__device__ __forceinline__ void conv3_pair(const bf16_t* __restrict__ row, int n0, float w0, float w1, float w2, float b, float& o0, float& o1) {
  const unsigned pr = *(const unsigned*)(row + (unsigned)n0); const float u0 = __uint_as_float(pr << 16), u1 = __uint_as_float(pr & 0xffff0000u);
  float um = bf2f(row[(unsigned)max(n0 - 1, 0)]), up = bf2f(row[(unsigned)min(n0 + 2, L - 1)]); um = n0 > 0 ? um : 0.f; up = (n0 + 2 < L) ? up : 0.f;
  o0 = w0 * um + w1 * u0 + w2 * u1 + b; o1 = w0 * u0 + w1 * u1 + w2 * up + b;
}
__device__ __forceinline__ void hyena_mfma_items(const Args& a, char* lds, int tid) {
  bf16_t* P1T = (bf16_t*)(a.ws + WS_P1T); const bf16_t* HT = (const bf16_t*)(a.ws + WS_HT);
  const float2* TW2 = (const float2*)(a.ws + WS_TW2);
  float* red = (float*)(lds + mf::O_RED); float* outf = (float*)lds;
  for (int idx = tid; idx < 16384; idx += 512) { const int r = idx >> 7, c = idx & 127, m = (r * c) & 127; float s, co; sincospif((float)m / 64.f, &s, &co);
    *(bf16_t*)(lds + mf::O_FRE + mf::RS * r + 2 * c) = (bf16_t)f2bf(co); *(bf16_t*)(lds + mf::O_FIM + mf::RS * r + 2 * c) = (bf16_t)f2bf(-s); }
  if (tid < 128) { float s, co; sincospif((float)tid / 64.f, &s, &co); ((float2*)(lds + mf::O_TWA))[tid] = make_float2(co, -s); ((float2*)(lds + mf::O_TWB))[tid] = TW2[2 * tid]; }
  __syncthreads();
  const float* cw = a.in[15]; const float* cbias = a.in[16]; const float* skip = a.in[23];
#ifndef HY_PROBE
#define HY_PROBE 0
#endif
#pragma unroll 1
  for (int pass = HY_PROBE ? 0 : 1; pass < 2; ++pass)
  for (int item = blockIdx.x; item < (pass ? 768 : 256); item += gridDim.x) {
    asm volatile("" : "+v"(tid));
    const int c = item;
    const float ad = fabsf(-3.0701134573f + (-15.350567286f + 3.0701134573f) * ((float)c * (1.f / 767.f))) * (1.f / 16383.f);
    const float dr1 = __expf(-ad);
    float z[32], acc[32];
    { const bf16_t* vr = P1T + (size_t)c * L; const float w0 = cw[c], w1 = cw[2304 + c], w2 = cw[4608 + c], b = cbias[c];
asm volatile("" : "+v"(tid));
#pragma unroll
      for (int jp = 0; jp < 16; ++jp) { if ((jp & 15) == 0) __builtin_amdgcn_sched_barrier(0); conv3_pair(vr, jp * 1024 + 2 * tid, w0, w1, w2, b, z[2 * jp], z[2 * jp + 1]); } }
#pragma unroll 1
    for (int o = 0; o < 2; ++o) {
      const bf16_t* hf = HT + (size_t)((o * 2 + 0) * 768 + c) * L; const bf16_t* hb = HT + (size_t)((o * 2 + 1) * 768 + c) * L;
      float ssum = 0.f;
asm volatile("" : "+v"(tid));
#pragma unroll
      for (int jp = 0; jp < 16; ++jp) { if ((jp & 15) == 0) __builtin_amdgcn_sched_barrier(0); const int n0 = jp * 1024 + 2 * tid; const int nb0 = (L - n0) & (L - 1), nb1 = L - 1 - n0;
        const unsigned pf = *(const unsigned*)(hf + (unsigned)n0); const float e0 = __expf(-ad * (float)n0);
        const float f0 = __uint_as_float(pf << 16) * e0, f1 = __uint_as_float(pf & 0xffff0000u) * (e0 * dr1);
        float b0 = bf2f(hb[(unsigned)nb0]) * __expf(-ad * (float)nb0); const float b1 = bf2f(hb[(unsigned)nb1]) * __expf(-ad * (float)nb1);
        ssum += (fabsf(f0) + fabsf(b0)) + (fabsf(f1) + fabsf(b1)); b0 = n0 ? b0 : 0.f; const int off = mf::RS * (n0 >> 7) + 2 * (n0 & 127);
        *(unsigned*)(lds + mf::O_DRE + off) = pk2(z[2 * jp], z[2 * jp + 1]); *(unsigned*)(lds + mf::O_DIM + off) = pk2(f0 + b0, f1 + b1); }
      ssum = wave_sum(ssum); if ((tid & 63) == 0) red[tid >> 6] = ssum;
      __syncthreads();
      const float nrm = EPS + ((red[0] + red[1]) + (red[2] + red[3])) + ((red[4] + red[5]) + (red[6] + red[7]));
      mf::dft_cols<false, true, 0>(lds, TW2, tid); mf::dft_rows<false, false>(lds, tid); mf::pointwise<false>(lds, tid);
      mf::dft_rows<true, true>(lds, tid); mf::dft_cols<true, false, 1>(lds, TW2, tid);
asm volatile("" : "+v"(tid));
#pragma unroll
      for (int jp = 0; jp < 16; ++jp) { if ((jp & 15) == 0) __builtin_amdgcn_sched_barrier(0); const float2 v = *(const float2*)(outf + jp * 1024 + 2 * tid); acc[2 * jp] = v.x; acc[2 * jp + 1] = v.y; }
      __syncthreads();
asm volatile("" : "+v"(tid));
#pragma unroll
      for (int jp = 0; jp < 16; ++jp) { if ((jp & 15) == 0) __builtin_amdgcn_sched_barrier(0); const int n0 = jp * 1024 + 2 * tid; const int nb0 = (L - n0) & (L - 1), nb1 = L - 1 - n0;
        const unsigned pf = *(const unsigned*)(hf + (unsigned)n0); const float e0 = __expf(-ad * (float)n0);
        const float f0 = __uint_as_float(pf << 16) * e0, f1 = __uint_as_float(pf & 0xffff0000u) * (e0 * dr1);
        float b0 = bf2f(hb[(unsigned)nb0]) * __expf(-ad * (float)nb0); const float b1 = bf2f(hb[(unsigned)nb1]) * __expf(-ad * (float)nb1);
        b0 = n0 ? b0 : 0.f; const float k0 = f0 - b0, k1 = f1 - b1; const f32x4 w = *(const f32x4*)(TW2 + n0);
        const int off = mf::RS * (n0 >> 7) + 2 * (n0 & 127);
        *(unsigned*)(lds + mf::O_DRE + off) = pk2(z[2 * jp] * w.x - k0 * w.y, z[2 * jp + 1] * w.z - k1 * w.w);
        *(unsigned*)(lds + mf::O_DIM + off) = pk2(z[2 * jp] * w.y + k0 * w.x, z[2 * jp + 1] * w.w + k1 * w.z); }
      __syncthreads();
      mf::dft_cols<false, true, 0>(lds, TW2, tid); mf::dft_rows<false, false>(lds, tid); mf::pointwise<true>(lds, tid);
      mf::dft_rows<true, true>(lds, tid); mf::dft_cols<true, false, 2>(lds, TW2, tid);
      const bf16_t* gr = P1T + (size_t)((o + 1) * 768 + c) * L; const int gc = (o + 1) * 768 + c;
      const float w0 = cw[gc], w1 = cw[2304 + gc], w2 = cw[4608 + gc], b = cbias[gc], sk = skip[o * 768 + c], sc = (1.f / 32768.f) / nrm;
asm volatile("" : "+v"(tid));
#pragma unroll
      for (int jp = 0; jp < 16; ++jp) { if ((jp & 15) == 0) __builtin_amdgcn_sched_barrier(0); const int n0 = jp * 1024 + 2 * tid; const float2 v = *(const float2*)(outf + n0);
        float g0, g1; conv3_pair(gr, n0, w0, w1, w2, b, g0, g1);
        z[2 * jp] = g0 * ((acc[2 * jp] + v.x) * sc + sk * z[2 * jp]); z[2 * jp + 1] = g1 * ((acc[2 * jp + 1] + v.y) * sc + sk * z[2 * jp + 1]); }
      __syncthreads();
    }
    { const bf16_t* gt = P1T + (size_t)(2304 + c) * L; bf16_t* orow = pass ? P1T + (size_t)c * L : (bf16_t*)(a.ws + 126 * MiB) + (size_t)c * L;
asm volatile("" : "+v"(tid));
#pragma unroll
      for (int jp = 0; jp < 16; ++jp) { if ((jp & 15) == 0) __builtin_amdgcn_sched_barrier(0); const int n0 = jp * 1024 + 2 * tid; const unsigned pg = *(const unsigned*)(gt + (unsigned)n0);
        *(unsigned*)(orow + (unsigned)n0) = pk2(z[2 * jp] * __uint_as_float(pg << 16), z[2 * jp + 1] * __uint_as_float(pg & 0xffff0000u)); } }
#ifdef HY_EXTRA
    __syncthreads();
    for (int xr = 0; xr < HY_EXTRA; ++xr) { mf::dft_cols<false, true, 0>(lds, TW2, tid); mf::dft_rows<false, false>(lds, tid); mf::pointwise<false>(lds, tid); mf::dft_rows<true, true>(lds, tid); mf::dft_cols<true, false, 1>(lds, TW2, tid); }
#endif
  }
}

__device__ __forceinline__ void hyena_fourier_phase(const Args& a, char* lds, int tid) {
  float2* cb = (float2*)lds; float2* twL = (float2*)(lds + 135168); float* red = (float*)(lds + 135168 + 16384);
  bf16_t* P1T = (bf16_t*)(a.ws + WS_P1T); const bf16_t* HT = (const bf16_t*)(a.ws + WS_HT);
  const float2* TW2 = (const float2*)(a.ws + WS_TW2);
  for (int i = tid; i < 2048; i += 512) twL[i] = TW2[2 * i];
  __syncthreads();
  const float* cw = a.in[15]; const float* cbias = a.in[16]; const float* skip = a.in[23];
#ifndef HY_MFMA
#define HY_MFMA 1
#endif
  for (int item = (HY_MFMA ? 768 : 0) + blockIdx.x; item < 1024; item += gridDim.x) {
    asm volatile("" : "+v"(tid));
    if (item < 768) {
      const int c = item;
      const float ad = fabsf(-3.0701134573f + (-15.350567286f + 3.0701134573f) * ((float)c * (1.f / 767.f))) * (1.f / 16383.f);
      float z[32], acc[32];
      { const bf16_t* vr = P1T + (size_t)c * L; const float w0 = cw[c], w1 = cw[2304 + c], w2 = cw[4608 + c], b = cbias[c];
asm volatile("" : "+v"(tid));
#pragma unroll
        for (int j = 0; j < 32; ++j) { if ((j & 15) == 0) __builtin_amdgcn_sched_barrier(0); z[j] = conv3_at(vr, j * 512 + tid, w0, w1, w2, b); } }
#pragma unroll 1
      for (int o = 0; o < 2; ++o) {
        const bf16_t* hf = HT + (size_t)((o * 2 + 0) * 768 + c) * L; const bf16_t* hb = HT + (size_t)((o * 2 + 1) * 768 + c) * L;
        float ssum = 0.f;
asm volatile("" : "+v"(tid));
#pragma unroll
        for (int j = 0; j < 32; ++j) { if ((j & 15) == 0) __builtin_amdgcn_sched_barrier(0); const int n = j * 512 + tid; const int nb = (L - n) & (L - 1); const float f = bf2f(hf[(unsigned)n]) * __expf(-ad * (float)n); float b = bf2f(hb[(unsigned)nb]) * __expf(-ad * (float)nb);
          ssum += fabsf(f) + fabsf(b); b = n ? b : 0.f; cb[PADI(n)] = make_float2(z[j], f + b); }
        ssum = wave_sum(ssum); if ((tid & 63) == 0) red[tid >> 6] = ssum;
        __syncthreads();
        const float nrm = EPS + ((red[0] + red[1]) + (red[2] + red[3])) + ((red[4] + red[5]) + (red[6] + red[7]));
        fft_fwd(cb, twL, tid); fft_pointwise<false>(cb, tid); fft_inv(cb, twL, tid);
asm volatile("" : "+v"(tid));
#pragma unroll
        for (int j = 0; j < 32; ++j) { if ((j & 15) == 0) __builtin_amdgcn_sched_barrier(0); acc[j] = cb[PADI(j * 512 + tid)].x; }
        __syncthreads();
asm volatile("" : "+v"(tid));
#pragma unroll
        for (int j = 0; j < 32; ++j) { if ((j & 15) == 0) __builtin_amdgcn_sched_barrier(0); const int n = j * 512 + tid; const int nb = (L - n) & (L - 1); const float f = bf2f(hf[(unsigned)n]) * __expf(-ad * (float)n); float b = bf2f(hb[(unsigned)nb]) * __expf(-ad * (float)nb); b = n ? b : 0.f; const float kk = f - b; const float2 w = TW2[n];
          cb[PADI(n)] = make_float2(z[j] * w.x - kk * w.y, z[j] * w.y + kk * w.x); }
        __syncthreads();
        fft_fwd(cb, twL, tid); fft_pointwise<true>(cb, tid); fft_inv(cb, twL, tid);
        const bf16_t* gr = P1T + (size_t)((o + 1) * 768 + c) * L; const int gc = (o + 1) * 768 + c;
        const float w0 = cw[gc], w1 = cw[2304 + gc], w2 = cw[4608 + gc], b = cbias[gc], sk = skip[o * 768 + c], sc = (1.f / 32768.f) / nrm;
asm volatile("" : "+v"(tid));
#pragma unroll
        for (int j = 0; j < 32; ++j) { if ((j & 15) == 0) __builtin_amdgcn_sched_barrier(0); const int n = j * 512 + tid; const float2 r = cb[PADI(n)], w = TW2[n];
          const float cv = (acc[j] + r.x * w.x + r.y * w.y) * sc;
          z[j] = conv3_at(gr, n, w0, w1, w2, b) * (cv + sk * z[j]); }
        __syncthreads();
      }
      { const bf16_t* gt = P1T + (size_t)(2304 + c) * L; bf16_t* orow = P1T + (size_t)c * L;
asm volatile("" : "+v"(tid));
#pragma unroll
        for (int j = 0; j < 32; ++j) { if ((j & 15) == 0) __builtin_amdgcn_sched_barrier(0); const int n = j * 512 + tid; orow[n] = (bf16_t)f2bf(z[j] * bf2f(gt[n])); } }
#ifdef HY_EXTRA
      __syncthreads();
      for (int xr = 0; xr < 2; ++xr) { fft_fwd(cb, twL, tid); fft_pointwise<false>(cb, tid); fft_inv(cb, twL, tid); fft_fwd(cb, twL, tid); fft_pointwise<true>(cb, tid); fft_inv(cb, twL, tid); }
#endif
    } else {
      const int k = item - 768;
      const bf16_t* ar = P1T + (size_t)(3072 + k) * L; const bf16_t* ai = P1T + (size_t)(3328 + k) * L; const bf16_t* gt = P1T + (size_t)(3584 + k) * L;
asm volatile("" : "+v"(tid));
#pragma unroll
      for (int j = 0; j < 32; ++j) { if ((j & 15) == 0) __builtin_amdgcn_sched_barrier(0); const int n = j * 512 + tid; cb[PADI(n)] = make_float2(bf2f(ar[n]), bf2f(ai[n])); }
      __syncthreads();
      fft_fwd(cb, twL, tid);
      bf16_t* orow = P1T + (size_t)(3072 + k) * L;
asm volatile("" : "+v"(tid));
#pragma unroll
      for (int j = 0; j < 32; ++j) { if ((j & 15) == 0) __builtin_amdgcn_sched_barrier(0); const int n = j * 512 + tid; const int p = (int)(__brev((unsigned)n) >> 18); orow[n] = (bf16_t)f2bf(cb[PADI(p)].x * bf2f(gt[n])); }
      __syncthreads();
    }
  }
#if HY_MFMA
  __syncthreads();
  hyena_mfma_items(a, lds, tid);
#endif
}

__device__ __forceinline__ void transpose_phase(const bf16_t* __restrict__ P1T, bf16_t* __restrict__ MIX, char* lds, int tid) {
  bf16_t* tl = (bf16_t*)lds;
  for (int item = blockIdx.x; item < 16 * 256; item += gridDim.x) {
    const int ct = item & 15, tt = item >> 4, c0 = ct * 64, t0 = tt * 64;
    { const int ch = tid >> 3, tq = (tid & 7) * 8; const int srow = (c0 + ch) < 768 ? (c0 + ch) : (3072 + c0 + ch - 768);
      *(u32x4*)(tl + ch * 72 + tq) = *(const u32x4*)(P1T + (size_t)srow * L + t0 + tq); }
    __syncthreads();
    { const int tok = tid >> 3, cq = (tid & 7) * 8; unsigned short v[8];
#pragma unroll
      for (int e = 0; e < 8; ++e) v[e] = tl[(cq + e) * 72 + tok];
      u32x4 w; w.x = v[0] | ((unsigned)v[1] << 16); w.y = v[2] | ((unsigned)v[3] << 16); w.z = v[4] | ((unsigned)v[5] << 16); w.w = v[6] | ((unsigned)v[7] << 16);
      *(u32x4*)(MIX + (size_t)(t0 + tok) * 1024 + c0 + cq) = w; }
    __syncthreads();
  }
}

__device__ __forceinline__ void ht_phase(const bf16_t* __restrict__ W3T, const bf16_t* __restrict__ HD2, bf16_t* __restrict__ HT, int lo, int hi_, unsigned* ctr, volatile unsigned* slot, int tid) {
  typedef short bf16x8 __attribute__((ext_vector_type(8)));
  typedef float f32x16 __attribute__((ext_vector_type(16)));
  const int lane = tid & 63, wid = tid >> 6, r32 = lane & 31, hi = lane >> 5;
  for (int it = 0;; ++it) {
    int item;
    if (ctr) { __syncthreads(); if (tid == 0) *slot = atomicAdd(ctr, 1u); __syncthreads(); item = lo + (int)*slot; }
    else item = lo + blockIdx.x + it * gridDim.x;
    if (item >= hi_) break;
    const int rb = item >> 3, tc = item & 7;
    bf16x8 af[4];
#pragma unroll
    for (int ks = 0; ks < 4; ++ks) af[ks] = *(const bf16x8*)(W3T + (size_t)(rb * 32 + r32) * 64 + ks * 16 + hi * 8);
#pragma unroll 2
    for (int tt = 0; tt < 8; ++tt) {
      const int t0 = tc * 2048 + wid * 256 + tt * 32;
      f32x16 acc = {};
#pragma unroll
      for (int ks = 0; ks < 4; ++ks) { const bf16x8 bfr = *(const bf16x8*)(HD2 + (size_t)(t0 + r32) * 64 + ks * 16 + hi * 8);
        acc = __builtin_amdgcn_mfma_f32_32x32x16_bf16(af[ks], bfr, acc, 0, 0, 0); }
#pragma unroll
      for (int r = 0; r < 16; ++r) { const int row = rb * 32 + (r & 3) + 8 * (r >> 2) + 4 * hi; HT[(size_t)row * L + t0 + r32] = (bf16_t)f2bf(acc[r]); }
    }
  }
}
__device__ __forceinline__ int lane_id_opaque() {
  int l; asm volatile("v_mbcnt_lo_u32_b32 %0, -1, 0\n\tv_mbcnt_hi_u32_b32 %0, -1, %0" : "=v"(l)); return l;
}
__global__ void __launch_bounds__(512, 2) mega_fwd(Args a) {
  extern __shared__ __attribute__((aligned(16))) unsigned char lds_raw[];
  const int wid_s = __builtin_amdgcn_readfirstlane((int)threadIdx.x >> 6);
#define MK_TID() (wid_s * 64 + lane_id_opaque())
  int tid;
  unsigned char* ws = a.ws;
  PG8_LAS unsigned char* ldsl = (PG8_LAS unsigned char*)lds_raw;
  float* xs = (float*)(lds_raw + XS_OFF);
  const float* MOD = (const float*)(ws + WS_MOD);
  const int lo = a.ph_lo, hi = a.ph_hi, G = gridDim.x, bc = blockIdx.x;
#ifndef MK_FUSE_NORM
#define MK_FUSE_NORM 0
#endif
  const bool fuse = MK_FUSE_NORM && (G == 256) && !MK_MULTI;
#ifndef PH_MASK
#define PH_MASK 0xFFF
#endif
#define IN(k) ((((PH_MASK) >> (k)) & 1) && lo <= (k) && (k) < hi)
#ifndef DBL_MASK
#define DBL_MASK 0
#endif
#define NREP(k) ((((DBL_MASK) >> (k)) & 1) ? 2 : 1)
  unsigned nbar = 0; unsigned* gbar = (unsigned*)(ws + WS_BAR);
  if (a.ph_hi < 0) cg::this_grid().sync();
#define SEAM(k) do { if (IN(k) && IN((k) + 1)) { ++nbar; __syncthreads(); if (MK_TID() == 0) { __threadfence(); __hip_atomic_fetch_add(gbar, 1u, __ATOMIC_RELAXED, __HIP_MEMORY_SCOPE_AGENT); \
      while (__hip_atomic_load(gbar, __ATOMIC_RELAXED, __HIP_MEMORY_SCOPE_AGENT) < nbar * (unsigned)G) __builtin_amdgcn_s_sleep(2); __threadfence(); } __syncthreads(); } } while (0)
  if (IN(0)) for (int rep = 0; rep < NREP(0); ++rep) { tid = MK_TID(); asm volatile("" : "+v"(tid)); p0_prep(a, (float*)lds_raw, tid); } SEAM(0);
  if (IN(1)) for (int rep = 0; rep < NREP(1); ++rep) { tid = MK_TID(); asm volatile("" : "+v"(tid)); rows_norm_mod(a.in[0], a.in[2], CTX, LK, a.in[6], MOD, MOD + 3072, (bf16_t*)(ws + WS_H), tid); } SEAM(1);
  if (IN(2)) for (int rep = 0; rep < NREP(2); ++rep) { tid = MK_TID(); asm volatile("" : "+v"(tid));
    pg8::Gemm g; g.A = (const bf16_t*)(ws + WS_H); g.Bt = (const bf16_t*)(ws + WS_WIN0); g.M = LK; g.N = 2560; g.K = 1024;
    pg8::SchedIn0 S; S.G = G; S.c = bc;
    pg8::EpiIn0 E; E.AV = (float*)(ws + WS_AV); E.AG = (bf16_t*)(ws + WS_AG); E.Q = (bf16_t*)(ws + WS_Q); E.K = (bf16_t*)(ws + WS_K); E.V = (bf16_t*)(ws + WS_V); E.BG = (bf16_t*)(ws + WS_BG);
    E.qg = a.in[11]; E.kg = a.in[12]; E.rope = (const float2*)(ws + WS_ROPE); E.xs = xs;
    pg8::gemm_phase<pg8::EpiIn0, pg8::SchedIn0, true, false>(ldsl, g, S, E, tid);
    tid = MK_TID(); asm volatile("" : "+v"(tid));
    prep_queue(a, (unsigned*)(ws + WS_CNT) + 388 + rep, (volatile unsigned*)(lds_raw + 154000), (float*)lds_raw, tid);
  } SEAM(2);
  if (IN(3)) for (int rep = 0; rep < NREP(3); ++rep) { tid = MK_TID(); asm volatile("" : "+v"(tid));
    if (G == 256) {
      const int vb = ((bc & 7) >> 2) * 128 + (bc >> 3) * 4 + (bc & 3);
      const int kvh = vb >> 7, pk = (vb & 127) >> 1, side = vb & 1, cidx = vb >> 1;
      { const int w = 3 * pk + side, h = kvh * 3 + (w % 3), qb = w / 3;
        __syncthreads();
        attn::attn_dense_body<false>((const attn::bf16*)(ws + WS_Q) + (size_t)qb * 256 * 768 + h * 128, (const attn::bf16*)(ws + WS_K) + (size_t)kvh * LK * 128, (const attn::bf16*)(ws + WS_V) + (size_t)kvh * LK * 128,
                              (const bf16_t*)(ws + WS_BG) + (size_t)qb * 256 * 768 + h * 128, (bf16_t*)(ws + WS_H) + (size_t)qb * 256 * 1024 + 256 + h * 128, LK, (char*)lds_raw, nullptr, nullptr, nullptr, MK_TID()); }
      { const int w = 3 * pk + 2, h = kvh * 3 + (w % 3), qb = w / 3; const size_t koff = (size_t)side * (LK / 2) * 128;
        float* pbase = (float*)(ws + WS_PARTIAL) + (size_t)cidx * 2 * PARTIAL_FLOATS;
        __syncthreads();
        attn::attn_dense_body<true>((const attn::bf16*)(ws + WS_Q) + (size_t)qb * 256 * 768 + h * 128, (const attn::bf16*)(ws + WS_K) + koff + (size_t)kvh * LK * 128, (const attn::bf16*)(ws + WS_V) + koff + (size_t)kvh * LK * 128,
                              (const bf16_t*)(ws + WS_BG) + (size_t)qb * 256 * 768 + h * 128, (bf16_t*)(ws + WS_H) + (size_t)qb * 256 * 1024 + 256 + h * 128, LK / 2, (char*)lds_raw,
                              pbase + (size_t)side * PARTIAL_FLOATS, pbase + (size_t)(side ^ 1) * PARTIAL_FLOATS, (unsigned*)(ws + WS_CNT) + cidx, MK_TID()); }
    } else {
      for (int item = bc; item < 384; item += G) {
        const int h = item % 6, qb = item / 6, kvh = h / 3;
        __syncthreads();
        attn::attn_dense_body<false>((const attn::bf16*)(ws + WS_Q) + (size_t)qb * 256 * 768 + h * 128, (const attn::bf16*)(ws + WS_K) + (size_t)kvh * LK * 128, (const attn::bf16*)(ws + WS_V) + (size_t)kvh * LK * 128,
                              (const bf16_t*)(ws + WS_BG) + (size_t)qb * 256 * 768 + h * 128, (bf16_t*)(ws + WS_H) + (size_t)qb * 256 * 1024 + 256 + h * 128, LK, (char*)lds_raw, nullptr, nullptr, nullptr, MK_TID());
      }
    }
    tid = MK_TID(); asm volatile("" : "+v"(tid));
    pool_phase((const float*)(ws + WS_AV), (const bf16_t*)(ws + WS_AG), (bf16_t*)(ws + WS_H), (unsigned*)(ws + WS_CNT) + 384 + rep, (volatile unsigned*)(lds_raw + 70000), tid);
  } SEAM(3);
  if (IN(4)) for (int rep = 0; rep < NREP(4); ++rep) { tid = MK_TID(); asm volatile("" : "+v"(tid));
    pg8::Gemm g; g.A = (const bf16_t*)(ws + WS_H); g.Bt = (const bf16_t*)(ws + WS_WOUT0); g.M = L; g.N = 1024; g.K = 1024;
    pg8::SchedRow S; S.nN = 4; S.total = 256; S.G = G; S.c = bc;
    if (fuse) { pg8::EpiResNorm<2> E; E.base = a.in[0]; E.out = a.out; E.gate = MOD + 2048; E.g = a.in[6] + 1024; E.mod = MOD + 2 * 3072; E.H = (bf16_t*)(ws + WS_H2);
      E.psq = (float*)(ws + WS_PART); E.cnt = (unsigned*)(ws + WS_CNT) + 256; E.xs = xs;
      pg8::gemm_phase<pg8::EpiResNorm<2>, pg8::SchedRow, true, false>(ldsl, g, S, E, tid); }
    else { pg8::EpiRes E; E.base = a.in[0]; E.out = a.out; E.gate = MOD + 2048;
      pg8::gemm_phase<pg8::EpiRes, pg8::SchedRow, true, false>(ldsl, g, S, E, tid); }
  } SEAM(4);
  if (IN(5)) for (int rep = 0; rep < NREP(5); ++rep) { tid = MK_TID(); asm volatile("" : "+v"(tid)); if (!fuse) rows_norm_mod(a.out, a.out, 0, L, a.in[6] + 1024, MOD + 2 * 3072, MOD + 2 * 3072, (bf16_t*)(ws + WS_H2), tid); } SEAM(5);
  if (IN(6)) for (int rep = 0; rep < NREP(6); ++rep) { tid = MK_TID(); asm volatile("" : "+v"(tid));
    pg8::Gemm g; g.A = (const bf16_t*)(ws + WS_WIN1); g.Bt = (const bf16_t*)(ws + WS_H2); g.M = 3840; g.N = L; g.K = 1024;
    pg8::SchedCol S; S.nM = 15; S.total = 15 * 64; S.G = G; S.c = bc;
    pg8::EpiT E; E.O = (bf16_t*)(ws + WS_P1T); E.gated = 1;
    pg8::gemm_phase<pg8::EpiT, pg8::SchedCol, true, false>(ldsl, g, S, E, tid);
    tid = MK_TID(); asm volatile("" : "+v"(tid));
    ht_phase((const bf16_t*)(ws + WS_W3T), (const bf16_t*)(ws + WS_HD2B), (bf16_t*)(ws + WS_HT), 0, 384, (unsigned*)(ws + WS_CNT) + 392 + rep, (volatile unsigned*)(lds_raw + 154000), tid);
  } SEAM(6);
  if (IN(7)) for (int rep = 0; rep < NREP(7); ++rep) { tid = MK_TID(); asm volatile("" : "+v"(tid));
    ht_phase((const bf16_t*)(ws + WS_W3T), (const bf16_t*)(ws + WS_HD2B), (bf16_t*)(ws + WS_HT), 384, 768, nullptr, nullptr, tid);
  } SEAM(7);
  if (IN(8)) for (int rep = 0; rep < NREP(8); ++rep) { tid = MK_TID(); asm volatile("" : "+v"(tid)); hyena_fourier_phase(a, (char*)lds_raw, tid); } SEAM(8);
  if (IN(9)) for (int rep = 0; rep < NREP(9); ++rep) { tid = MK_TID(); asm volatile("" : "+v"(tid)); transpose_phase((const bf16_t*)(ws + WS_P1T), (bf16_t*)(ws + WS_H), (char*)lds_raw, tid); } SEAM(9);
  if (IN(10)) for (int rep = 0; rep < NREP(10); ++rep) { tid = MK_TID(); asm volatile("" : "+v"(tid));
    pg8::Gemm g; g.A = (const bf16_t*)(ws + WS_H); g.Bt = (const bf16_t*)(ws + WS_WOUT1); g.M = L; g.N = 1024; g.K = 1024;
    pg8::SchedRow S; S.nN = 4; S.total = 256; S.G = G; S.c = bc;
    if (fuse) { pg8::EpiResNorm<1> E; E.base = a.out; E.out = a.out; E.gate = MOD + 2 * 3072 + 2048; E.g = a.in[25]; E.mod = MOD; E.H = nullptr;
      E.psq = (float*)(ws + WS_PART) + 65536; E.cnt = (unsigned*)(ws + WS_CNT) + 320; E.xs = xs;
      pg8::gemm_phase<pg8::EpiResNorm<1>, pg8::SchedRow, true, false>(ldsl, g, S, E, tid); }
    else { pg8::EpiRes E; E.base = a.out; E.out = a.out; E.gate = MOD + 2 * 3072 + 2048;
      pg8::gemm_phase<pg8::EpiRes, pg8::SchedRow, true, false>(ldsl, g, S, E, tid); }
  } SEAM(10);
  if (IN(11)) for (int rep = 0; rep < NREP(11); ++rep) { tid = MK_TID(); asm volatile("" : "+v"(tid)); if (!fuse) rows_final(a.out, a.in[25], tid); }
#undef IN
#undef SEAM
}

extern "C" void kernel_launch(void* const* d_in, const int* in_sizes, int n_in, void* d_out, int out_size, void* d_ws, size_t ws_size, hipStream_t stream) {
  static int grid = 0;
  if (grid == 0) {
    if (n_in != 26 || in_sizes[0] != L * DM || out_size != L * DM || ws_size < WS_END) {
      fprintf(stderr, "kernel_launch: unexpected shapes: n_in %d in0 %d out %d ws %zu (need >= %zu)\n", n_in, n_in > 0 ? in_sizes[0] : -1, out_size, ws_size, (size_t)WS_END); grid = -1; return; }
    int dev = 0, cus = 0, per_cu = 0;
    if (hipGetDevice(&dev) != hipSuccess || hipDeviceGetAttribute(&cus, hipDeviceAttributeMultiprocessorCount, dev) != hipSuccess) { fprintf(stderr, "kernel_launch: device query failed\n"); grid = -1; return; }
    if (hipFuncSetAttribute((const void*)mega_fwd, hipFuncAttributeMaxDynamicSharedMemorySize, LDS_BYTES) != hipSuccess) { fprintf(stderr, "kernel_launch: hipFuncSetAttribute failed\n"); grid = -1; return; }
    if (hipOccupancyMaxActiveBlocksPerMultiprocessor(&per_cu, (const void*)mega_fwd, 512, LDS_BYTES) != hipSuccess || per_cu < 1) { fprintf(stderr, "kernel_launch: occupancy query says %d\n", per_cu); per_cu = 1; }
    (void)hipGetLastError();
    grid = cus * per_cu;
    fprintf(stderr, "kernel_launch: grid %d (cus %d x %d)\n", grid, cus, per_cu);
  }
  if (grid < 0) return;
  if (hipMemsetAsync((unsigned char*)d_ws + WS_BAR, 0, 256, stream) != hipSuccess) { fprintf(stderr, "kernel_launch: memset failed\n"); return; }
  Args a{};
  for (int i = 0; i < 26; ++i) a.in[i] = (const float*)d_in[i];
  a.out = (float*)d_out; a.ws = (unsigned char*)d_ws;
#if MK_MULTI
  for (int ph = 0; ph < NPH; ++ph) { a.ph_lo = ph; a.ph_hi = ph + 1; hipLaunchKernelGGL(mega_fwd, dim3(grid), dim3(512), LDS_BYTES, stream, a); }
#else
  a.ph_lo = 0; a.ph_hi = NPH;
  void* args[] = {&a};
  hipError_t e = hipLaunchCooperativeKernel((const void*)mega_fwd, dim3(grid), dim3(512), args, LDS_BYTES, stream);
  if (e != hipSuccess) fprintf(stderr, "kernel_launch: cooperative launch failed: %s (grid %d)\n", hipGetErrorString(e), grid);
#endif
}
```

```cpp
#include <hip/hip_runtime.h>
#include <hip/hip_bf16.h>
#include <hip/hip_cooperative_groups.h>
#include <cstdio>
#include <cstdint>
namespace cg = cooperative_groups;

#ifndef MK_FUSE_NORM
#define MK_FUSE_NORM 0
#endif
#ifndef MK_MULTI
#define MK_MULTI 0
#endif

constexpr int L = 16384, DM = 1024, CTX = 256, LK = L + CTX;
constexpr int NPH = 12;
constexpr float EPS = 1e-6f;
constexpr size_t MiB = (size_t)1 << 20, KiB = 1024;
constexpr size_t WS_MOD = 0, WS_ROPE = 64 * KiB, WS_TW2 = 128 * KiB, WS_T = 256 * KiB, WS_PART = 768 * KiB;
constexpr size_t WS_WIN0 = 2 * MiB, WS_WOUT0 = 7 * MiB, WS_WIN1 = 9 * MiB, WS_WOUT1 = 17 * MiB, WS_W3T = 19 * MiB, WS_HD2B = 21 * MiB;
constexpr size_t WS_H = 30 * MiB, WS_AV = 63 * MiB, WS_AG = 79 * MiB, WS_Q = 87 * MiB, WS_K = 111 * MiB, WS_V = 120 * MiB, WS_BG = 129 * MiB;
constexpr size_t WS_BAR = 1600 * KiB; constexpr size_t WS_CNT = 1536 * KiB, WS_PARTIAL = 160 * MiB; constexpr size_t PARTIAL_FLOATS = 256 * 128 + 512;
constexpr size_t WS_H2 = MK_FUSE_NORM ? 63 * MiB : 30 * MiB;
constexpr size_t WS_P1T = 136 * MiB, WS_HT = 30 * MiB, WS_END = 256 * MiB;
constexpr int LDS_BYTES = 155648;
constexpr int XS_OFF = 131072;

typedef unsigned short bf16_t;
typedef float f32x4 __attribute__((ext_vector_type(4)));
typedef unsigned u32x4 __attribute__((ext_vector_type(4)));
typedef unsigned u32x2 __attribute__((ext_vector_type(2)));

struct Args { const float* in[26]; float* out; unsigned char* ws; int ph_lo, ph_hi; };

__device__ __forceinline__ float bf2f(bf16_t v) { return __uint_as_float((unsigned)v << 16); }
__device__ __forceinline__ unsigned f2bf(float f) { unsigned u = __float_as_uint(f); return (u + 0x7fffu + ((u >> 16) & 1u)) >> 16; }
__device__ __forceinline__ unsigned pk2(float lo, float hi) { return f2bf(lo) | (f2bf(hi) << 16); }
__device__ __forceinline__ float siluf(float v) { return v / (1.f + __expf(-v)); }
__device__ __forceinline__ float wave_sum(float v) {
#pragma unroll
  for (int o = 32; o >= 1; o >>= 1) v += __shfl_xor(v, o);
  return v;
}

__device__ __forceinline__ int qk_srccol(int j) {
  if (j < 512 || j >= 1536) return j;
  const int base = j & ~127, p = j & 127, g = p >> 3, e = p & 7;
  const int axis = g >> 3, f = 4 * (g & 7) + (e & 3), half = e >> 2;
  return base + axis * 64 + half * 32 + f;
}
template <int MODE>
__device__ __forceinline__ void wt_tile(const float* __restrict__ src, int ldn, int off, bf16_t* __restrict__ dst, int j0, int k0, float* tl, int tid) {
  const int cc = tid & 63, r0 = tid >> 6;
  const int sc = (MODE == 1) ? qk_srccol(j0 + cc) : (off + j0 + cc);
#pragma unroll
  for (int i = 0; i < 8; ++i) { const int r = r0 + 8 * i; tl[r * 65 + cc] = src[(size_t)(k0 + r) * ldn + sc]; }
  __syncthreads();
  const int n = tid >> 3, kq = (tid & 7) * 8;
  u32x4 w;
  w.x = pk2(tl[(kq + 0) * 65 + n], tl[(kq + 1) * 65 + n]); w.y = pk2(tl[(kq + 2) * 65 + n], tl[(kq + 3) * 65 + n]);
  w.z = pk2(tl[(kq + 4) * 65 + n], tl[(kq + 5) * 65 + n]); w.w = pk2(tl[(kq + 6) * 65 + n], tl[(kq + 7) * 65 + n]);
  *(u32x4*)(dst + (size_t)(j0 + n) * 1024 + k0 + kq) = w;
  __syncthreads();
}
template <int MODE>
__device__ __forceinline__ void wt_quad(const float* __restrict__ src, int ldn, int off, bf16_t* __restrict__ dst, int j0, int k0, float* tl, int tid) {
  const int cc = tid & 63, r0 = tid >> 6;
  const int sc = (MODE == 1) ? qk_srccol(j0 + cc) : (off + j0 + cc);
  float v[32];
#pragma unroll
  for (int i = 0; i < 32; ++i) v[i] = src[(size_t)(k0 + r0 + 8 * i) * ldn + sc];
#pragma unroll
  for (int i = 0; i < 32; ++i) tl[(r0 + 8 * i) * 65 + cc] = v[i];
  __syncthreads();
  const int n = tid >> 3, kq = (tid & 7) * 8;
#pragma unroll
  for (int s = 0; s < 4; ++s) { const float* t = tl + (s * 64 + kq) * 65 + n; u32x4 w;
    w.x = pk2(t[0], t[65]); w.y = pk2(t[130], t[195]); w.z = pk2(t[260], t[325]); w.w = pk2(t[390], t[455]);
    *(u32x4*)(dst + (size_t)(j0 + n) * 1024 + k0 + s * 64 + kq) = w; }
  __syncthreads();
}
__device__ __forceinline__ void wt_pool_tile(const float* __restrict__ src, const float* __restrict__ pw, const float* __restrict__ pscale, bf16_t* __restrict__ dst, int j0, int k0, float* lds, int tid) {
  float* A = lds; float* Bm = lds + 64 * 65; float* tl = lds + 2 * 64 * 65;
  const int cc = tid & 63, r0 = tid >> 6, g = j0 >> 6;
#pragma unroll
  for (int i = 0; i < 8; ++i) { const int r = r0 + 8 * i; A[r * 65 + cc] = src[(size_t)(k0 + r) * 2560 + g * 64 + cc]; Bm[r * 65 + cc] = pw[(g * 64 + r) * 64 + cc]; }
  __syncthreads();
  const float sc = pscale[j0 + cc];
#pragma unroll
  for (int i = 0; i < 8; ++i) { const int r = r0 + 8 * i; float s = 0.f;
    for (int q = 0; q < 64; ++q) s += A[r * 65 + q] * Bm[q * 65 + cc];
    tl[r * 65 + cc] = s * sc; }
  __syncthreads();
  const int n = tid >> 3, kq = (tid & 7) * 8;
  u32x4 w;
  w.x = pk2(tl[(kq + 0) * 65 + n], tl[(kq + 1) * 65 + n]); w.y = pk2(tl[(kq + 2) * 65 + n], tl[(kq + 3) * 65 + n]);
  w.z = pk2(tl[(kq + 4) * 65 + n], tl[(kq + 5) * 65 + n]); w.w = pk2(tl[(kq + 6) * 65 + n], tl[(kq + 7) * 65 + n]);
  *(u32x4*)(dst + (size_t)(j0 + n) * 1024 + k0 + kq) = w;
  __syncthreads();
}

namespace prep {
constexpr int N_MOD = 192, N_WIN0 = 208, N_WOUT = 64, N_WIN1A = 192, N_WIN1B = 16, N_T = 256, N_HD2 = 256, N_W3T = 48, N_ROPE = 16, N_TW2 = 32;
constexpr int O_WIN0 = N_MOD, O_WOUT0 = O_WIN0 + N_WIN0, O_WOUT1 = O_WOUT0 + N_WOUT, O_WIN1A = O_WOUT1 + N_WOUT, O_WIN1B = O_WIN1A + N_WIN1A,
                O_T = O_WIN1B + N_WIN1B, O_HD2 = O_T + N_T, O_W3T = O_HD2 + N_HD2, O_ROPE = O_W3T + N_W3T, O_TW2 = O_ROPE + N_ROPE, O_END = O_TW2 + N_TW2;
constexpr int N_EARLY = O_WOUT1 + N_T + N_ROPE + N_TW2, N_LATE = (O_T - O_WOUT1) + (O_ROPE - O_HD2);
__host__ __device__ constexpr int early_item(int e) { return e < O_WOUT1 ? e : (e < O_WOUT1 + N_T ? O_T + (e - O_WOUT1) : O_ROPE + (e - O_WOUT1 - N_T)); }
__host__ __device__ constexpr int late_item(int q) { return q < O_T - O_WOUT1 ? O_WOUT1 + q : O_HD2 + (q - (O_T - O_WOUT1)); }
}
__device__ __forceinline__ void prep_item(const Args& a, int item, float* lds, int tid) {
  using namespace prep;
  unsigned char* ws = a.ws;
  {
    asm volatile("" : "+v"(tid));
    if (item < O_WIN0) {
      const int layer = item / 96, chunk = item % 96, col = chunk * 32 + (tid & 31), rg = tid >> 5;
      const float* wm = a.in[4] + (size_t)layer * 1024 * 3072; const float* cv = a.in[1]; const float* cc = a.in[3];
      float s0 = 0.f, s1 = 0.f;
      for (int r = rg; r < 1024; r += 16) { const float w = wm[(size_t)r * 3072 + col]; s0 += siluf(cv[r]) * w; if (layer == 0) s1 += siluf(cc[r]) * w; }
      lds[tid] = s0; lds[512 + tid] = s1; __syncthreads();
      if (tid < 32) { float t0 = 0.f, t1 = 0.f; for (int q = 0; q < 16; ++q) { t0 += lds[q * 32 + tid]; t1 += lds[512 + q * 32 + tid]; }
        const float bm = a.in[5][layer * 3072 + col]; float* MOD = (float*)(ws + WS_MOD);
        if (layer == 0) { MOD[col] = t0 + bm; MOD[3072 + col] = t1 + bm; } else MOD[2 * 3072 + col] = t0 + bm; }
      __syncthreads();
    } else if (item < O_WOUT0) {
      const int ti = item - O_WIN0;
      if (ti < 64) wt_pool_tile(a.in[7], a.in[9], a.in[10], (bf16_t*)(ws + WS_WIN0), (ti / 16) * 64, (ti % 16) * 64, lds, tid);
      else { const int tq = ti - 64; wt_quad<1>(a.in[7], 2560, 0, (bf16_t*)(ws + WS_WIN0), (4 + tq / 4) * 64, (tq % 4) * 256, lds, tid); }
    } else if (item < O_WOUT1) { const int ti = item - O_WOUT0; wt_quad<0>(a.in[8], 1024, 0, (bf16_t*)(ws + WS_WOUT0), (ti / 4) * 64, (ti % 4) * 256, lds, tid);
    } else if (item < O_WIN1A) { const int ti = item - O_WOUT1; wt_quad<0>(a.in[14], 1024, 0, (bf16_t*)(ws + WS_WOUT1), (ti / 4) * 64, (ti % 4) * 256, lds, tid);
    } else if (item < O_WIN1B) { const int ti = item - O_WIN1A; wt_quad<0>(a.in[13], 3584, 0, (bf16_t*)(ws + WS_WIN1), (ti / 4) * 64, (ti % 4) * 256, lds, tid);
    } else if (item < O_T) {     const int ti = item - O_WIN1B; wt_quad<0>(a.in[13], 3584, 3328 - 3584, (bf16_t*)(ws + WS_WIN1), 3584 + (ti / 4) * 64, (ti % 4) * 256, lds, tid);
    } else if (item < O_HD2) {
      const int i = item - O_T;
      if (tid < 256) lds[tid] = cospif((float)tid / 128.f);
      __syncthreads();
      const int n = tid & 255, part = tid >> 8; const float* fw = a.in[24];
      float s = 0.f;
      for (int j = 0; j < 256; ++j) { const int m = (i * j) & 255; const float tr = part ? lds[(m - 64) & 255] : lds[m]; s += tr * fw[j * 256 + n]; }
      ((float*)(ws + WS_T))[(part * 256 + i) * 256 + n] = (part ? -s : s) * (1.f / 2048.f);
      __syncthreads();
    } else if (item < O_W3T) {
      const int t0 = (item - O_HD2) * 64;
      float* e = lds; float* h1 = lds + 64 * 34;
      for (int idx = tid; idx < 64 * 33; idx += 512) { const int tl = idx / 33, q = idx % 33, t = t0 + tl; float v;
        if (q == 0) v = (float)t / 16383.f;
        else { const int b = (q - 1) & 15; const float f = 1e-4f + (float)b * ((15.f - 1e-4f) / 15.f); const float w = 6.2831855f * (float)t / 16384.f; const float ar = f * w;
          v = (q <= 16) ? cosf(ar) : -sinf(ar); }
        e[tl * 34 + q] = v; }
      __syncthreads();
      const int j = tid & 63, r0 = tid >> 6; const float fr = a.in[22][j];
#pragma unroll
      for (int i = 0; i < 8; ++i) { const int tl = r0 + 8 * i; float s = a.in[18][j];
        for (int q = 0; q < 33; ++q) s += e[tl * 34 + q] * a.in[17][q * 64 + j];
        h1[tl * 65 + j] = sinf(fr * s); }
      __syncthreads();
      bf16_t* HD = (bf16_t*)(ws + WS_HD2B);
#pragma unroll
      for (int i = 0; i < 8; ++i) { const int tl = r0 + 8 * i; float s = a.in[20][j];
        for (int q = 0; q < 64; ++q) s += h1[tl * 65 + q] * a.in[19][q * 64 + j];
        HD[(size_t)(t0 + tl) * 64 + j] = (bf16_t)f2bf(sinf(fr * s)); }
      __syncthreads();
    } else if (item < O_ROPE) {
      const int row = (item - O_W3T) * 64 + (tid >> 3), kg = (tid & 7) * 8; u32x4 w = {0u, 0u, 0u, 0u};
      { const float* w3 = a.in[21]; float v[8];
#pragma unroll
        for (int q = 0; q < 8; ++q) v[q] = w3[(size_t)(kg + q) * 3072 + row];
        w.x = pk2(v[0], v[1]); w.y = pk2(v[2], v[3]); w.z = pk2(v[4], v[5]); w.w = pk2(v[6], v[7]); }
      *(u32x4*)((bf16_t*)(ws + WS_W3T) + (size_t)row * 64 + kg) = w;
    } else if (item < O_TW2) {
      const int idx = (item - O_ROPE) * 512 + tid, pos = idx >> 5, f = idx & 31;
      const float inv = powf(10000.f, -(float)f / 32.f), ang = (float)pos * inv;
      ((float2*)(ws + WS_ROPE))[idx] = make_float2(cosf(ang), sinf(ang));
    } else {
      if (item == O_TW2 && tid < 392) ((unsigned*)(ws + WS_CNT))[tid] = 0u;
      const int n = (item - O_TW2) * 512 + tid; float s, c; sincospif((float)n / 16384.f, &s, &c);
      ((float2*)(ws + WS_TW2))[n] = make_float2(c, -s);
    }
  }
}
__device__ __forceinline__ void p0_prep(const Args& a, float* lds, int tid) {
  for (int e = blockIdx.x; e < prep::N_EARLY; e += gridDim.x) prep_item(a, prep::early_item(e), lds, tid);
}

__device__ __forceinline__ void rows_norm_mod(const float* __restrict__ X, const float* __restrict__ C, int nctx, int nrows, const float* __restrict__ g,
                                              const float* __restrict__ modx, const float* __restrict__ modc, bf16_t* __restrict__ H, int tid) {
  const int lane = tid & 63, wid = tid >> 6;
  for (int row = blockIdx.x * 8 + wid; row < nrows; row += gridDim.x * 8) {
    const float* src = row < nctx ? C + (size_t)row * 1024 : X + (size_t)(row - nctx) * 1024; const float* md = row < nctx ? modc : modx;
    f32x4 v[4]; float ss = 0.f;
#pragma unroll
    for (int i = 0; i < 4; ++i) { v[i] = *(const f32x4*)(src + (lane + 64 * i) * 4); ss += v[i].x * v[i].x + v[i].y * v[i].y + v[i].z * v[i].z + v[i].w * v[i].w; }
    ss = wave_sum(ss); const float rinv = rsqrtf(ss * (1.f / 1024.f) + EPS);
#pragma unroll
    for (int i = 0; i < 4; ++i) { const int c = (lane + 64 * i) * 4; const f32x4 gg = *(const f32x4*)(g + c), sh = *(const f32x4*)(md + c), sc = *(const f32x4*)(md + 1024 + c);
      const f32x4 y = v[i] * rinv * gg * (sc + 1.f) + sh;
      u32x2 w; w.x = pk2(y.x, y.y); w.y = pk2(y.z, y.w); *(u32x2*)(H + (size_t)row * 1024 + c) = w; }
  }
}
__device__ __forceinline__ void rows_final(float* __restrict__ X, const float* __restrict__ g, int tid) {
  const int lane = tid & 63, wid = tid >> 6;
  for (int row = blockIdx.x * 8 + wid; row < L; row += gridDim.x * 8) {
    float* src = X + (size_t)row * 1024; f32x4 v[4]; float ss = 0.f;
#pragma unroll
    for (int i = 0; i < 4; ++i) { v[i] = *(const f32x4*)(src + (lane + 64 * i) * 4); ss += v[i].x * v[i].x + v[i].y * v[i].y + v[i].z * v[i].z + v[i].w * v[i].w; }
    ss = wave_sum(ss); const float rinv = rsqrtf(ss * (1.f / 1024.f) + EPS);
#pragma unroll
    for (int i = 0; i < 4; ++i) { const int c = (lane + 64 * i) * 4; const f32x4 gg = *(const f32x4*)(g + c); *(f32x4*)(src + c) = v[i] * rinv * gg; }
  }
}
__device__ __forceinline__ void fold_item(const Args& a, int item, float* lds, int tid) {
  float* A = lds; float* Bm = lds + 64 * 257; const float* T = (const float*)(a.ws + WS_T); bf16_t* W = (bf16_t*)(a.ws + WS_WIN1);
  {
    const int kt = item >> 3, nt = item & 7, part = nt >> 2, n0 = (nt & 3) * 64, k0 = kt * 64;
    for (int idx = tid; idx < 64 * 256; idx += 512) { const int k = idx >> 8, i = idx & 255; A[k * 257 + i] = a.in[13][(size_t)(k0 + k) * 3584 + 3072 + i]; }
    for (int idx = tid; idx < 256 * 64; idx += 512) { const int i = idx >> 6, n = idx & 63; Bm[i * 64 + n] = T[(part * 256 + i) * 256 + n0 + n]; }
    __syncthreads();
    const int n = tid & 63, r0 = tid >> 6; float s[8];
#pragma unroll
    for (int q = 0; q < 8; ++q) s[q] = 0.f;
    for (int i = 0; i < 256; ++i) { const float b = Bm[i * 64 + n];
#pragma unroll
      for (int q = 0; q < 8; ++q) s[q] += A[(r0 + 8 * q) * 257 + i] * b; }
#pragma unroll
    for (int q = 0; q < 8; ++q) W[(size_t)(3072 + part * 256 + n0 + n) * 1024 + k0 + r0 + 8 * q] = (bf16_t)f2bf(s[q]);
    __syncthreads();
  }
}

namespace pg8 {
#define PG8_LAS __attribute__((address_space(3)))
typedef unsigned short bf16_t;
typedef short bf16x8 __attribute__((ext_vector_type(8)));
typedef float f32x4 __attribute__((ext_vector_type(4)));
typedef unsigned u32x4 __attribute__((ext_vector_type(4)));
constexpr int BM = 256, BK = 64, HALF = 128, HTB = HALF * BK * 2  , STAGE_BYTES = 8 * HTB, NXCD = 8, WGM = 8;

__host__ __device__ __forceinline__ int lds_byte(int r, int c) { const int st = (r >> 4) * 2 + (c >> 5), rr = r & 15, cc = c & 31, ob = rr * 64 + cc * 2; return st * 1024 + (ob ^ (((ob >> 9) & 1) << 5)); }
__host__ __device__ __forceinline__ void stage_rc(int b, int& R, int& C) { const int st = b / 1024, sb = b % 1024, swz = sb ^ (((sb >> 9) & 1) << 5); R = (st >> 1) * 16 + swz / 64; C = (st & 1) * 32 + (swz % 64) / 2; }
__host__ __device__ __forceinline__ int perm32(int rho) { const int n = rho >> 4, i = rho & 15; return 8 * (i >> 2) + 4 * n + (i & 3); }

struct Unit { int pm, pn; };
struct Gemm { const bf16_t* A; const bf16_t* Bt; int M, N, K; };
__device__ __forceinline__ unsigned cvt_pk_bf16(float lo, float hi) { unsigned r; asm volatile("v_cvt_pk_bf16_f32 %0, %1, %2" : "=v"(r) : "v"(lo), "v"(hi)); return r; }
}

namespace pg8 {

struct StaticOrder {
    int nM, nN, nwg, G, c;
    __host__ __device__ void init(int M, int N, int G_, int c_) { nM = M / BM; nN = N / BM; nwg = nM * nN; G = G_; c = c_; }
    __host__ __device__ bool next(int i, Unit& u) const {
        const long L = (long)i * G + c; if (L >= nwg) return false;
        int wgid = (int)L; { const int q = nwg / NXCD, r = nwg % NXCD, xcd = wgid % NXCD, off = wgid / NXCD; wgid = (xcd < r ? xcd * (q + 1) : r * (q + 1) + (xcd - r) * q) + off; }
        const int nig = WGM * nN, gid = wgid / nig, fm = gid * WGM, gsz = (nM - fm) < WGM ? (nM - fm) : WGM;
        u.pm = fm + ((wgid % nig) % gsz); u.pn = (wgid % nig) / gsz; return true;
    }
    __device__ __forceinline__ void a_ready(const Unit&) const {}
    __device__ __forceinline__ void done(const Unit&) const {}
};

struct SchedIn0 {
  int G, c;
  __device__ __forceinline__ bool next(int i, Unit& u) const { const int l = i * G + c; if (l >= 642) return false;
    if (l < 2) { u.pm = 0; u.pn = 5 + l; } else { const int v = l - 2; u.pm = 1 + v / 10; u.pn = v % 10; } return true; }
  __device__ __forceinline__ void a_ready(const Unit&) const {}
  __device__ __forceinline__ void done(const Unit&) const {}
};
struct SchedRow {
  int nN, total, G, c;
  __device__ __forceinline__ bool next(int i, Unit& u) const { const int l = i * G + c; if (l >= total) return false; u.pm = l / nN; u.pn = l % nN; return true; }
  __device__ __forceinline__ void a_ready(const Unit&) const {}
  __device__ __forceinline__ void done(const Unit&) const {}
};
struct SchedCol {
  int nM, total, G, c;
  __device__ __forceinline__ bool next(int i, Unit& u) const { const int l = i * G + c; if (l >= total) return false; u.pn = l / nM; u.pm = l % nM; return true; }
  __device__ __forceinline__ void a_ready(const Unit&) const {}
  __device__ __forceinline__ void done(const Unit&) const {}
};
struct EpiIn0 {
  static constexpr bool PERM = true, AFTER_DRAIN = false;
  float* AV; bf16_t *AG, *Q, *K, *V, *BG; const float *qg, *kg; const float2* rope; float* xs;
  __device__ __forceinline__ void operator()(const f32x4 (&acc)[2][2][4][2], const Unit& u, int wr, int wc, int fr, int fq) const {
    const int pn = u.pn, rl0 = wr * 64 + fr, row0 = u.pm * 256 + rl0, cl = wc * 32 + 8 * fq;
    if (u.pm == 0 && pn != 5 && pn != 6) return;
    if (pn == 0) {
#pragma unroll
      for (int ai = 0; ai < 2; ++ai)
#pragma unroll
        for (int m = 0; m < 4; ++m) { float* p = AV + (size_t)(row0 + ai * 128 + m * 16 - 256) * 256 + cl;
#pragma unroll
          for (int bj = 0; bj < 2; ++bj) { *(f32x4*)(p + bj * 128) = acc[ai][bj][m][0]; *(f32x4*)(p + bj * 128 + 4) = acc[ai][bj][m][1]; } }
    } else if (pn == 1 || pn >= 6) {
      bf16_t* dst; int ld, roff = 256, coff = 0; bool act = true;
      size_t hstride = 128;
      if (pn == 1) { dst = AG; ld = 256; } else if (pn == 6) { dst = V; ld = 128; roff = 0; act = false; hstride = (size_t)LK * 128; } else { dst = BG; ld = 768; coff = (pn - 7) * 256; }
#pragma unroll
      for (int ai = 0; ai < 2; ++ai)
#pragma unroll
        for (int m = 0; m < 4; ++m) { bf16_t* p = dst + (size_t)(row0 + ai * 128 + m * 16 - roff) * ld + coff + cl;
#pragma unroll
          for (int bj = 0; bj < 2; ++bj) { f32x4 v0 = acc[ai][bj][m][0], v1 = acc[ai][bj][m][1];
            if (act) { v0.x = siluf(v0.x); v0.y = siluf(v0.y); v0.z = siluf(v0.z); v0.w = siluf(v0.w); v1.x = siluf(v1.x); v1.y = siluf(v1.y); v1.z = siluf(v1.z); v1.w = siluf(v1.w); }
            u32x4 w; w.x = pk2(v0.x, v0.y); w.y = pk2(v0.z, v0.w); w.z = pk2(v1.x, v1.y); w.w = pk2(v1.z, v1.w);
            *(u32x4*)(p + bj * hstride) = w; } }
    } else {
#pragma unroll
      for (int ai = 0; ai < 2; ++ai)
#pragma unroll
        for (int m = 0; m < 4; ++m)
#pragma unroll
          for (int bj = 0; bj < 2; ++bj) { const f32x4 x0 = acc[ai][bj][m][0], x1 = acc[ai][bj][m][1];
            float s = x0.x * x0.x + x0.y * x0.y + x0.z * x0.z + x0.w * x0.w + x1.x * x1.x + x1.y * x1.y + x1.z * x1.z + x1.w * x1.w;
            s += __shfl_xor(s, 16); s += __shfl_xor(s, 32);
            if (fq == 0) xs[(bj * 256 + ai * 128 + m * 16 + rl0) * 4 + wc] = s; }
      __syncthreads();
      const bool isk = (pn == 5); const float* gw = isk ? kg : qg;
      const int axis = wc >> 1, f0 = 4 * ((4 * wc + fq) & 7);
      const f32x4 g0 = *(const f32x4*)(gw + axis * 64 + f0), g1 = *(const f32x4*)(gw + axis * 64 + 32 + f0);
      bf16_t* dst = isk ? K : Q; const int ld = isk ? 128 : 768, coff = isk ? 0 : (pn - 2) * 256, roff = isk ? 0 : 256; const size_t hstride = isk ? (size_t)LK * 128 : 128;
#pragma unroll
      for (int ai = 0; ai < 2; ++ai)
#pragma unroll
        for (int m = 0; m < 4; ++m) { const int row = row0 + ai * 128 + m * 16, tok = row - 256;
          f32x4 cs0 = {1.f, 0.f, 1.f, 0.f}, cs1 = {1.f, 0.f, 1.f, 0.f};
          if (tok >= 0) { const int pos = axis ? (tok & 63) : (tok >> 6); const float* rp = (const float*)(rope + pos * 32 + f0); cs0 = *(const f32x4*)rp; cs1 = *(const f32x4*)(rp + 4); }
#pragma unroll
          for (int bj = 0; bj < 2; ++bj) { const f32x4 t = *(const f32x4*)(xs + (bj * 256 + ai * 128 + m * 16 + rl0) * 4);
            const float rinv = rsqrtf((t.x + t.y + t.z + t.w) * (1.f / 128.f) + EPS);
            const f32x4 av = acc[ai][bj][m][0] * rinv * g0, bv = acc[ai][bj][m][1] * rinv * g1;
            const float o00 = av.x * cs0.x - bv.x * cs0.y, o10 = bv.x * cs0.x + av.x * cs0.y;
            const float o01 = av.y * cs0.z - bv.y * cs0.w, o11 = bv.y * cs0.z + av.y * cs0.w;
            const float o02 = av.z * cs1.x - bv.z * cs1.y, o12 = bv.z * cs1.x + av.z * cs1.y;
            const float o03 = av.w * cs1.z - bv.w * cs1.w, o13 = bv.w * cs1.z + av.w * cs1.w;
            u32x4 w; w.x = pk2(o00, o01); w.y = pk2(o02, o03); w.z = pk2(o10, o11); w.w = pk2(o12, o13);
            *(u32x4*)(dst + (size_t)(row - roff) * ld + coff + bj * hstride + cl) = w; } }
    }
  }
};
struct EpiRes {
  static constexpr bool PERM = true, AFTER_DRAIN = false;
  const float* base; float* out; const float* gate;
  __device__ __forceinline__ void operator()(const f32x4 (&acc)[2][2][4][2], const Unit& u, int wr, int wc, int fr, int fq) const {
    const int row0 = u.pm * 256 + wr * 64 + fr, col0 = u.pn * 256 + wc * 32 + 8 * fq;
#pragma unroll
    for (int bj = 0; bj < 2; ++bj) { const f32x4 g0 = *(const f32x4*)(gate + col0 + bj * 128), g1 = *(const f32x4*)(gate + col0 + bj * 128 + 4);
#pragma unroll
      for (int ai = 0; ai < 2; ++ai)
#pragma unroll
        for (int m = 0; m < 4; ++m) { const size_t o = (size_t)(row0 + ai * 128 + m * 16) * 1024 + col0 + bj * 128;
          const f32x4 b0 = *(const f32x4*)(base + o), b1 = *(const f32x4*)(base + o + 4);
          *(f32x4*)(out + o) = b0 + g0 * acc[ai][bj][m][0]; *(f32x4*)(out + o + 4) = b1 + g1 * acc[ai][bj][m][1]; } }
  }
};
template <int MODE> struct EpiResNorm {
  static constexpr bool PERM = true, AFTER_DRAIN = false; static constexpr int mode = MODE;
  const float* base; float* out; const float* gate; const float* g; const float* mod; bf16_t* H; float* psq; unsigned* cnt; float* xs;
  __device__ __forceinline__ void operator()(const f32x4 (&acc)[2][2][4][2], const Unit& u, int wr, int wc, int fr, int fq) const {
    const int rl0 = wr * 64 + fr, row0 = u.pm * 256 + rl0, col0 = u.pn * 256 + wc * 32 + 8 * fq, tid = (wr * 4 + wc) * 64 + fq * 16 + fr;
#pragma unroll
    for (int ai = 0; ai < 2; ++ai)
#pragma unroll
      for (int m = 0; m < 4; ++m) { float s = 0.f;
#pragma unroll
        for (int bj = 0; bj < 2; ++bj) { int cc = col0 + bj * 128; asm volatile("" : "+v"(cc)); const size_t o = (size_t)(row0 + ai * 128 + m * 16) * 1024 + cc;
          const f32x4 x0 = *(const f32x4*)(base + o) + *(const f32x4*)(gate + cc) * acc[ai][bj][m][0], x1 = *(const f32x4*)(base + o + 4) + *(const f32x4*)(gate + cc + 4) * acc[ai][bj][m][1];
          if (mode == 2) { *(f32x4*)(out + o) = x0; *(f32x4*)(out + o + 4) = x1; }
          s += x0.x * x0.x + x0.y * x0.y + x0.z * x0.z + x0.w * x0.w + x1.x * x1.x + x1.y * x1.y + x1.z * x1.z + x1.w * x1.w; }
        s += __shfl_xor(s, 16); s += __shfl_xor(s, 32); if (fq == 0) xs[(ai * 128 + m * 16 + rl0) * 4 + wc] = s;
        __builtin_amdgcn_sched_barrier(0); }
    __syncthreads();
    if (tid < 256) { const f32x4 t = *(const f32x4*)(xs + tid * 4); psq[(size_t)(u.pm * 256 + tid) * 4 + u.pn] = (t.x + t.y) + (t.z + t.w); }
    __threadfence(); __syncthreads();
    if (tid == 0) { __hip_atomic_fetch_add(cnt + u.pm, 1u, __ATOMIC_RELAXED, __HIP_MEMORY_SCOPE_AGENT);
      for (int it = 0; it < (1 << 22) && __hip_atomic_load(cnt + u.pm, __ATOMIC_RELAXED, __HIP_MEMORY_SCOPE_AGENT) < 4u; ++it) __builtin_amdgcn_s_sleep(1);
      __threadfence(); }
    __syncthreads();
#pragma unroll
    for (int ai = 0; ai < 2; ++ai)
#pragma unroll
      for (int m = 0; m < 4; ++m) { const float* pq = psq + (size_t)(row0 + ai * 128 + m * 16) * 4;
        const float t = (__builtin_nontemporal_load(pq) + __builtin_nontemporal_load(pq + 1)) + (__builtin_nontemporal_load(pq + 2) + __builtin_nontemporal_load(pq + 3));
        const float ri = rsqrtf(t * (1.f / 1024.f) + EPS);
#pragma unroll
        for (int bj = 0; bj < 2; ++bj) { int cc = col0 + bj * 128; asm volatile("" : "+v"(cc)); const size_t o = (size_t)(row0 + ai * 128 + m * 16) * 1024 + cc;
          const f32x4 x0 = *(const f32x4*)(base + o) + *(const f32x4*)(gate + cc) * acc[ai][bj][m][0], x1 = *(const f32x4*)(base + o + 4) + *(const f32x4*)(gate + cc + 4) * acc[ai][bj][m][1];
          f32x4 y0 = x0 * ri * *(const f32x4*)(g + cc), y1 = x1 * ri * *(const f32x4*)(g + cc + 4);
          if (mode == 2) { y0 = y0 * (*(const f32x4*)(mod + 1024 + cc) + 1.f) + *(const f32x4*)(mod + cc); y1 = y1 * (*(const f32x4*)(mod + 1024 + cc + 4) + 1.f) + *(const f32x4*)(mod + cc + 4);
            u32x4 w; w.x = pk2(y0.x, y0.y); w.y = pk2(y0.z, y0.w); w.z = pk2(y1.x, y1.y); w.w = pk2(y1.z, y1.w); *(u32x4*)(H + o) = w; }
          else { *(f32x4*)(out + o) = y0; *(f32x4*)(out + o + 4) = y1; } }
        __builtin_amdgcn_sched_barrier(0); }
  }
};
struct EpiT {
  static constexpr bool PERM = true, AFTER_DRAIN = false;
  bf16_t* O; int gated;
  __device__ __forceinline__ void operator()(const f32x4 (&acc)[2][2][4][2], const Unit& u, int wr, int wc, int fr, int fq) const {
    const int row0 = u.pm * 256 + wr * 64 + fr, col0 = u.pn * 256 + wc * 32 + 8 * fq; const bool act = gated && ((u.pm >= 9 && u.pm <= 11) || u.pm == 14);
#pragma unroll
    for (int ai = 0; ai < 2; ++ai)
#pragma unroll
      for (int m = 0; m < 4; ++m) { bf16_t* p = O + (size_t)(row0 + ai * 128 + m * 16) * L + col0;
#pragma unroll
        for (int bj = 0; bj < 2; ++bj) { f32x4 v0 = acc[ai][bj][m][0], v1 = acc[ai][bj][m][1];
          if (act) { v0.x = siluf(v0.x); v0.y = siluf(v0.y); v0.z = siluf(v0.z); v0.w = siluf(v0.w); v1.x = siluf(v1.x); v1.y = siluf(v1.y); v1.z = siluf(v1.z); v1.w = siluf(v1.w); }
          u32x4 w; w.x = pk2(v0.x, v0.y); w.y = pk2(v0.z, v0.w); w.z = pk2(v1.x, v1.y); w.w = pk2(v1.z, v1.w);
          *(u32x4*)(p + bj * 128) = w; } }
  }
};
}
namespace pg8 {
template <class Epi, class Sched, bool ALIGN_EPI = false, bool SP2 = false>
__device__ __forceinline__ void gemm_phase(PG8_LAS unsigned char* lds, const Gemm g, const Sched& S, const Epi& E, int tid_in) {
    const int tid = tid_in, wid = __builtin_amdgcn_readfirstlane(tid >> 6), lane = tid & 63, wr = wid >> 2, wc = wid & 3, fr = lane & 15, fq = lane >> 4;
    const int K = g.K, nt = K / BK;
    unsigned voffA[2], voffB[2];
#pragma unroll
    for (int i = 0; i < 2; ++i) { int R, C; stage_rc(tid * 16 + i * 8192, R, C); const int Rb = Epi::PERM ? ((R & ~31) + perm32(R & 31)) : R;
        voffA[i] = (unsigned)(R * K + C) * 2u; voffB[i] = (unsigned)(Rb * K + C) * 2u; }
    const size_t kstep = (size_t)(BK * 2);
    const size_t hstep = (size_t)HALF * K * 2;
    const size_t tstep = 2 * hstep;
    const unsigned ldsw = (unsigned)wid * 1024u;
    const int aoff = lds_byte(wr * 64 + fr, fq * 8), boff = lds_byte(wc * 32 + fr, fq * 8);
#define PG8_SA(b, h) (((b) * 2 + (h)) * HTB)
#define PG8_SB(b, h) ((4 + (b) * 2 + (h)) * HTB)
#define PG8_STAGE(bufoff, gbase, voff) do { _Pragma("unroll") for (int _i = 0; _i < 2; ++_i) \
        __builtin_amdgcn_global_load_lds((const unsigned*)((const char*)(gbase) + (voff)[_i]), (PG8_LAS unsigned*)(lds + (bufoff) + ldsw + _i * 8192), 16, 0, 0); } while (0)
#define PG8_LDA(dst, b, h) do { _Pragma("unroll") for (int m = 0; m < 4; ++m) _Pragma("unroll") for (int k = 0; k < 2; ++k) dst[m][k] = *(const PG8_LAS bf16x8*)(lds + PG8_SA(b, h) + aoff + m * 2048 + k * 1024); } while (0)
#define PG8_LDB(dst, b, h) do { _Pragma("unroll") for (int n = 0; n < 2; ++n) _Pragma("unroll") for (int k = 0; k < 2; ++k) dst[n][k] = *(const PG8_LAS bf16x8*)(lds + PG8_SB(b, h) + boff + n * 2048 + k * 1024); } while (0)
#define PG8_MMA(ai, bj, At, Bt) do { __builtin_amdgcn_s_setprio(1); _Pragma("unroll") for (int m = 0; m < 4; ++m) _Pragma("unroll") for (int n = 0; n < 2; ++n) _Pragma("unroll") for (int k = 0; k < 2; ++k) \
        acc[ai][bj][m][n] = __builtin_amdgcn_mfma_f32_16x16x32_bf16(Bt[n][k], At[m][k], acc[ai][bj][m][n], 0, 0, 0); __builtin_amdgcn_s_setprio(0); } while (0)
#define PG8_WAIT_V(n) asm volatile("s_waitcnt vmcnt(" #n ")" ::: "memory")
#define PG8_WAIT_L(n) asm volatile("s_waitcnt lgkmcnt(" #n ")" ::: "memory")
#define PG8_BAR __builtin_amdgcn_s_barrier()
#define PG8_SCHED __builtin_amdgcn_sched_barrier(0)
    Unit cur, nxt; int ui = 0;
    if (!S.next(0, cur)) return;
    f32x4 acc[2][2][4][2];
#pragma unroll
    for (int a = 0; a < 2; ++a)
#pragma unroll
        for (int b = 0; b < 2; ++b)
#pragma unroll
            for (int m = 0; m < 4; ++m)
#pragma unroll
                for (int n = 0; n < 2; ++n) acc[a][b][m][n] = (f32x4){0.f, 0.f, 0.f, 0.f};
    bf16x8 At[4][2], B0[2][2], B1[2][2];
    const char* cA = (const char*)g.A + (size_t)cur.pm * tstep; const char* cB = (const char*)g.Bt + (size_t)cur.pn * tstep;
    S.a_ready(cur);
    if constexpr (SP2) {
        PG8_STAGE(PG8_SB(0, 0), cB, voffB); PG8_STAGE(PG8_SB(0, 1), cB + hstep, voffB); PG8_STAGE(PG8_SA(0, 0), cA, voffA); PG8_STAGE(PG8_SA(0, 1), cA + hstep, voffA);
        if (wr == 1) PG8_BAR;
        PG8_WAIT_V(2); PG8_BAR;
        PG8_STAGE(PG8_SB(1, 0), cB + kstep, voffB); PG8_STAGE(PG8_SA(1, 0), cA + kstep, voffA); PG8_STAGE(PG8_SB(1, 1), cB + hstep + kstep, voffB);
        PG8_WAIT_V(6); PG8_BAR;
    } else {
        PG8_STAGE(PG8_SB(0, 0), cB, voffB); PG8_STAGE(PG8_SA(0, 0), cA, voffA); PG8_STAGE(PG8_SB(0, 1), cB + hstep, voffB); PG8_STAGE(PG8_SA(0, 1), cA + hstep, voffA);
        if (wr == 1) PG8_BAR;
        PG8_WAIT_V(4); PG8_BAR;
        PG8_STAGE(PG8_SB(1, 0), cB + kstep, voffB); PG8_STAGE(PG8_SA(1, 0), cA + kstep, voffA); PG8_STAGE(PG8_SB(1, 1), cB + hstep + kstep, voffB);
        PG8_WAIT_V(6); PG8_BAR;
    }
    for (;;) {
        const bool has_next = S.next(ui + 1, nxt);
        const char* nA = has_next ? (const char*)g.A + (size_t)nxt.pm * tstep : cA; const char* nB = has_next ? (const char*)g.Bt + (size_t)nxt.pn * tstep : cB;
        for (int t = 0; t < nt; t += 2) {
            const bool last = (t == nt - 2);
            const char* a1 = cA + (size_t)(t + 1) * kstep;
            const char* a2 = last ? nA : cA + (size_t)(t + 2) * kstep; const char* b2 = last ? nB : cB + (size_t)(t + 2) * kstep;
            const char* a3 = a2 + kstep; const char* b3 = b2 + kstep;
            if (last && has_next) S.a_ready(nxt);
            if constexpr (SP2) {
            PG8_LDB(B0, 0, 0); PG8_LDB(B1, 0, 1); PG8_SCHED; PG8_LDA(At, 0, 0); PG8_STAGE(PG8_SA(1, 1), a1 + hstep, voffA);
            PG8_WAIT_V(8); PG8_WAIT_L(0); PG8_BAR; PG8_MMA(0, 0, At, B0); PG8_MMA(0, 1, At, B1); PG8_BAR; PG8_SCHED;
            PG8_LDA(At, 0, 1); PG8_STAGE(PG8_SB(0, 0), b2, voffB); PG8_STAGE(PG8_SB(0, 1), b2 + hstep, voffB); PG8_STAGE(PG8_SA(0, 0), a2, voffA);
            PG8_WAIT_V(8); PG8_WAIT_L(0); PG8_BAR; PG8_MMA(1, 0, At, B0); PG8_MMA(1, 1, At, B1); PG8_BAR; PG8_SCHED;
            PG8_LDB(B0, 1, 0); PG8_LDB(B1, 1, 1); PG8_SCHED; PG8_LDA(At, 1, 0); PG8_STAGE(PG8_SA(0, 1), a2 + hstep, voffA);
            PG8_WAIT_V(8); PG8_WAIT_L(0); PG8_BAR; PG8_MMA(0, 0, At, B0); PG8_MMA(0, 1, At, B1); PG8_BAR; PG8_SCHED;
            PG8_LDA(At, 1, 1); PG8_STAGE(PG8_SB(1, 0), b3, voffB); PG8_STAGE(PG8_SB(1, 1), b3 + hstep, voffB); PG8_STAGE(PG8_SA(1, 0), a3, voffA);
            PG8_WAIT_V(8); PG8_WAIT_L(0); PG8_BAR; PG8_MMA(1, 0, At, B0); PG8_MMA(1, 1, At, B1); PG8_BAR; PG8_SCHED;
            } else {
            PG8_LDB(B0, 0, 0); PG8_SCHED; PG8_LDA(At, 0, 0); PG8_STAGE(PG8_SA(1, 1), a1 + hstep, voffA);
            PG8_WAIT_L(8); PG8_BAR; PG8_WAIT_L(0); PG8_MMA(0, 0, At, B0); PG8_BAR; PG8_SCHED;
            PG8_LDB(B1, 0, 1); PG8_STAGE(PG8_SB(0, 0), b2, voffB);
            PG8_BAR; PG8_WAIT_L(0); PG8_MMA(0, 1, At, B1); PG8_BAR;
            PG8_LDA(At, 0, 1); PG8_STAGE(PG8_SA(0, 0), a2, voffA);
            PG8_BAR; PG8_WAIT_L(0); PG8_MMA(1, 0, At, B0); PG8_BAR; PG8_SCHED;
            PG8_STAGE(PG8_SB(0, 1), b2 + hstep, voffB);
            PG8_WAIT_V(6); PG8_BAR; PG8_MMA(1, 1, At, B1); PG8_BAR;
            PG8_LDB(B0, 1, 0); PG8_SCHED; PG8_LDA(At, 1, 0); PG8_STAGE(PG8_SA(0, 1), a2 + hstep, voffA);
            PG8_WAIT_L(8); PG8_BAR; PG8_WAIT_L(0); PG8_MMA(0, 0, At, B0); PG8_BAR; PG8_SCHED;
            PG8_LDB(B1, 1, 1); PG8_STAGE(PG8_SB(1, 0), b3, voffB);
            PG8_BAR; PG8_WAIT_L(0); PG8_MMA(0, 1, At, B1); PG8_BAR;
            PG8_LDA(At, 1, 1); PG8_STAGE(PG8_SA(1, 0), a3, voffA);
            PG8_BAR; PG8_WAIT_L(0); PG8_MMA(1, 0, At, B0); PG8_BAR; PG8_SCHED;
            PG8_STAGE(PG8_SB(1, 1), b3 + hstep, voffB);
            PG8_WAIT_V(6); PG8_BAR; PG8_MMA(1, 1, At, B1); PG8_BAR;
            }
        }
        if constexpr (ALIGN_EPI) { if (wr == 0) PG8_BAR; }
        if constexpr (!Epi::AFTER_DRAIN) { E(acc, cur, wr, wc, fr, fq); S.done(cur); }
        if (!has_next) break;
#pragma unroll
        for (int a = 0; a < 2; ++a)
#pragma unroll
            for (int b = 0; b < 2; ++b)
#pragma unroll
                for (int m = 0; m < 4; ++m)
#pragma unroll
                    for (int n = 0; n < 2; ++n) acc[a][b][m][n] = (f32x4){0.f, 0.f, 0.f, 0.f};
        cur = nxt; cA = nA; cB = nB; ++ui;
        if constexpr (ALIGN_EPI) { if (wr == 1) PG8_BAR; }
    }
    PG8_WAIT_V(0);
    if constexpr (!ALIGN_EPI) { if (wr == 0) PG8_BAR; }
    PG8_BAR;
    if constexpr (Epi::AFTER_DRAIN) { E.fused(acc, cur, wr, wc, fr, fq, lds, wid, lane); S.done(cur); }
#undef PG8_SA
#undef PG8_SB
#undef PG8_STAGE
#undef PG8_LDA
#undef PG8_LDB
#undef PG8_MMA
#undef PG8_WAIT_V
#undef PG8_WAIT_L
#undef PG8_BAR
#undef PG8_SCHED
}
}

namespace attn {
using bf16 = __hip_bfloat16;
constexpr int   D = 128, NW = 8, QBLK = 32, KVBLK = 64;
constexpr float SCALE = 0.088388347648318440f;
constexpr float THR = 8.f;
constexpr int SDEPTH = 2;
constexpr int LDQ = 768, LDK = 128, LDO = 1024, LDG = 768;
constexpr size_t SHM_V = KVBLK * D * 2, SHM_K = KVBLK * D * 2, SHM_ATTN = 2 * SHM_V + 2 * SHM_K + NW * 64 * 4;
using bf16x8 = __attribute__((ext_vector_type(8))) short;
using s16x4  = __attribute__((ext_vector_type(4))) short;
using f32x16 = __attribute__((ext_vector_type(16))) float;
using f32x8  = __attribute__((ext_vector_type(8))) float;
using u32x4  = __attribute__((ext_vector_type(4))) unsigned;
#define KSWZ(row, colB) ((row) * 256 + ((colB) ^ (((row) & 7) << 4)))
#define SBAR() __builtin_amdgcn_sched_barrier(0)
__device__ __forceinline__ int crow(int r, int hi) { return (r & 3) + 8 * (r >> 2) + 4 * hi; }
__device__ __forceinline__ unsigned cvtpk(float lo, float hi) {
  unsigned r; asm volatile("v_cvt_pk_bf16_f32 %0, %1, %2" : "=v"(r) : "v"(lo), "v"(hi)); return r;
}
template <typename TIn> struct Stage;
template <> struct Stage<bf16>  { using T = bf16x8;
  __device__ static __forceinline__ T ld8(const bf16* p) { return *reinterpret_cast<const bf16x8*>(p); }
  __device__ static __forceinline__ bf16x8 tobf(T x) { return x; } };
template <> struct Stage<float> { using T = f32x8;
  __device__ static __forceinline__ T ld8(const float* p) { return *reinterpret_cast<const f32x8*>(p); }
  __device__ static __forceinline__ bf16x8 tobf(T x) {
    u32x4 w = {cvtpk(x[0], x[1]), cvtpk(x[2], x[3]), cvtpk(x[4], x[5]), cvtpk(x[6], x[7])}; return *reinterpret_cast<bf16x8*>(&w); } };

__device__ __forceinline__ void partialSM(f32x16& p0, f32x16& p1, float& m_reg, float& mn, float& alpha) {
  constexpr float C = SCALE * 1.4426950408889634f;
  float pmax = p0[0]; for (int r = 1; r < 16; ++r) pmax = fmaxf(pmax, p0[r]); for (int r = 0; r < 16; ++r) pmax = fmaxf(pmax, p1[r]);
  { auto rr = __builtin_amdgcn_permlane32_swap(__float_as_uint(pmax), __float_as_uint(pmax), false, false);
    pmax = fmaxf(__uint_as_float(rr[0]), __uint_as_float(rr[1])); }
  if (__builtin_expect(__all(pmax - m_reg <= THR / SCALE), 1)) { mn = m_reg; alpha = 1.f; }
  else { mn = fmaxf(m_reg, pmax); alpha = __builtin_amdgcn_exp2f((m_reg - mn) * C); m_reg = mn; }
  float mnC = -mn * C;
  for (int r = 0; r < 16; ++r) p0[r] = fmaf(p0[r], C, mnC); for (int r = 0; r < 16; ++r) p1[r] = fmaf(p1[r], C, mnC);
  for (int r = 0; r < 16; ++r) p0[r] = __builtin_amdgcn_exp2f(p0[r]);
}
__device__ __forceinline__ void finishSM(f32x16& p0, f32x16& p1, float alpha, float& l_reg, bf16x8& pa0, bf16x8& pa1, bf16x8& pa2, bf16x8& pa3) {
  for (int r = 0; r < 16; ++r) p1[r] = __builtin_amdgcn_exp2f(p1[r]);
  float ps = 0; for (int r = 0; r < 16; ++r) ps += p0[r]; for (int r = 0; r < 16; ++r) ps += p1[r];
  { auto rr = __builtin_amdgcn_permlane32_swap(__float_as_uint(ps), __float_as_uint(ps), false, false);
    ps = __uint_as_float(rr[0]) + __uint_as_float(rr[1]); }
  l_reg = l_reg * alpha + ps;
#define PK4(P, BASE, OUT) do { unsigned a0 = cvtpk(P[BASE + 0], P[BASE + 1]), a1 = cvtpk(P[BASE + 2], P[BASE + 3]);   \
    unsigned b0 = cvtpk(P[BASE + 4], P[BASE + 5]), b1 = cvtpk(P[BASE + 6], P[BASE + 7]);                              \
    auto r0 = __builtin_amdgcn_permlane32_swap(a0, b0, false, false); auto r1 = __builtin_amdgcn_permlane32_swap(a1, b1, false, false); \
    u32x4 w = {r0[0], r1[0], r0[1], r1[1]}; OUT = *reinterpret_cast<bf16x8*>(&w); } while (0)
  PK4(p0, 0, pa0); PK4(p0, 8, pa1); PK4(p1, 0, pa2); PK4(p1, 8, pa3);
#undef PK4
}
__device__ __forceinline__ void qkt(f32x16& p0, f32x16& p1, const bf16* Ks, const bf16x8* qr, int r32, int hi) {
  p0 = f32x16{}; p1 = f32x16{};
  for (int d0 = 0; d0 < 8; ++d0) { int cb = (d0 * 16 + hi * 8) * 2;
    bf16x8 b0 = *reinterpret_cast<const bf16x8*>((const char*)Ks + KSWZ(r32, cb));
    bf16x8 b1 = *reinterpret_cast<const bf16x8*>((const char*)Ks + KSWZ(32 + r32, cb));
    p0 = __builtin_amdgcn_mfma_f32_32x32x16_bf16(b0, qr[d0], p0, 0, 0, 0);
    p1 = __builtin_amdgcn_mfma_f32_32x32x16_bf16(b1, qr[d0], p1, 0, 0, 0); }
}
__device__ __forceinline__ int v_st(int k, int c) { const int kk = (k & ~0xC) | ((k & 4) << 1) | ((k & 8) >> 1); return ((kk >> 3) * 4 + (c >> 5)) * 512 + ((kk & 7) * 32 + (c & 31)) * 2; }
__device__ __forceinline__ int v_rd_base(int lane) { return ((lane & 3) << 3) | (((lane >> 2) & 3) << 6) | (((lane >> 4) & 1) << 5) | (((lane >> 5) & 1) << 8); }
constexpr int v_rd_off(int d0, int ks, int half) { return d0 * 512 + ks * 4096 + half * 2048; }
template <int OFF> __device__ __forceinline__ s16x4 tr_read(int vb) {
  s16x4 r; asm volatile("ds_read_b64_tr_b16 %0, %1 offset:%2" : "=&v"(r) : "v"(vb), "i"(OFF) : "memory"); return r;
}
template <int D0> __device__ __forceinline__ void pv_one(f32x16& od, int vb, bf16x8 pa0, bf16x8 pa1, bf16x8 pa2, bf16x8 pa3) {
  const s16x4 l0 = tr_read<v_rd_off(D0, 0, 0)>(vb), h0 = tr_read<v_rd_off(D0, 0, 1)>(vb), l1 = tr_read<v_rd_off(D0, 1, 0)>(vb), h1 = tr_read<v_rd_off(D0, 1, 1)>(vb);
  const s16x4 l2 = tr_read<v_rd_off(D0, 2, 0)>(vb), h2 = tr_read<v_rd_off(D0, 2, 1)>(vb), l3 = tr_read<v_rd_off(D0, 3, 0)>(vb), h3 = tr_read<v_rd_off(D0, 3, 1)>(vb);
  asm volatile("s_waitcnt lgkmcnt(0)" ::: "memory"); SBAR();
#define PK(L, H) (bf16x8){L[0], L[1], L[2], L[3], H[0], H[1], H[2], H[3]}
  od = __builtin_amdgcn_mfma_f32_32x32x16_bf16(pa0, PK(l0, h0), od, 0, 0, 0);
  od = __builtin_amdgcn_mfma_f32_32x32x16_bf16(pa1, PK(l1, h1), od, 0, 0, 0);
  od = __builtin_amdgcn_mfma_f32_32x32x16_bf16(pa2, PK(l2, h2), od, 0, 0, 0);
  od = __builtin_amdgcn_mfma_f32_32x32x16_bf16(pa3, PK(l3, h3), od, 0, 0, 0);
#undef PK
}
__device__ __forceinline__ void pv_d0(f32x16* o, int vb, bf16x8 pa0, bf16x8 pa1, bf16x8 pa2, bf16x8 pa3) {
  pv_one<0>(o[0], vb, pa0, pa1, pa2, pa3); pv_one<1>(o[1], vb, pa0, pa1, pa2, pa3); pv_one<2>(o[2], vb, pa0, pa1, pa2, pa3); pv_one<3>(o[3], vb, pa0, pa1, pa2, pa3);
}

template <bool PARTIAL>
__device__ __forceinline__ void attn_dense_body(const bf16* __restrict__ Qb, const bf16* __restrict__ Kh, const bf16* __restrict__ Vh,
                                                const bf16_t* __restrict__ Gb, bf16_t* __restrict__ Ob, int seq, char* lds,
                                                float* Pself, const float* Pother, unsigned* cnt, int tid_) {
  using TQ = bf16;
  using St = Stage<bf16>; using SQ = Stage<TQ>;
  asm volatile("" : "+v"(tid_));
  const int tid = tid_, wid = tid >> 6, lane = tid & 63, r32 = lane & 31, hi = lane >> 5;
  bf16* V_lds = (bf16*)lds; bf16* K_lds = (bf16*)(lds + 2 * SHM_V);
  float* ws = (float*)(lds + 2 * SHM_V + 2 * SHM_K) + wid * 64; float* li_l = ws; float* al_l = ws + 32;
  float m_reg = -1e30f, l_reg = 0; f32x16 o[4] = {}; bf16x8 qr[8];
  const TQ* Qw = Qb + (long)(wid * QBLK + r32) * LDQ + hi * 8;
#pragma unroll
  for (int d0 = 0; d0 < 8; ++d0) qr[d0] = SQ::tobf(SQ::ld8(Qw + d0 * 16));
  const int sr = tid >> 4, sc = (tid & 15) * 8, vst0 = v_st(sr, sc), vst1 = v_st(32 + sr, sc);
  const int vb0 = (int)(uintptr_t)V_lds + v_rd_base(lane);
  struct { typename St::T vs0, vs1, ks0, ks1; } sr_[SDEPTH];
  const unsigned so0 = (unsigned)(sr * LDK + sc), so1 = (unsigned)((32 + sr) * LDK + sc);
#define SLOAD(i, k0) do { const bf16* Vt_ = Vh + (long)(k0) * LDK; const bf16* Kt_ = Kh + (long)(k0) * LDK; \
    sr_[i].vs0 = St::ld8(Vt_ + so0); sr_[i].vs1 = St::ld8(Vt_ + so1); sr_[i].ks0 = St::ld8(Kt_ + so0); sr_[i].ks1 = St::ld8(Kt_ + so1); } while (0)
#define SWRITE(b, i) do { *(bf16x8*)((char*)V_lds + (b) * SHM_V + vst0) = St::tobf(sr_[i].vs0);          \
    *(bf16x8*)((char*)V_lds + (b) * SHM_V + vst1) = St::tobf(sr_[i].vs1); int kc = sc * 2;               \
    *(bf16x8*)((char*)K_lds + (b) * SHM_K + KSWZ(sr, kc)) = St::tobf(sr_[i].ks0);                       \
    *(bf16x8*)((char*)K_lds + (b) * SHM_K + KSWZ(32 + sr, kc)) = St::tobf(sr_[i].ks1); } while (0)
#define SWAIT() do { if constexpr (SDEPTH == 2) asm volatile("s_waitcnt vmcnt(4)" ::: "memory"); else asm volatile("s_waitcnt vmcnt(0)" ::: "memory"); } while (0)
#define RESC(a) do { if (__any((a) < 1.f)) { if (hi == 0) al_l[r32] = (a); asm volatile("s_waitcnt lgkmcnt(0)" ::: "memory"); \
    for (int d = 0; d < 4; ++d) for (int r = 0; r < 16; ++r) o[d][r] *= al_l[crow(r, hi)]; } } while (0)
  f32x16 pA0, pA1, pB0, pB1; float mnA, mnB, alA, alB; bf16x8 pa0, pa1, pa2, pa3; const int NT = seq / KVBLK;
  constexpr int SE = 0, SO = SDEPTH - 1;
  SLOAD(SE, 0); asm volatile("s_waitcnt vmcnt(0)" ::: "memory"); SWRITE(0, SE); __syncthreads();
  qkt(pA0, pA1, K_lds, qr, r32, hi); partialSM(pA0, pA1, m_reg, mnA, alA);
  SLOAD(SO, KVBLK); if constexpr (SDEPTH == 2) { if (2 < NT) SLOAD(SE, 2 * KVBLK); }
  SWAIT(); SWRITE(1, SO); __syncthreads();
  for (int j = 1; j + 1 < NT; j += 2) {
    SBAR(); qkt(pB0, pB1, (bf16*)((char*)K_lds + SHM_K), qr, r32, hi);
    finishSM(pA0, pA1, alA, l_reg, pa0, pa1, pa2, pa3); SBAR();
    SLOAD(SO, (j + SDEPTH) * KVBLK); SBAR();
    pv_d0(o, vb0, pa0, pa1, pa2, pa3); partialSM(pB0, pB1, m_reg, mnB, alB);
    __syncthreads(); SWAIT(); SWRITE(0, SE);
    RESC(alB); __syncthreads();
    SBAR(); qkt(pA0, pA1, K_lds, qr, r32, hi);
    finishSM(pB0, pB1, alB, l_reg, pa0, pa1, pa2, pa3); SBAR();
    if (SDEPTH == 1 || j + 3 < NT) SLOAD(SE, (j + 1 + SDEPTH) * KVBLK); SBAR();
    pv_d0(o, vb0 + (int)SHM_V, pa0, pa1, pa2, pa3); partialSM(pA0, pA1, m_reg, mnA, alA);
    __syncthreads(); SWAIT(); SWRITE(1, SO);
    RESC(alA); __syncthreads();
  }
  SBAR(); qkt(pB0, pB1, (bf16*)((char*)K_lds + SHM_K), qr, r32, hi);
  finishSM(pA0, pA1, alA, l_reg, pa0, pa1, pa2, pa3); SBAR();
  pv_d0(o, vb0, pa0, pa1, pa2, pa3); partialSM(pB0, pB1, m_reg, mnB, alB);
  __syncthreads(); RESC(alB);
  finishSM(pB0, pB1, alB, l_reg, pa0, pa1, pa2, pa3); SBAR();
  pv_d0(o, vb0 + (int)SHM_V, pa0, pa1, pa2, pa3);
  if constexpr (!PARTIAL) {
  if (hi == 0) li_l[r32] = l_reg; asm volatile("s_waitcnt lgkmcnt(0)" ::: "memory");
  float rli[16];
#pragma unroll
  for (int r = 0; r < 16; ++r) rli[r] = __builtin_amdgcn_rcpf(li_l[crow(r, hi)]);
  const bf16_t* Gw = Gb + (long)(wid * QBLK) * LDG; bf16_t* Ow = Ob + (long)(wid * QBLK) * LDO;
#pragma unroll
  for (int r = 0; r < 16; ++r) { int orow = crow(r, hi);
    for (int d0 = 0; d0 < 4; ++d0) { const float gt = bf2f(Gw[(long)orow * LDG + d0 * 32 + r32]); Ow[(long)orow * LDO + d0 * 32 + r32] = (bf16_t)f2bf(o[d0][r] * rli[r] * gt); }
    if ((r & 3) == 3) __builtin_amdgcn_sched_barrier(0); }
  } else {
    constexpr float C = SCALE * 1.4426950408889634f;
    { float* Pw = Pself + (long)(wid * QBLK) * 128;
#pragma unroll
      for (int r = 0; r < 16; ++r) { const int orow = crow(r, hi);
        for (int d0 = 0; d0 < 4; ++d0) Pw[orow * 128 + d0 * 32 + r32] = o[d0][r];
        if ((r & 3) == 3) __builtin_amdgcn_sched_barrier(0); }
      if (hi == 0) { Pself[256 * 128 + wid * QBLK + r32] = m_reg; Pself[256 * 128 + 256 + wid * QBLK + r32] = l_reg; } }
    __threadfence(); __syncthreads();
    volatile unsigned* flag = (volatile unsigned*)(lds + SHM_ATTN);
    if (tid == 0) *flag = atomicAdd(cnt, 1u);
    __syncthreads();
    if (*flag == 1u) {
      __threadfence();
      const float m2 = __builtin_nontemporal_load(Pother + 256 * 128 + wid * QBLK + r32), l2 = __builtin_nontemporal_load(Pother + 256 * 128 + 256 + wid * QBLK + r32);
      const float M = fmaxf(m_reg, m2), a1 = __builtin_amdgcn_exp2f((m_reg - M) * C), a2 = __builtin_amdgcn_exp2f((m2 - M) * C), inv = __builtin_amdgcn_rcpf(l_reg * a1 + l2 * a2);
      if (hi == 0) { li_l[r32] = a1 * inv; al_l[r32] = a2 * inv; } asm volatile("s_waitcnt lgkmcnt(0)" ::: "memory");
      const float* Po = Pother + (long)(wid * QBLK) * 128; const bf16_t* Gw = Gb + (long)(wid * QBLK) * LDG; bf16_t* Ow = Ob + (long)(wid * QBLK) * LDO;
#pragma unroll
      for (int r = 0; r < 16; ++r) { const int orow = crow(r, hi); const float w1 = li_l[orow], w2 = al_l[orow];
        for (int d0 = 0; d0 < 4; ++d0) { const float gt = bf2f(Gw[(long)orow * LDG + d0 * 32 + r32]); const float ov = __builtin_nontemporal_load(Po + orow * 128 + d0 * 32 + r32);
          Ow[(long)orow * LDO + d0 * 32 + r32] = (bf16_t)f2bf((o[d0][r] * w1 + ov * w2) * gt); }
        if ((r & 3) == 3) __builtin_amdgcn_sched_barrier(0); }
    }
    __syncthreads();
  }
#undef SLOAD
#undef SWRITE
#undef SWAIT
#undef RESC
}

#undef KSWZ
#undef SBAR
}

__device__ __forceinline__ void pool_phase(const float* __restrict__ AV, const bf16_t* __restrict__ AG, bf16_t* __restrict__ MIX, unsigned* ctr, volatile unsigned* slot, int tid) {
  const int c4 = (tid & 63) * 4, tg = tid >> 6, w2 = 1 << (c4 >> 6);
  for (;;) {
    __syncthreads();
    if (tid == 0) *slot = atomicAdd(ctr, 1u);
    __syncthreads();
    const int item = (int)*slot;
    if (item >= L / 32) break;
#pragma unroll 1
    for (int q = 0; q < 4; ++q) { const int t = item * 32 + tg * 4 + q;
      const int lo = max(t - w2, 0), hi = min(t + w2, L);
      f32x4 s = {0.f, 0.f, 0.f, 0.f};
      for (int u = lo; u < hi; ++u) s += *(const f32x4*)(AV + (size_t)u * 256 + c4);
      const f32x4 me = *(const f32x4*)(AV + (size_t)t * 256 + c4); const float ic = 1.f / (float)(hi - lo);
      const u32x2 gw = *(const u32x2*)(AG + (size_t)t * 256 + c4);
      const float g0 = __uint_as_float(gw.x << 16), g1 = __uint_as_float(gw.x & 0xffff0000u), g2 = __uint_as_float(gw.y << 16), g3 = __uint_as_float(gw.y & 0xffff0000u);
      u32x2 w; w.x = pk2((s.x * ic - me.x) * g0, (s.y * ic - me.y) * g1); w.y = pk2((s.z * ic - me.z) * g2, (s.w * ic - me.w) * g3);
      *(u32x2*)(MIX + (size_t)t * 1024 + c4) = w; }
  }
}

__device__ __forceinline__ void prep_queue(const Args& a, unsigned* ctr, volatile unsigned* slot, float* lds, int tid) {
  for (;;) {
    __syncthreads();
    if (tid == 0) *slot = atomicAdd(ctr, 1u);
    __syncthreads();
    int item = (int)*slot;
    if (item < 128) { fold_item(a, item, lds, tid); continue; }
    item -= 128;
    if (item >= prep::N_LATE) break;
    prep_item(a, prep::late_item(item), lds, tid);
  }
}

#define PADI(i) ((i) + ((i) >> 5))
__device__ __forceinline__ float2 cadd(float2 a, float2 b) { return make_float2(a.x + b.x, a.y + b.y); }
__device__ __forceinline__ float2 csub(float2 a, float2 b) { return make_float2(a.x - b.x, a.y - b.y); }
__device__ __forceinline__ float2 cmul(float2 a, float2 b) { return make_float2(a.x * b.x - a.y * b.y, a.x * b.y + a.y * b.x); }
__device__ constexpr float W32C[16] = {1.f, 0.98078528040323043f, 0.92387953251128674f, 0.83146961230254524f, 0.70710678118654752f, 0.55557023301960218f, 0.38268343236508977f, 0.19509032201612825f,
                                       0.f, -0.19509032201612825f, -0.38268343236508977f, -0.55557023301960218f, -0.70710678118654752f, -0.83146961230254524f, -0.92387953251128674f, -0.98078528040323043f};
__device__ constexpr float W32S[16] = {0.f, 0.19509032201612825f, 0.38268343236508977f, 0.55557023301960218f, 0.70710678118654752f, 0.83146961230254524f, 0.92387953251128674f, 0.98078528040323043f,
                                       1.f, 0.98078528040323043f, 0.92387953251128674f, 0.83146961230254524f, 0.70710678118654752f, 0.55557023301960218f, 0.38268343236508977f, 0.19509032201612825f};
template <int S, bool INV>
__device__ __forceinline__ void fft_pass8(float2* cb, const float2* twL, int tid) {
  static_assert(S % 32 == 0, "constant LDS offsets need S % 32 == 0");
  constexpr float R = 0.70710678118654752f;
  constexpr int ES = S + S / 32;
#pragma unroll 2
  for (int it = 0; it < 4; ++it) {
    const int u = it * 512 + tid, j = u & (S - 1), base = ((u & ~(S - 1)) << 3) + j;
    float2* p = cb + PADI(base);
    float2 x[8];
#pragma unroll
    for (int e = 0; e < 8; ++e) x[e] = p[e * ES];
    float2 t1 = twL[j * (2048 / S)]; if (INV) t1.y = -t1.y;
    const float2 t2 = cmul(t1, t1), t3 = cmul(t2, t2);
    float2 w8[4]; w8[0] = t1;
    if (!INV) { w8[1] = cmul(t1, make_float2(R, -R)); w8[2] = make_float2(t1.y, -t1.x); w8[3] = cmul(t1, make_float2(-R, -R)); }
    else      { w8[1] = cmul(t1, make_float2(R, R));  w8[2] = make_float2(-t1.y, t1.x); w8[3] = cmul(t1, make_float2(-R, R)); }
    float2 w4[2]; w4[0] = t2; w4[1] = INV ? make_float2(-t2.y, t2.x) : make_float2(t2.y, -t2.x);
    if (!INV) {
#pragma unroll
      for (int e = 0; e < 4; ++e) { const float2 a = x[e], c = x[e + 4]; x[e] = cadd(a, c); x[e + 4] = cmul(csub(a, c), w8[e]); }
#pragma unroll
      for (int q = 0; q < 8; q += 4)
#pragma unroll
        for (int e = 0; e < 2; ++e) { const float2 a = x[q + e], c = x[q + e + 2]; x[q + e] = cadd(a, c); x[q + e + 2] = cmul(csub(a, c), w4[e]); }
#pragma unroll
      for (int q = 0; q < 8; q += 2) { const float2 a = x[q], c = x[q + 1]; x[q] = cadd(a, c); x[q + 1] = cmul(csub(a, c), t3); }
    } else {
#pragma unroll
      for (int q = 0; q < 8; q += 2) { const float2 a = x[q], c = cmul(x[q + 1], t3); x[q] = cadd(a, c); x[q + 1] = csub(a, c); }
#pragma unroll
      for (int q = 0; q < 8; q += 4)
#pragma unroll
        for (int e = 0; e < 2; ++e) { const float2 a = x[q + e], c = cmul(x[q + e + 2], w4[e]); x[q + e] = cadd(a, c); x[q + e + 2] = csub(a, c); }
#pragma unroll
      for (int e = 0; e < 4; ++e) { const float2 a = x[e], c = cmul(x[e + 4], w8[e]); x[e] = cadd(a, c); x[e + 4] = csub(a, c); }
    }
#pragma unroll
    for (int e = 0; e < 8; ++e) p[e * ES] = x[e];
  }
  __syncthreads();
}
template <bool INV>
__device__ __forceinline__ void fft_pass32(float2* cb, int tid) {
  float2* p = cb + 33 * tid;
  float2 x[32];
#pragma unroll
  for (int e = 0; e < 32; ++e) x[e] = p[e];
  if (!INV) {
#pragma unroll
    for (int h = 16; h >= 1; h >>= 1)
#pragma unroll
      for (int b = 0; b < 32; b += 2 * h)
#pragma unroll
        for (int q = 0; q < h; ++q) { const float2 a = x[b + q], c = x[b + q + h], d = csub(a, c); x[b + q] = cadd(a, c);
          const int k = q * (16 / h);
          if (k == 0) x[b + q + h] = d; else if (k == 8) x[b + q + h] = make_float2(d.y, -d.x); else x[b + q + h] = cmul(d, make_float2(W32C[k], -W32S[k])); }
  } else {
#pragma unroll
    for (int h = 1; h <= 16; h <<= 1)
#pragma unroll
      for (int b = 0; b < 32; b += 2 * h)
#pragma unroll
        for (int q = 0; q < h; ++q) { const float2 a = x[b + q], c0 = x[b + q + h]; float2 c;
          const int k = q * (16 / h);
          if (k == 0) c = c0; else if (k == 8) c = make_float2(-c0.y, c0.x); else c = cmul(c0, make_float2(W32C[k], W32S[k]));
          x[b + q] = cadd(a, c); x[b + q + h] = csub(a, c); }
  }
#pragma unroll
  for (int e = 0; e < 32; ++e) p[e] = x[e];
  __syncthreads();
}
__device__ __forceinline__ void fft_fwd(float2* cb, const float2* twL, int tid) {
  fft_pass8<2048, false>(cb, twL, tid); fft_pass8<256, false>(cb, twL, tid); fft_pass8<32, false>(cb, twL, tid); fft_pass32<false>(cb, tid);
}
__device__ __forceinline__ void fft_inv(float2* cb, const float2* twL, int tid) {
  fft_pass32<true>(cb, tid); fft_pass8<32, true>(cb, twL, tid); fft_pass8<256, true>(cb, twL, tid); fft_pass8<2048, true>(cb, twL, tid);
}
template <bool ODD>
__device__ __forceinline__ void fft_pointwise(float2* cb, int tid) {
#pragma unroll 1
  for (int j = 0; j < (ODD ? 16 : 32); ++j) {
    const int p = j * 512 + tid;
    int pp;
    if (ODD) pp = 16383 - p; else pp = (p < 2) ? p : (p ^ ((1 << (31 - __clz(p))) - 1));
    if (p <= pp) {
      const float2 C = cb[PADI(p)], C2 = cb[PADI(pp)];
      const float2 Z = make_float2(0.5f * (C.x + C2.x), 0.5f * (C.y - C2.y)), K = make_float2(0.5f * (C.y + C2.y), -0.5f * (C.x - C2.x));
      const float2 Y = cmul(Z, K);
      cb[PADI(p)] = Y; cb[PADI(pp)] = make_float2(Y.x, -Y.y);
    }
  }
  __syncthreads();
}
__device__ __forceinline__ float conv3_at(const bf16_t* __restrict__ row, int t, float w0, float w1, float w2, float b) {
  const unsigned tm = (unsigned)max(t - 1, 0), tp = (unsigned)min(t + 1, L - 1); float um = bf2f(row[tm]), up = bf2f(row[tp]); const float u0 = bf2f(row[(unsigned)t]);
  um = t > 0 ? um : 0.f; up = t < L - 1 ? up : 0.f;
  return w0 * um + w1 * u0 + w2 * up + b;
}


namespace mf {
typedef short bf16x8 __attribute__((ext_vector_type(8)));
typedef short bf16x4 __attribute__((ext_vector_type(4)));
constexpr int RS = 272, PL = 128 * RS;
constexpr int O_DRE = 0, O_DIM = PL, O_FRE = 2 * PL, O_FIM = 3 * PL, O_TWA = 4 * PL, O_TWB = 4 * PL + 1024, O_RED = 4 * PL + 2048;
__device__ __forceinline__ bf16x4 tr_rd(unsigned addr) { bf16x4 r; asm volatile("ds_read_b64_tr_b16 %0, %1" : "=&v"(r) : "v"(addr) : "memory"); return r; }
__device__ __forceinline__ bf16x8 negv(bf16x8 v) { u32x4 t = __builtin_bit_cast(u32x4, v); t.x ^= 0x80008000u; t.y ^= 0x80008000u; t.z ^= 0x80008000u; t.w ^= 0x80008000u; return __builtin_bit_cast(bf16x8, t); }
__device__ __forceinline__ bf16x8 cat(bf16x4 a, bf16x4 b) { return (bf16x8){a[0], a[1], a[2], a[3], b[0], b[1], b[2], b[3]}; }
__device__ __forceinline__ float2 twid(const char* lds, int idx, bool inv) {
  const float2 ta = ((const float2*)(lds + O_TWA))[idx >> 7], tb = ((const float2*)(lds + O_TWB))[idx & 127];
  float2 w = make_float2(ta.x * tb.x - ta.y * tb.y, ta.x * tb.y + ta.y * tb.x); if (inv) w.y = -w.y; return w;
}
template <bool INV, bool TW, int OUT>
__device__ __forceinline__ void dft_cols(char* lds, const float2* __restrict__ TW2, int tid) {
  const int lane = tid & 63, w = tid >> 6, g = lane >> 4, n16 = lane & 15, q = n16 >> 2, p = lane & 3;
  const unsigned base = (unsigned)(uintptr_t)lds;
  bf16x8 bre[4], bim[4];
  { bf16x4 t0[4], t1[4], u0[4], u1[4];
#pragma unroll
    for (int ks = 0; ks < 4; ++ks) { const unsigned a0 = base + RS * (32 * ks + 8 * g + q) + 16 * (2 * w + (p >> 1)) + 8 * (p & 1), a1 = a0 + 4 * RS;
      t0[ks] = tr_rd(a0 + O_DRE); t1[ks] = tr_rd(a1 + O_DRE); u0[ks] = tr_rd(a0 + O_DIM); u1[ks] = tr_rd(a1 + O_DIM); }
    asm volatile("s_waitcnt lgkmcnt(0)" ::: "memory"); __builtin_amdgcn_sched_barrier(0);
#pragma unroll
    for (int ks = 0; ks < 4; ++ks) { bre[ks] = cat(t0[ks], t1[ks]); bim[ks] = cat(u0[ks], u1[ks]); } }
  if (OUT != 0) __syncthreads();
  bf16x8 x2[4], x3[4];
#pragma unroll
  for (int ks = 0; ks < 4; ++ks) { x2[ks] = INV ? bim[ks] : negv(bim[ks]); x3[ks] = INV ? negv(bre[ks]) : bre[ks]; }
#pragma unroll 2
  for (int rb = 0; rb < 8; ++rb) {
    f32x4 dre = {0.f, 0.f, 0.f, 0.f}, dim = {0.f, 0.f, 0.f, 0.f};
    const char* fr = lds + O_FRE + RS * (n16 + 16 * rb) + 16 * g; const char* fi = fr + PL;
#pragma unroll
    for (int ks = 0; ks < 4; ++ks) { const bf16x8 afr = *(const bf16x8*)(fr + 64 * ks), afi = *(const bf16x8*)(fi + 64 * ks);
      dre = __builtin_amdgcn_mfma_f32_16x16x32_bf16(bre[ks], afr, dre, 0, 0, 0); dre = __builtin_amdgcn_mfma_f32_16x16x32_bf16(x2[ks], afi, dre, 0, 0, 0);
      if (OUT != 1) { dim = __builtin_amdgcn_mfma_f32_16x16x32_bf16(bim[ks], afr, dim, 0, 0, 0); dim = __builtin_amdgcn_mfma_f32_16x16x32_bf16(x3[ks], afi, dim, 0, 0, 0); } }
    const int row = 16 * rb + n16, c0 = 16 * w + 4 * g;
    float vr[4], vi[4];
#pragma unroll
    for (int r = 0; r < 4; ++r) { vr[r] = dre[r]; vi[r] = dim[r];
      if (TW) { const float2 t = twid(lds, row * (c0 + r), INV); const float a = vr[r] * t.x - vi[r] * t.y, b = vr[r] * t.y + vi[r] * t.x; vr[r] = a; vi[r] = b; } }
    if (OUT == 0) { u32x2 wr_, wi_; wr_.x = pk2(vr[0], vr[1]); wr_.y = pk2(vr[2], vr[3]); wi_.x = pk2(vi[0], vi[1]); wi_.y = pk2(vi[2], vi[3]);
      *(u32x2*)(lds + O_DRE + RS * row + 2 * c0) = wr_; *(u32x2*)(lds + O_DIM + RS * row + 2 * c0) = wi_; }
    else if (OUT == 1) { *(f32x4*)((float*)lds + 128 * row + c0) = (f32x4){vr[0], vr[1], vr[2], vr[3]}; }
    else { const f32x4 ta = *(const f32x4*)(TW2 + 128 * row + c0), tb = *(const f32x4*)(TW2 + 128 * row + c0 + 2);
      *(f32x4*)((float*)lds + 128 * row + c0) = (f32x4){vr[0] * ta.x + vi[0] * ta.y, vr[1] * ta.z + vi[1] * ta.w, vr[2] * tb.x + vi[2] * tb.y, vr[3] * tb.z + vi[3] * tb.w}; }
  }
  __syncthreads();
}
template <bool INV, bool TW>
__device__ __forceinline__ void dft_rows(char* lds, int tid) {
  const int lane = tid & 63, w = tid >> 6, g = lane >> 4, n16 = lane & 15;
  bf16x8 are[4], aim[4], x2[4], x3[4];
  { const char* pr = lds + O_DRE + RS * (n16 + 16 * w) + 16 * g; const char* pi = pr + PL;
#pragma unroll
    for (int ks = 0; ks < 4; ++ks) { are[ks] = *(const bf16x8*)(pr + 64 * ks); aim[ks] = *(const bf16x8*)(pi + 64 * ks); x2[ks] = INV ? aim[ks] : negv(aim[ks]); x3[ks] = INV ? negv(are[ks]) : are[ks]; } }
#pragma unroll 2
  for (int cbk = 0; cbk < 8; ++cbk) {
    f32x4 dre = {0.f, 0.f, 0.f, 0.f}, dim = {0.f, 0.f, 0.f, 0.f};
    const char* fr = lds + O_FRE + RS * (n16 + 16 * cbk) + 16 * g; const char* fi = fr + PL;
#pragma unroll
    for (int ks = 0; ks < 4; ++ks) { const bf16x8 bfr = *(const bf16x8*)(fr + 64 * ks), bfi = *(const bf16x8*)(fi + 64 * ks);
      dre = __builtin_amdgcn_mfma_f32_16x16x32_bf16(bfr, are[ks], dre, 0, 0, 0); dre = __builtin_amdgcn_mfma_f32_16x16x32_bf16(bfi, x2[ks], dre, 0, 0, 0);
      dim = __builtin_amdgcn_mfma_f32_16x16x32_bf16(bfi, x3[ks], dim, 0, 0, 0); dim = __builtin_amdgcn_mfma_f32_16x16x32_bf16(bfr, aim[ks], dim, 0, 0, 0); }
    const int row = 16 * w + n16, c0 = 16 * cbk + 4 * g;
    float vr[4], vi[4];
#pragma unroll
    for (int r = 0; r < 4; ++r) { vr[r] = dre[r]; vi[r] = dim[r];
      if (TW) { const float2 t = twid(lds, row * (c0 + r), INV); const float a = vr[r] * t.x - vi[r] * t.y, b = vr[r] * t.y + vi[r] * t.x; vr[r] = a; vi[r] = b; } }
    u32x2 wr_, wi_; wr_.x = pk2(vr[0], vr[1]); wr_.y = pk2(vr[2], vr[3]); wi_.x = pk2(vi[0], vi[1]); wi_.y = pk2(vi[2], vi[3]);
    *(u32x2*)(lds + O_DRE + RS * row + 2 * c0) = wr_; *(u32x2*)(lds + O_DIM + RS * row + 2 * c0) = wi_;
  }
  __syncthreads();
}
template <bool ODD>
__device__ __forceinline__ void pointwise(char* lds, int tid) {
#pragma unroll 1
  for (int j = 0; j < (ODD ? 16 : 17); ++j) {
    const int pq = j * 512 + tid;
    int k1, k2, q1, q2; bool act = true;
    if (ODD) { k1 = pq >> 7; k2 = pq & 127; q1 = 127 - k1; q2 = 127 - k2; }
    else if (pq < 8064) { k1 = 1 + (pq >> 7); k2 = pq & 127; q1 = 128 - k1; q2 = 127 - k2; }
    else if (pq < 8192) { k1 = 0; k2 = pq - 8064; q1 = 0; q2 = (128 - k2) & 127; act = k2 <= q2; }
    else if (pq < 8320) { k1 = 64; k2 = pq - 8192; q1 = 64; q2 = 127 - k2; act = k2 <= q2; }
    else { k1 = k2 = q1 = q2 = 0; act = false; }
    if (act) {
      bf16_t* r0 = (bf16_t*)(lds + O_DRE + RS * k1 + 2 * k2); bf16_t* i0 = (bf16_t*)(lds + O_DIM + RS * k1 + 2 * k2);
      bf16_t* r1 = (bf16_t*)(lds + O_DRE + RS * q1 + 2 * q2); bf16_t* i1 = (bf16_t*)(lds + O_DIM + RS * q1 + 2 * q2);
      const float cx = bf2f(*r0), cy = bf2f(*i0), dx = bf2f(*r1), dy = bf2f(*i1);
      const float zx = 0.5f * (cx + dx), zy = 0.5f * (cy - dy), kx = 0.5f * (cy + dy), ky = -0.5f * (cx - dx);
      const float yx = zx * kx - zy * ky, yy = zx * ky + zy * kx;
      *r0 = (bf16_t)f2bf(yx); *i0 = (bf16_t)f2bf(yy); *r1 = (bf16_t)f2bf(yx); *i1 = (bf16_t)f2bf(-yy);
    }
  }
  __syncthreads();
}
}

__device__ __forceinline__ void conv3_pair(const bf16_t* __restrict__ row, int n0, float w0, float w1, float w2, float b, float& o0, float& o1) {
  const unsigned pr = *(const unsigned*)(row + (unsigned)n0); const float u0 = __uint_as_float(pr << 16), u1 = __uint_as_float(pr & 0xffff0000u);
  float um = bf2f(row[(unsigned)max(n0 - 1, 0)]), up = bf2f(row[(unsigned)min(n0 + 2, L - 1)]); um = n0 > 0 ? um : 0.f; up = (n0 + 2 < L) ? up : 0.f;
  o0 = w0 * um + w1 * u0 + w2 * u1 + b; o1 = w0 * u0 + w1 * u1 + w2 * up + b;
}
__device__ __forceinline__ void hyena_mfma_items(const Args& a, char* lds, int tid) {
  bf16_t* P1T = (bf16_t*)(a.ws + WS_P1T); const bf16_t* HT = (const bf16_t*)(a.ws + WS_HT);
  const float2* TW2 = (const float2*)(a.ws + WS_TW2);
  float* red = (float*)(lds + mf::O_RED); float* outf = (float*)lds;
  for (int idx = tid; idx < 16384; idx += 512) { const int r = idx >> 7, c = idx & 127, m = (r * c) & 127; float s, co; sincospif((float)m / 64.f, &s, &co);
    *(bf16_t*)(lds + mf::O_FRE + mf::RS * r + 2 * c) = (bf16_t)f2bf(co); *(bf16_t*)(lds + mf::O_FIM + mf::RS * r + 2 * c) = (bf16_t)f2bf(-s); }
  if (tid < 128) { float s, co; sincospif((float)tid / 64.f, &s, &co); ((float2*)(lds + mf::O_TWA))[tid] = make_float2(co, -s); ((float2*)(lds + mf::O_TWB))[tid] = TW2[2 * tid]; }
  __syncthreads();
  const float* cw = a.in[15]; const float* cbias = a.in[16]; const float* skip = a.in[23];
#ifndef HY_PROBE
#define HY_PROBE 0
#endif
#pragma unroll 1
  for (int pass = HY_PROBE ? 0 : 1; pass < 2; ++pass)
  for (int item = blockIdx.x; item < (pass ? 768 : 256); item += gridDim.x) {
    asm volatile("" : "+v"(tid));
    const int c = item;
    const float ad = fabsf(-3.0701134573f + (-15.350567286f + 3.0701134573f) * ((float)c * (1.f / 767.f))) * (1.f / 16383.f);
    const float dr1 = __expf(-ad);
    float z[32], acc[32];
    { const bf16_t* vr = P1T + (size_t)c * L; const float w0 = cw[c], w1 = cw[2304 + c], w2 = cw[4608 + c], b = cbias[c];
asm volatile("" : "+v"(tid));
#pragma unroll
      for (int jp = 0; jp < 16; ++jp) { if ((jp & 15) == 0) __builtin_amdgcn_sched_barrier(0); conv3_pair(vr, jp * 1024 + 2 * tid, w0, w1, w2, b, z[2 * jp], z[2 * jp + 1]); } }
#pragma unroll 1
    for (int o = 0; o < 2; ++o) {
      const bf16_t* hf = HT + (size_t)((o * 2 + 0) * 768 + c) * L; const bf16_t* hb = HT + (size_t)((o * 2 + 1) * 768 + c) * L;
      float ssum = 0.f; unsigned kst[16];
asm volatile("" : "+v"(tid));
#pragma unroll
      for (int jp = 0; jp < 16; ++jp) { if ((jp & 15) == 0) __builtin_amdgcn_sched_barrier(0); const int n0 = jp * 1024 + 2 * tid; const int nb0 = (L - n0) & (L - 1), nb1 = L - 1 - n0;
        const unsigned pf = *(const unsigned*)(hf + (unsigned)n0); const float e0 = __expf(-ad * (float)n0);
        const float f0 = __uint_as_float(pf << 16) * e0, f1 = __uint_as_float(pf & 0xffff0000u) * (e0 * dr1);
        float b0 = bf2f(hb[(unsigned)nb0]) * __expf(-ad * (float)nb0); const float b1 = bf2f(hb[(unsigned)nb1]) * __expf(-ad * (float)nb1);
        ssum += (fabsf(f0) + fabsf(b0)) + (fabsf(f1) + fabsf(b1)); b0 = n0 ? b0 : 0.f; const int off = mf::RS * (n0 >> 7) + 2 * (n0 & 127);
        *(unsigned*)(lds + mf::O_DRE + off) = pk2(z[2 * jp], z[2 * jp + 1]); *(unsigned*)(lds + mf::O_DIM + off) = pk2(f0 + b0, f1 + b1); kst[jp] = pk2(f0 - b0, f1 - b1); }
      ssum = wave_sum(ssum); if ((tid & 63) == 0) red[tid >> 6] = ssum;
      __syncthreads();
      const float nrm = EPS + ((red[0] + red[1]) + (red[2] + red[3])) + ((red[4] + red[5]) + (red[6] + red[7]));
      mf::dft_cols<false, true, 0>(lds, TW2, tid); mf::dft_rows<false, false>(lds, tid); mf::pointwise<false>(lds, tid);
      mf::dft_rows<true, true>(lds, tid); mf::dft_cols<true, false, 1>(lds, TW2, tid);
asm volatile("" : "+v"(tid));
#pragma unroll
      for (int jp = 0; jp < 16; ++jp) { if ((jp & 15) == 0) __builtin_amdgcn_sched_barrier(0); const float2 v = *(const float2*)(outf + jp * 1024 + 2 * tid); acc[2 * jp] = v.x; acc[2 * jp + 1] = v.y; }
      __syncthreads();
asm volatile("" : "+v"(tid));
#pragma unroll
      for (int jp = 0; jp < 16; ++jp) { if ((jp & 15) == 0) __builtin_amdgcn_sched_barrier(0); const int n0 = jp * 1024 + 2 * tid;
        const float k0 = __uint_as_float(kst[jp] << 16), k1 = __uint_as_float(kst[jp] & 0xffff0000u); const f32x4 w = *(const f32x4*)(TW2 + n0);
        const int off = mf::RS * (n0 >> 7) + 2 * (n0 & 127);
        *(unsigned*)(lds + mf::O_DRE + off) = pk2(z[2 * jp] * w.x - k0 * w.y, z[2 * jp + 1] * w.z - k1 * w.w);
        *(unsigned*)(lds + mf::O_DIM + off) = pk2(z[2 * jp] * w.y + k0 * w.x, z[2 * jp + 1] * w.w + k1 * w.z); }
      __syncthreads();
      mf::dft_cols<false, true, 0>(lds, TW2, tid); mf::dft_rows<false, false>(lds, tid); mf::pointwise<true>(lds, tid);
      mf::dft_rows<true, true>(lds, tid); mf::dft_cols<true, false, 2>(lds, TW2, tid);
      const bf16_t* gr = P1T + (size_t)((o + 1) * 768 + c) * L; const int gc = (o + 1) * 768 + c;
      const float w0 = cw[gc], w1 = cw[2304 + gc], w2 = cw[4608 + gc], b = cbias[gc], sk = skip[o * 768 + c], sc = (1.f / 32768.f) / nrm;
asm volatile("" : "+v"(tid));
#pragma unroll
      for (int jp = 0; jp < 16; ++jp) { if ((jp & 15) == 0) __builtin_amdgcn_sched_barrier(0); const int n0 = jp * 1024 + 2 * tid; const float2 v = *(const float2*)(outf + n0);
        float g0, g1; conv3_pair(gr, n0, w0, w1, w2, b, g0, g1);
        z[2 * jp] = g0 * ((acc[2 * jp] + v.x) * sc + sk * z[2 * jp]); z[2 * jp + 1] = g1 * ((acc[2 * jp + 1] + v.y) * sc + sk * z[2 * jp + 1]); }
      __syncthreads();
    }
    { const bf16_t* gt = P1T + (size_t)(2304 + c) * L; bf16_t* orow = pass ? P1T + (size_t)c * L : (bf16_t*)(a.ws + 126 * MiB) + (size_t)c * L;
asm volatile("" : "+v"(tid));
#pragma unroll
      for (int jp = 0; jp < 16; ++jp) { if ((jp & 15) == 0) __builtin_amdgcn_sched_barrier(0); const int n0 = jp * 1024 + 2 * tid; const unsigned pg = *(const unsigned*)(gt + (unsigned)n0);
        *(unsigned*)(orow + (unsigned)n0) = pk2(z[2 * jp] * __uint_as_float(pg << 16), z[2 * jp + 1] * __uint_as_float(pg & 0xffff0000u)); } }
#ifdef HY_EXTRA
    __syncthreads();
    for (int xr = 0; xr < HY_EXTRA; ++xr) { mf::dft_cols<false, true, 0>(lds, TW2, tid); mf::dft_rows<false, false>(lds, tid); mf::pointwise<false>(lds, tid); mf::dft_rows<true, true>(lds, tid); mf::dft_cols<true, false, 1>(lds, TW2, tid); }
#endif
  }
}

__device__ __forceinline__ void hyena_fourier_phase(const Args& a, char* lds, int tid) {
  float2* cb = (float2*)lds; float2* twL = (float2*)(lds + 135168); float* red = (float*)(lds + 135168 + 16384);
  bf16_t* P1T = (bf16_t*)(a.ws + WS_P1T); const bf16_t* HT = (const bf16_t*)(a.ws + WS_HT);
  const float2* TW2 = (const float2*)(a.ws + WS_TW2);
  for (int i = tid; i < 2048; i += 512) twL[i] = TW2[2 * i];
  __syncthreads();
  const float* cw = a.in[15]; const float* cbias = a.in[16]; const float* skip = a.in[23];
#ifndef HY_MFMA
#define HY_MFMA 1
#endif
  for (int item = (HY_MFMA ? 768 : 0) + blockIdx.x; item < 1024; item += gridDim.x) {
    asm volatile("" : "+v"(tid));
    if (item < 768) {
      const int c = item;
      const float ad = fabsf(-3.0701134573f + (-15.350567286f + 3.0701134573f) * ((float)c * (1.f / 767.f))) * (1.f / 16383.f);
      float z[32], acc[32];
      { const bf16_t* vr = P1T + (size_t)c * L; const float w0 = cw[c], w1 = cw[2304 + c], w2 = cw[4608 + c], b = cbias[c];
asm volatile("" : "+v"(tid));
#pragma unroll
        for (int j = 0; j < 32; ++j) { if ((j & 15) == 0) __builtin_amdgcn_sched_barrier(0); z[j] = conv3_at(vr, j * 512 + tid, w0, w1, w2, b); } }
#pragma unroll 1
      for (int o = 0; o < 2; ++o) {
        const bf16_t* hf = HT + (size_t)((o * 2 + 0) * 768 + c) * L; const bf16_t* hb = HT + (size_t)((o * 2 + 1) * 768 + c) * L;
        float ssum = 0.f;
asm volatile("" : "+v"(tid));
#pragma unroll
        for (int j = 0; j < 32; ++j) { if ((j & 15) == 0) __builtin_amdgcn_sched_barrier(0); const int n = j * 512 + tid; const int nb = (L - n) & (L - 1); const float f = bf2f(hf[(unsigned)n]) * __expf(-ad * (float)n); float b = bf2f(hb[(unsigned)nb]) * __expf(-ad * (float)nb);
          ssum += fabsf(f) + fabsf(b); b = n ? b : 0.f; cb[PADI(n)] = make_float2(z[j], f + b); }
        ssum = wave_sum(ssum); if ((tid & 63) == 0) red[tid >> 6] = ssum;
        __syncthreads();
        const float nrm = EPS + ((red[0] + red[1]) + (red[2] + red[3])) + ((red[4] + red[5]) + (red[6] + red[7]));
        fft_fwd(cb, twL, tid); fft_pointwise<false>(cb, tid); fft_inv(cb, twL, tid);
asm volatile("" : "+v"(tid));
#pragma unroll
        for (int j = 0; j < 32; ++j) { if ((j & 15) == 0) __builtin_amdgcn_sched_barrier(0); acc[j] = cb[PADI(j * 512 + tid)].x; }
        __syncthreads();
asm volatile("" : "+v"(tid));
#pragma unroll
        for (int j = 0; j < 32; ++j) { if ((j & 15) == 0) __builtin_amdgcn_sched_barrier(0); const int n = j * 512 + tid; const int nb = (L - n) & (L - 1); const float f = bf2f(hf[(unsigned)n]) * __expf(-ad * (float)n); float b = bf2f(hb[(unsigned)nb]) * __expf(-ad * (float)nb); b = n ? b : 0.f; const float kk = f - b; const float2 w = TW2[n];
          cb[PADI(n)] = make_float2(z[j] * w.x - kk * w.y, z[j] * w.y + kk * w.x); }
        __syncthreads();
        fft_fwd(cb, twL, tid); fft_pointwise<true>(cb, tid); fft_inv(cb, twL, tid);
        const bf16_t* gr = P1T + (size_t)((o + 1) * 768 + c) * L; const int gc = (o + 1) * 768 + c;
        const float w0 = cw[gc], w1 = cw[2304 + gc], w2 = cw[4608 + gc], b = cbias[gc], sk = skip[o * 768 + c], sc = (1.f / 32768.f) / nrm;
asm volatile("" : "+v"(tid));
#pragma unroll
        for (int j = 0; j < 32; ++j) { if ((j & 15) == 0) __builtin_amdgcn_sched_barrier(0); const int n = j * 512 + tid; const float2 r = cb[PADI(n)], w = TW2[n];
          const float cv = (acc[j] + r.x * w.x + r.y * w.y) * sc;
          z[j] = conv3_at(gr, n, w0, w1, w2, b) * (cv + sk * z[j]); }
        __syncthreads();
      }
      { const bf16_t* gt = P1T + (size_t)(2304 + c) * L; bf16_t* orow = P1T + (size_t)c * L;
asm volatile("" : "+v"(tid));
#pragma unroll
        for (int j = 0; j < 32; ++j) { if ((j & 15) == 0) __builtin_amdgcn_sched_barrier(0); const int n = j * 512 + tid; orow[n] = (bf16_t)f2bf(z[j] * bf2f(gt[n])); } }
#ifdef HY_EXTRA
      __syncthreads();
      for (int xr = 0; xr < 2; ++xr) { fft_fwd(cb, twL, tid); fft_pointwise<false>(cb, tid); fft_inv(cb, twL, tid); fft_fwd(cb, twL, tid); fft_pointwise<true>(cb, tid); fft_inv(cb, twL, tid); }
#endif
    } else {
      const int k = item - 768;
      const bf16_t* ar = P1T + (size_t)(3072 + k) * L; const bf16_t* ai = P1T + (size_t)(3328 + k) * L; const bf16_t* gt = P1T + (size_t)(3584 + k) * L;
asm volatile("" : "+v"(tid));
#pragma unroll
      for (int j = 0; j < 32; ++j) { if ((j & 15) == 0) __builtin_amdgcn_sched_barrier(0); const int n = j * 512 + tid; cb[PADI(n)] = make_float2(bf2f(ar[n]), bf2f(ai[n])); }
      __syncthreads();
      fft_fwd(cb, twL, tid);
      bf16_t* orow = P1T + (size_t)(3072 + k) * L;
asm volatile("" : "+v"(tid));
#pragma unroll
      for (int j = 0; j < 32; ++j) { if ((j & 15) == 0) __builtin_amdgcn_sched_barrier(0); const int n = j * 512 + tid; const int p = (int)(__brev((unsigned)n) >> 18); orow[n] = (bf16_t)f2bf(cb[PADI(p)].x * bf2f(gt[n])); }
      __syncthreads();
    }
  }
#if HY_MFMA
  __syncthreads();
  hyena_mfma_items(a, lds, tid);
#endif
}

__device__ __forceinline__ void transpose_phase(const bf16_t* __restrict__ P1T, bf16_t* __restrict__ MIX, char* lds, int tid) {
  bf16_t* tl = (bf16_t*)lds;
  for (int item = blockIdx.x; item < 16 * 256; item += gridDim.x) {
    const int ct = item & 15, tt = item >> 4, c0 = ct * 64, t0 = tt * 64;
    { const int ch = tid >> 3, tq = (tid & 7) * 8; const int srow = (c0 + ch) < 768 ? (c0 + ch) : (3072 + c0 + ch - 768);
      *(u32x4*)(tl + ch * 72 + tq) = *(const u32x4*)(P1T + (size_t)srow * L + t0 + tq); }
    __syncthreads();
    { const int tok = tid >> 3, cq = (tid & 7) * 8; unsigned short v[8];
#pragma unroll
      for (int e = 0; e < 8; ++e) v[e] = tl[(cq + e) * 72 + tok];
      u32x4 w; w.x = v[0] | ((unsigned)v[1] << 16); w.y = v[2] | ((unsigned)v[3] << 16); w.z = v[4] | ((unsigned)v[5] << 16); w.w = v[6] | ((unsigned)v[7] << 16);
      *(u32x4*)(MIX + (size_t)(t0 + tok) * 1024 + c0 + cq) = w; }
    __syncthreads();
  }
}

__device__ __forceinline__ void ht_phase(const bf16_t* __restrict__ W3T, const bf16_t* __restrict__ HD2, bf16_t* __restrict__ HT, int tid) {
  typedef short bf16x8 __attribute__((ext_vector_type(8)));
  typedef float f32x16 __attribute__((ext_vector_type(16)));
  const int lane = tid & 63, wid = tid >> 6, r32 = lane & 31, hi = lane >> 5;
  for (int item = blockIdx.x; item < 96 * 8; item += gridDim.x) {
    const int rb = item >> 3, tc = item & 7;
    bf16x8 af[4];
#pragma unroll
    for (int ks = 0; ks < 4; ++ks) af[ks] = *(const bf16x8*)(W3T + (size_t)(rb * 32 + r32) * 64 + ks * 16 + hi * 8);
#pragma unroll 2
    for (int tt = 0; tt < 8; ++tt) {
      const int t0 = tc * 2048 + wid * 256 + tt * 32;
      f32x16 acc = {};
#pragma unroll
      for (int ks = 0; ks < 4; ++ks) { const bf16x8 bfr = *(const bf16x8*)(HD2 + (size_t)(t0 + r32) * 64 + ks * 16 + hi * 8);
        acc = __builtin_amdgcn_mfma_f32_32x32x16_bf16(af[ks], bfr, acc, 0, 0, 0); }
#pragma unroll
      for (int r = 0; r < 16; ++r) { const int row = rb * 32 + (r & 3) + 8 * (r >> 2) + 4 * hi; HT[(size_t)row * L + t0 + r32] = (bf16_t)f2bf(acc[r]); }
    }
  }
}
__device__ __forceinline__ int lane_id_opaque() {
  int l; asm volatile("v_mbcnt_lo_u32_b32 %0, -1, 0\n\tv_mbcnt_hi_u32_b32 %0, -1, %0" : "=v"(l)); return l;
}
__global__ void __launch_bounds__(512, 2) mega_fwd(Args a) {
  extern __shared__ __attribute__((aligned(16))) unsigned char lds_raw[];
  const int wid_s = __builtin_amdgcn_readfirstlane((int)threadIdx.x >> 6);
#define MK_TID() (wid_s * 64 + lane_id_opaque())
  int tid;
  unsigned char* ws = a.ws;
  PG8_LAS unsigned char* ldsl = (PG8_LAS unsigned char*)lds_raw;
  float* xs = (float*)(lds_raw + XS_OFF);
  const float* MOD = (const float*)(ws + WS_MOD);
  const int lo = a.ph_lo, hi = a.ph_hi, G = gridDim.x, bc = blockIdx.x;
#ifndef MK_FUSE_NORM
#define MK_FUSE_NORM 0
#endif
  const bool fuse = MK_FUSE_NORM && (G == 256) && !MK_MULTI;
#ifndef PH_MASK
#define PH_MASK 0xFFF
#endif
#define IN(k) ((((PH_MASK) >> (k)) & 1) && lo <= (k) && (k) < hi)
#ifndef DBL_MASK
#define DBL_MASK 0
#endif
#define NREP(k) ((((DBL_MASK) >> (k)) & 1) ? 2 : 1)
  unsigned nbar = 0; unsigned* gbar = (unsigned*)(ws + WS_BAR);
  if (a.ph_hi < 0) cg::this_grid().sync();
#define SEAM(k) do { if (IN(k) && IN((k) + 1)) { ++nbar; __syncthreads(); if (MK_TID() == 0) { __threadfence(); __hip_atomic_fetch_add(gbar, 1u, __ATOMIC_RELAXED, __HIP_MEMORY_SCOPE_AGENT); \
      while (__hip_atomic_load(gbar, __ATOMIC_RELAXED, __HIP_MEMORY_SCOPE_AGENT) < nbar * (unsigned)G) __builtin_amdgcn_s_sleep(2); __threadfence(); } __syncthreads(); } } while (0)
  if (IN(0)) for (int rep = 0; rep < NREP(0); ++rep) { tid = MK_TID(); asm volatile("" : "+v"(tid)); p0_prep(a, (float*)lds_raw, tid); } SEAM(0);
  if (IN(1)) for (int rep = 0; rep < NREP(1); ++rep) { tid = MK_TID(); asm volatile("" : "+v"(tid)); rows_norm_mod(a.in[0], a.in[2], CTX, LK, a.in[6], MOD, MOD + 3072, (bf16_t*)(ws + WS_H), tid); } SEAM(1);
  if (IN(2)) for (int rep = 0; rep < NREP(2); ++rep) { tid = MK_TID(); asm volatile("" : "+v"(tid));
    pg8::Gemm g; g.A = (const bf16_t*)(ws + WS_H); g.Bt = (const bf16_t*)(ws + WS_WIN0); g.M = LK; g.N = 2560; g.K = 1024;
    pg8::SchedIn0 S; S.G = G; S.c = bc;
    pg8::EpiIn0 E; E.AV = (float*)(ws + WS_AV); E.AG = (bf16_t*)(ws + WS_AG); E.Q = (bf16_t*)(ws + WS_Q); E.K = (bf16_t*)(ws + WS_K); E.V = (bf16_t*)(ws + WS_V); E.BG = (bf16_t*)(ws + WS_BG);
    E.qg = a.in[11]; E.kg = a.in[12]; E.rope = (const float2*)(ws + WS_ROPE); E.xs = xs;
    pg8::gemm_phase<pg8::EpiIn0, pg8::SchedIn0, true, false>(ldsl, g, S, E, tid);
    tid = MK_TID(); asm volatile("" : "+v"(tid));
    prep_queue(a, (unsigned*)(ws + WS_CNT) + 388 + rep, (volatile unsigned*)(lds_raw + 154000), (float*)lds_raw, tid);
  } SEAM(2);
  if (IN(3)) for (int rep = 0; rep < NREP(3); ++rep) { tid = MK_TID(); asm volatile("" : "+v"(tid));
    if (G == 256) {
      const int vb = ((bc & 7) >> 2) * 128 + (bc >> 3) * 4 + (bc & 3);
      const int kvh = vb >> 7, pk = (vb & 127) >> 1, side = vb & 1, cidx = vb >> 1;
      { const int w = 3 * pk + side, h = kvh * 3 + (w % 3), qb = w / 3;
        __syncthreads();
        attn::attn_dense_body<false>((const attn::bf16*)(ws + WS_Q) + (size_t)qb * 256 * 768 + h * 128, (const attn::bf16*)(ws + WS_K) + (size_t)kvh * LK * 128, (const attn::bf16*)(ws + WS_V) + (size_t)kvh * LK * 128,
                              (const bf16_t*)(ws + WS_BG) + (size_t)qb * 256 * 768 + h * 128, (bf16_t*)(ws + WS_H) + (size_t)qb * 256 * 1024 + 256 + h * 128, LK, (char*)lds_raw, nullptr, nullptr, nullptr, MK_TID()); }
      { const int w = 3 * pk + 2, h = kvh * 3 + (w % 3), qb = w / 3; const size_t koff = (size_t)side * (LK / 2) * 128;
        float* pbase = (float*)(ws + WS_PARTIAL) + (size_t)cidx * 2 * PARTIAL_FLOATS;
        __syncthreads();
        attn::attn_dense_body<true>((const attn::bf16*)(ws + WS_Q) + (size_t)qb * 256 * 768 + h * 128, (const attn::bf16*)(ws + WS_K) + koff + (size_t)kvh * LK * 128, (const attn::bf16*)(ws + WS_V) + koff + (size_t)kvh * LK * 128,
                              (const bf16_t*)(ws + WS_BG) + (size_t)qb * 256 * 768 + h * 128, (bf16_t*)(ws + WS_H) + (size_t)qb * 256 * 1024 + 256 + h * 128, LK / 2, (char*)lds_raw,
                              pbase + (size_t)side * PARTIAL_FLOATS, pbase + (size_t)(side ^ 1) * PARTIAL_FLOATS, (unsigned*)(ws + WS_CNT) + cidx, MK_TID()); }
    } else {
      for (int item = bc; item < 384; item += G) {
        const int h = item % 6, qb = item / 6, kvh = h / 3;
        __syncthreads();
        attn::attn_dense_body<false>((const attn::bf16*)(ws + WS_Q) + (size_t)qb * 256 * 768 + h * 128, (const attn::bf16*)(ws + WS_K) + (size_t)kvh * LK * 128, (const attn::bf16*)(ws + WS_V) + (size_t)kvh * LK * 128,
                              (const bf16_t*)(ws + WS_BG) + (size_t)qb * 256 * 768 + h * 128, (bf16_t*)(ws + WS_H) + (size_t)qb * 256 * 1024 + 256 + h * 128, LK, (char*)lds_raw, nullptr, nullptr, nullptr, MK_TID());
      }
    }
    tid = MK_TID(); asm volatile("" : "+v"(tid));
    pool_phase((const float*)(ws + WS_AV), (const bf16_t*)(ws + WS_AG), (bf16_t*)(ws + WS_H), (unsigned*)(ws + WS_CNT) + 384 + rep, (volatile unsigned*)(lds_raw + 70000), tid);
  } SEAM(3);
  if (IN(4)) for (int rep = 0; rep < NREP(4); ++rep) { tid = MK_TID(); asm volatile("" : "+v"(tid));
    pg8::Gemm g; g.A = (const bf16_t*)(ws + WS_H); g.Bt = (const bf16_t*)(ws + WS_WOUT0); g.M = L; g.N = 1024; g.K = 1024;
    pg8::SchedRow S; S.nN = 4; S.total = 256; S.G = G; S.c = bc;
    if (fuse) { pg8::EpiResNorm<2> E; E.base = a.in[0]; E.out = a.out; E.gate = MOD + 2048; E.g = a.in[6] + 1024; E.mod = MOD + 2 * 3072; E.H = (bf16_t*)(ws + WS_H2);
      E.psq = (float*)(ws + WS_PART); E.cnt = (unsigned*)(ws + WS_CNT) + 256; E.xs = xs;
      pg8::gemm_phase<pg8::EpiResNorm<2>, pg8::SchedRow, true, false>(ldsl, g, S, E, tid); }
    else { pg8::EpiRes E; E.base = a.in[0]; E.out = a.out; E.gate = MOD + 2048;
      pg8::gemm_phase<pg8::EpiRes, pg8::SchedRow, true, false>(ldsl, g, S, E, tid); }
  } SEAM(4);
  if (IN(5)) for (int rep = 0; rep < NREP(5); ++rep) { tid = MK_TID(); asm volatile("" : "+v"(tid)); if (!fuse) rows_norm_mod(a.out, a.out, 0, L, a.in[6] + 1024, MOD + 2 * 3072, MOD + 2 * 3072, (bf16_t*)(ws + WS_H2), tid); } SEAM(5);
  if (IN(6)) for (int rep = 0; rep < NREP(6); ++rep) { tid = MK_TID(); asm volatile("" : "+v"(tid));
    pg8::Gemm g; g.A = (const bf16_t*)(ws + WS_WIN1); g.Bt = (const bf16_t*)(ws + WS_H2); g.M = 3840; g.N = L; g.K = 1024;
    pg8::SchedCol S; S.nM = 15; S.total = 15 * 64; S.G = G; S.c = bc;
    pg8::EpiT E; E.O = (bf16_t*)(ws + WS_P1T); E.gated = 1;
    pg8::gemm_phase<pg8::EpiT, pg8::SchedCol, true, false>(ldsl, g, S, E, tid);
  } SEAM(6);
  if (IN(7)) for (int rep = 0; rep < NREP(7); ++rep) { tid = MK_TID(); asm volatile("" : "+v"(tid));
    ht_phase((const bf16_t*)(ws + WS_W3T), (const bf16_t*)(ws + WS_HD2B), (bf16_t*)(ws + WS_HT), tid);
  } SEAM(7);
  if (IN(8)) for (int rep = 0; rep < NREP(8); ++rep) { tid = MK_TID(); asm volatile("" : "+v"(tid)); hyena_fourier_phase(a, (char*)lds_raw, tid); } SEAM(8);
  if (IN(9)) for (int rep = 0; rep < NREP(9); ++rep) { tid = MK_TID(); asm volatile("" : "+v"(tid)); transpose_phase((const bf16_t*)(ws + WS_P1T), (bf16_t*)(ws + WS_H), (char*)lds_raw, tid); } SEAM(9);
  if (IN(10)) for (int rep = 0; rep < NREP(10); ++rep) { tid = MK_TID(); asm volatile("" : "+v"(tid));
    pg8::Gemm g; g.A = (const bf16_t*)(ws + WS_H); g.Bt = (const bf16_t*)(ws + WS_WOUT1); g.M = L; g.N = 1024; g.K = 1024;
    pg8::SchedRow S; S.nN = 4; S.total = 256; S.G = G; S.c = bc;
    if (fuse) { pg8::EpiResNorm<1> E; E.base = a.out; E.out = a.out; E.gate = MOD + 2 * 3072 + 2048; E.g = a.in[25]; E.mod = MOD; E.H = nullptr;
      E.psq = (float*)(ws + WS_PART) + 65536; E.cnt = (unsigned*)(ws + WS_CNT) + 320; E.xs = xs;
      pg8::gemm_phase<pg8::EpiResNorm<1>, pg8::SchedRow, true, false>(ldsl, g, S, E, tid); }
    else { pg8::EpiRes E; E.base = a.out; E.out = a.out; E.gate = MOD + 2 * 3072 + 2048;
      pg8::gemm_phase<pg8::EpiRes, pg8::SchedRow, true, false>(ldsl, g, S, E, tid); }
  } SEAM(10);
  if (IN(11)) for (int rep = 0; rep < NREP(11); ++rep) { tid = MK_TID(); asm volatile("" : "+v"(tid)); if (!fuse) rows_final(a.out, a.in[25], tid); }
#undef IN
#undef SEAM
}

extern "C" void kernel_launch(void* const* d_in, const int* in_sizes, int n_in, void* d_out, int out_size, void* d_ws, size_t ws_size, hipStream_t stream) {
  static int grid = 0;
  if (grid == 0) {
    if (n_in != 26 || in_sizes[0] != L * DM || out_size != L * DM || ws_size < WS_END) {
      fprintf(stderr, "kernel_launch: unexpected shapes: n_in %d in0 %d out %d ws %zu (need >= %zu)\n", n_in, n_in > 0 ? in_sizes[0] : -1, out_size, ws_size, (size_t)WS_END); grid = -1; return; }
    int dev = 0, cus = 0, per_cu = 0;
    if (hipGetDevice(&dev) != hipSuccess || hipDeviceGetAttribute(&cus, hipDeviceAttributeMultiprocessorCount, dev) != hipSuccess) { fprintf(stderr, "kernel_launch: device query failed\n"); grid = -1; return; }
    if (hipFuncSetAttribute((const void*)mega_fwd, hipFuncAttributeMaxDynamicSharedMemorySize, LDS_BYTES) != hipSuccess) { fprintf(stderr, "kernel_launch: hipFuncSetAttribute failed\n"); grid = -1; return; }
    if (hipOccupancyMaxActiveBlocksPerMultiprocessor(&per_cu, (const void*)mega_fwd, 512, LDS_BYTES) != hipSuccess || per_cu < 1) { fprintf(stderr, "kernel_launch: occupancy query says %d\n", per_cu); per_cu = 1; }
    (void)hipGetLastError();
    grid = cus * per_cu;
    fprintf(stderr, "kernel_launch: grid %d (cus %d x %d)\n", grid, cus, per_cu);
  }
  if (grid < 0) return;
  if (hipMemsetAsync((unsigned char*)d_ws + WS_BAR, 0, 256, stream) != hipSuccess) { fprintf(stderr, "kernel_launch: memset failed\n"); return; }
  Args a{};
  for (int i = 0; i < 26; ++i) a.in[i] = (const float*)d_in[i];
  a.out = (float*)d_out; a.ws = (unsigned char*)d_ws;
#if MK_MULTI
  for (int ph = 0; ph < NPH; ++ph) { a.ph_lo = ph; a.ph_hi = ph + 1; hipLaunchKernelGGL(mega_fwd, dim3(grid), dim3(512), LDS_BYTES, stream, a); }
#else
  a.ph_lo = 0; a.ph_hi = NPH;
  void* args[] = {&a};
  hipError_t e = hipLaunchCooperativeKernel((const void*)mega_fwd, dim3(grid), dim3(512), args, LDS_BYTES, stream);
  if (e != hipSuccess) fprintf(stderr, "kernel_launch: cooperative launch failed: %s (grid %d)\n", hipGetErrorString(e), grid);
#endif
}
```

```cpp
#include <hip/hip_runtime.h>
#include <hip/hip_bf16.h>
#include <hip/hip_cooperative_groups.h>
#include <cstdio>
#include <cstdint>
namespace cg = cooperative_groups;

#ifndef MK_FUSE_NORM
#define MK_FUSE_NORM 0
#endif
#ifndef MK_MULTI
#define MK_MULTI 0
#endif

constexpr int L = 16384, DM = 1024, CTX = 256, LK = L + CTX;
constexpr int NPH = 12;
constexpr float EPS = 1e-6f;
constexpr size_t MiB = (size_t)1 << 20, KiB = 1024;
constexpr size_t WS_MOD = 0, WS_ROPE = 64 * KiB, WS_TW2 = 128 * KiB, WS_T = 256 * KiB, WS_PART = 768 * KiB;
constexpr size_t WS_WIN0 = 2 * MiB, WS_WOUT0 = 7 * MiB, WS_WIN1 = 9 * MiB, WS_WOUT1 = 17 * MiB, WS_W3T = 19 * MiB, WS_HD2B = 21 * MiB;
constexpr size_t WS_H = 30 * MiB, WS_AV = 63 * MiB, WS_AG = 79 * MiB, WS_Q = 87 * MiB, WS_K = 111 * MiB, WS_V = 120 * MiB, WS_BG = 129 * MiB;
constexpr size_t WS_BAR = 1600 * KiB; constexpr size_t WS_CNT = 1536 * KiB, WS_PARTIAL = 160 * MiB; constexpr size_t PARTIAL_FLOATS = 256 * 128 + 512;
constexpr size_t WS_H2 = MK_FUSE_NORM ? 63 * MiB : 30 * MiB;
constexpr size_t WS_P1T = 136 * MiB, WS_HT = 30 * MiB, WS_END = 256 * MiB;
constexpr int LDS_BYTES = 155648;
constexpr int XS_OFF = 131072;

typedef unsigned short bf16_t;
typedef float f32x4 __attribute__((ext_vector_type(4)));
typedef unsigned u32x4 __attribute__((ext_vector_type(4)));
typedef unsigned u32x2 __attribute__((ext_vector_type(2)));

struct Args { const float* in[26]; float* out; unsigned char* ws; int ph_lo, ph_hi; };

__device__ __forceinline__ float bf2f(bf16_t v) { return __uint_as_float((unsigned)v << 16); }
__device__ __forceinline__ unsigned f2bf(float f) { unsigned u = __float_as_uint(f); return (u + 0x7fffu + ((u >> 16) & 1u)) >> 16; }
__device__ __forceinline__ unsigned pk2(float lo, float hi) { return f2bf(lo) | (f2bf(hi) << 16); }
__device__ __forceinline__ float siluf(float v) { return v / (1.f + __expf(-v)); }
__device__ __forceinline__ float wave_sum(float v) {
#pragma unroll
  for (int o = 32; o >= 1; o >>= 1) v += __shfl_xor(v, o);
  return v;
}

__device__ __forceinline__ int qk_srccol(int j) {
  if (j < 512 || j >= 1536) return j;
  const int base = j & ~127, p = j & 127, g = p >> 3, e = p & 7;
  const int axis = g >> 3, f = 4 * (g & 7) + (e & 3), half = e >> 2;
  return base + axis * 64 + half * 32 + f;
}
template <int MODE>
__device__ __forceinline__ void wt_tile(const float* __restrict__ src, int ldn, int off, bf16_t* __restrict__ dst, int j0, int k0, float* tl, int tid) {
  const int cc = tid & 63, r0 = tid >> 6;
  const int sc = (MODE == 1) ? qk_srccol(j0 + cc) : (off + j0 + cc);
#pragma unroll
  for (int i = 0; i < 8; ++i) { const int r = r0 + 8 * i; tl[r * 65 + cc] = src[(size_t)(k0 + r) * ldn + sc]; }
  __syncthreads();
  const int n = tid >> 3, kq = (tid & 7) * 8;
  u32x4 w;
  w.x = pk2(tl[(kq + 0) * 65 + n], tl[(kq + 1) * 65 + n]); w.y = pk2(tl[(kq + 2) * 65 + n], tl[(kq + 3) * 65 + n]);
  w.z = pk2(tl[(kq + 4) * 65 + n], tl[(kq + 5) * 65 + n]); w.w = pk2(tl[(kq + 6) * 65 + n], tl[(kq + 7) * 65 + n]);
  *(u32x4*)(dst + (size_t)(j0 + n) * 1024 + k0 + kq) = w;
  __syncthreads();
}
template <int MODE>
__device__ __forceinline__ void wt_quad(const float* __restrict__ src, int ldn, int off, bf16_t* __restrict__ dst, int j0, int k0, float* tl, int tid) {
  const int cc = tid & 63, r0 = tid >> 6;
  const int sc = (MODE == 1) ? qk_srccol(j0 + cc) : (off + j0 + cc);
  float v[32];
#pragma unroll
  for (int i = 0; i < 32; ++i) v[i] = src[(size_t)(k0 + r0 + 8 * i) * ldn + sc];
#pragma unroll
  for (int i = 0; i < 32; ++i) tl[(r0 + 8 * i) * 65 + cc] = v[i];
  __syncthreads();
  const int n = tid >> 3, kq = (tid & 7) * 8;
#pragma unroll
  for (int s = 0; s < 4; ++s) { const float* t = tl + (s * 64 + kq) * 65 + n; u32x4 w;
    w.x = pk2(t[0], t[65]); w.y = pk2(t[130], t[195]); w.z = pk2(t[260], t[325]); w.w = pk2(t[390], t[455]);
    *(u32x4*)(dst + (size_t)(j0 + n) * 1024 + k0 + s * 64 + kq) = w; }
  __syncthreads();
}
__device__ __forceinline__ void wt_pool_tile(const float* __restrict__ src, const float* __restrict__ pw, const float* __restrict__ pscale, bf16_t* __restrict__ dst, int j0, int k0, float* lds, int tid) {
  float* A = lds; float* Bm = lds + 64 * 65; float* tl = lds + 2 * 64 * 65;
  const int cc = tid & 63, r0 = tid >> 6, g = j0 >> 6;
#pragma unroll
  for (int i = 0; i < 8; ++i) { const int r = r0 + 8 * i; A[r * 65 + cc] = src[(size_t)(k0 + r) * 2560 + g * 64 + cc]; Bm[r * 65 + cc] = pw[(g * 64 + r) * 64 + cc]; }
  __syncthreads();
  const float sc = pscale[j0 + cc];
#pragma unroll
  for (int i = 0; i < 8; ++i) { const int r = r0 + 8 * i; float s = 0.f;
    for (int q = 0; q < 64; ++q) s += A[r * 65 + q] * Bm[q * 65 + cc];
    tl[r * 65 + cc] = s * sc; }
  __syncthreads();
  const int n = tid >> 3, kq = (tid & 7) * 8;
  u32x4 w;
  w.x = pk2(tl[(kq + 0) * 65 + n], tl[(kq + 1) * 65 + n]); w.y = pk2(tl[(kq + 2) * 65 + n], tl[(kq + 3) * 65 + n]);
  w.z = pk2(tl[(kq + 4) * 65 + n], tl[(kq + 5) * 65 + n]); w.w = pk2(tl[(kq + 6) * 65 + n], tl[(kq + 7) * 65 + n]);
  *(u32x4*)(dst + (size_t)(j0 + n) * 1024 + k0 + kq) = w;
  __syncthreads();
}

namespace prep {
constexpr int N_MOD = 192, N_WIN0 = 208, N_WOUT = 64, N_WIN1A = 192, N_WIN1B = 16, N_T = 256, N_HD2 = 256, N_W3T = 48, N_ROPE = 16, N_TW2 = 32;
constexpr int O_WIN0 = N_MOD, O_WOUT0 = O_WIN0 + N_WIN0, O_WOUT1 = O_WOUT0 + N_WOUT, O_WIN1A = O_WOUT1 + N_WOUT, O_WIN1B = O_WIN1A + N_WIN1A,
                O_T = O_WIN1B + N_WIN1B, O_HD2 = O_T + N_T, O_W3T = O_HD2 + N_HD2, O_ROPE = O_W3T + N_W3T, O_TW2 = O_ROPE + N_ROPE, O_END = O_TW2 + N_TW2;
constexpr int N_EARLY = O_WOUT1 + N_T + N_ROPE + N_TW2, N_LATE = (O_T - O_WOUT1) + (O_ROPE - O_HD2);
__host__ __device__ constexpr int early_item(int e) { return e < O_WOUT1 ? e : (e < O_WOUT1 + N_T ? O_T + (e - O_WOUT1) : O_ROPE + (e - O_WOUT1 - N_T)); }
__host__ __device__ constexpr int late_item(int q) { return q < O_T - O_WOUT1 ? O_WOUT1 + q : O_HD2 + (q - (O_T - O_WOUT1)); }
}
__device__ __forceinline__ void prep_item(const Args& a, int item, float* lds, int tid) {
  using namespace prep;
  unsigned char* ws = a.ws;
  {
    asm volatile("" : "+v"(tid));
    if (item < O_WIN0) {
      const int layer = item / 96, chunk = item % 96, col = chunk * 32 + (tid & 31), rg = tid >> 5;
      const float* wm = a.in[4] + (size_t)layer * 1024 * 3072; const float* cv = a.in[1]; const float* cc = a.in[3];
      float s0 = 0.f, s1 = 0.f;
      for (int r = rg; r < 1024; r += 16) { const float w = wm[(size_t)r * 3072 + col]; s0 += siluf(cv[r]) * w; if (layer == 0) s1 += siluf(cc[r]) * w; }
      lds[tid] = s0; lds[512 + tid] = s1; __syncthreads();
      if (tid < 32) { float t0 = 0.f, t1 = 0.f; for (int q = 0; q < 16; ++q) { t0 += lds[q * 32 + tid]; t1 += lds[512 + q * 32 + tid]; }
        const float bm = a.in[5][layer * 3072 + col]; float* MOD = (float*)(ws + WS_MOD);
        if (layer == 0) { MOD[col] = t0 + bm; MOD[3072 + col] = t1 + bm; } else MOD[2 * 3072 + col] = t0 + bm; }
      __syncthreads();
    } else if (item < O_WOUT0) {
      const int ti = item - O_WIN0;
      if (ti < 64) wt_pool_tile(a.in[7], a.in[9], a.in[10], (bf16_t*)(ws + WS_WIN0), (ti / 16) * 64, (ti % 16) * 64, lds, tid);
      else { const int tq = ti - 64; wt_quad<1>(a.in[7], 2560, 0, (bf16_t*)(ws + WS_WIN0), (4 + tq / 4) * 64, (tq % 4) * 256, lds, tid); }
    } else if (item < O_WOUT1) { const int ti = item - O_WOUT0; wt_quad<0>(a.in[8], 1024, 0, (bf16_t*)(ws + WS_WOUT0), (ti / 4) * 64, (ti % 4) * 256, lds, tid);
    } else if (item < O_WIN1A) { const int ti = item - O_WOUT1; wt_quad<0>(a.in[14], 1024, 0, (bf16_t*)(ws + WS_WOUT1), (ti / 4) * 64, (ti % 4) * 256, lds, tid);
    } else if (item < O_WIN1B) { const int ti = item - O_WIN1A; wt_quad<0>(a.in[13], 3584, 0, (bf16_t*)(ws + WS_WIN1), (ti / 4) * 64, (ti % 4) * 256, lds, tid);
    } else if (item < O_T) {     const int ti = item - O_WIN1B; wt_quad<0>(a.in[13], 3584, 3328 - 3584, (bf16_t*)(ws + WS_WIN1), 3584 + (ti / 4) * 64, (ti % 4) * 256, lds, tid);
    } else if (item < O_HD2) {
      const int i = item - O_T;
      if (tid < 256) lds[tid] = cospif((float)tid / 128.f);
      __syncthreads();
      const int n = tid & 255, part = tid >> 8; const float* fw = a.in[24];
      float s = 0.f;
      for (int j = 0; j < 256; ++j) { const int m = (i * j) & 255; const float tr = part ? lds[(m - 64) & 255] : lds[m]; s += tr * fw[j * 256 + n]; }
      ((float*)(ws + WS_T))[(part * 256 + i) * 256 + n] = (part ? -s : s) * (1.f / 2048.f);
      __syncthreads();
    } else if (item < O_W3T) {
      const int t0 = (item - O_HD2) * 64;
      float* e = lds; float* h1 = lds + 64 * 34;
      for (int idx = tid; idx < 64 * 33; idx += 512) { const int tl = idx / 33, q = idx % 33, t = t0 + tl; float v;
        if (q == 0) v = (float)t / 16383.f;
        else { const int b = (q - 1) & 15; const float f = 1e-4f + (float)b * ((15.f - 1e-4f) / 15.f); const float w = 6.2831855f * (float)t / 16384.f; const float ar = f * w;
          v = (q <= 16) ? cosf(ar) : -sinf(ar); }
        e[tl * 34 + q] = v; }
      __syncthreads();
      const int j = tid & 63, r0 = tid >> 6; const float fr = a.in[22][j];
#pragma unroll
      for (int i = 0; i < 8; ++i) { const int tl = r0 + 8 * i; float s = a.in[18][j];
        for (int q = 0; q < 33; ++q) s += e[tl * 34 + q] * a.in[17][q * 64 + j];
        h1[tl * 65 + j] = sinf(fr * s); }
      __syncthreads();
      bf16_t* HD = (bf16_t*)(ws + WS_HD2B);
#pragma unroll
      for (int i = 0; i < 8; ++i) { const int tl = r0 + 8 * i; float s = a.in[20][j];
        for (int q = 0; q < 64; ++q) s += h1[tl * 65 + q] * a.in[19][q * 64 + j];
        HD[(size_t)(t0 + tl) * 64 + j] = (bf16_t)f2bf(sinf(fr * s)); }
      __syncthreads();
    } else if (item < O_ROPE) {
      const int row = (item - O_W3T) * 64 + (tid >> 3), kg = (tid & 7) * 8; u32x4 w = {0u, 0u, 0u, 0u};
      { const float* w3 = a.in[21]; float v[8];
#pragma unroll
        for (int q = 0; q < 8; ++q) v[q] = w3[(size_t)(kg + q) * 3072 + row];
        w.x = pk2(v[0], v[1]); w.y = pk2(v[2], v[3]); w.z = pk2(v[4], v[5]); w.w = pk2(v[6], v[7]); }
      *(u32x4*)((bf16_t*)(ws + WS_W3T) + (size_t)row * 64 + kg) = w;
    } else if (item < O_TW2) {
      const int idx = (item - O_ROPE) * 512 + tid, pos = idx >> 5, f = idx & 31;
      const float inv = powf(10000.f, -(float)f / 32.f), ang = (float)pos * inv;
      ((float2*)(ws + WS_ROPE))[idx] = make_float2(cosf(ang), sinf(ang));
    } else {
      if (item == O_TW2 && tid < 392) ((unsigned*)(ws + WS_CNT))[tid] = 0u;
      const int n = (item - O_TW2) * 512 + tid; float s, c; sincospif((float)n / 16384.f, &s, &c);
      ((float2*)(ws + WS_TW2))[n] = make_float2(c, -s);
    }
  }
}
__device__ __forceinline__ void p0_prep(const Args& a, float* lds, int tid) {
  for (int e = blockIdx.x; e < prep::N_EARLY; e += gridDim.x) prep_item(a, prep::early_item(e), lds, tid);
}

__device__ __forceinline__ void rows_norm_mod(const float* __restrict__ X, const float* __restrict__ C, int nctx, int nrows, const float* __restrict__ g,
                                              const float* __restrict__ modx, const float* __restrict__ modc, bf16_t* __restrict__ H, int tid) {
  const int lane = tid & 63, wid = tid >> 6;
  for (int row = blockIdx.x * 8 + wid; row < nrows; row += gridDim.x * 8) {
    const float* src = row < nctx ? C + (size_t)row * 1024 : X + (size_t)(row - nctx) * 1024; const float* md = row < nctx ? modc : modx;
    f32x4 v[4]; float ss = 0.f;
#pragma unroll
    for (int i = 0; i < 4; ++i) { v[i] = *(const f32x4*)(src + (lane + 64 * i) * 4); ss += v[i].x * v[i].x + v[i].y * v[i].y + v[i].z * v[i].z + v[i].w * v[i].w; }
    ss = wave_sum(ss); const float rinv = rsqrtf(ss * (1.f / 1024.f) + EPS);
#pragma unroll
    for (int i = 0; i < 4; ++i) { const int c = (lane + 64 * i) * 4; const f32x4 gg = *(const f32x4*)(g + c), sh = *(const f32x4*)(md + c), sc = *(const f32x4*)(md + 1024 + c);
      const f32x4 y = v[i] * rinv * gg * (sc + 1.f) + sh;
      u32x2 w; w.x = pk2(y.x, y.y); w.y = pk2(y.z, y.w); *(u32x2*)(H + (size_t)row * 1024 + c) = w; }
  }
}
__device__ __forceinline__ void rows_final(float* __restrict__ X, const float* __restrict__ g, int tid) {
  const int lane = tid & 63, wid = tid >> 6;
  for (int row = blockIdx.x * 8 + wid; row < L; row += gridDim.x * 8) {
    float* src = X + (size_t)row * 1024; f32x4 v[4]; float ss = 0.f;
#pragma unroll
    for (int i = 0; i < 4; ++i) { v[i] = *(const f32x4*)(src + (lane + 64 * i) * 4); ss += v[i].x * v[i].x + v[i].y * v[i].y + v[i].z * v[i].z + v[i].w * v[i].w; }
    ss = wave_sum(ss); const float rinv = rsqrtf(ss * (1.f / 1024.f) + EPS);
#pragma unroll
    for (int i = 0; i < 4; ++i) { const int c = (lane + 64 * i) * 4; const f32x4 gg = *(const f32x4*)(g + c); *(f32x4*)(src + c) = v[i] * rinv * gg; }
  }
}
__device__ __forceinline__ void fold_item(const Args& a, int item, float* lds, int tid) {
  float* A = lds; float* Bm = lds + 64 * 257; const float* T = (const float*)(a.ws + WS_T); bf16_t* W = (bf16_t*)(a.ws + WS_WIN1);
  {
    const int kt = item >> 3, nt = item & 7, part = nt >> 2, n0 = (nt & 3) * 64, k0 = kt * 64;
    for (int idx = tid; idx < 64 * 256; idx += 512) { const int k = idx >> 8, i = idx & 255; A[k * 257 + i] = a.in[13][(size_t)(k0 + k) * 3584 + 3072 + i]; }
    for (int idx = tid; idx < 256 * 64; idx += 512) { const int i = idx >> 6, n = idx & 63; Bm[i * 64 + n] = T[(part * 256 + i) * 256 + n0 + n]; }
    __syncthreads();
    const int n = tid & 63, r0 = tid >> 6; float s[8];
#pragma unroll
    for (int q = 0; q < 8; ++q) s[q] = 0.f;
    for (int i = 0; i < 256; ++i) { const float b = Bm[i * 64 + n];
#pragma unroll
      for (int q = 0; q < 8; ++q) s[q] += A[(r0 + 8 * q) * 257 + i] * b; }
#pragma unroll
    for (int q = 0; q < 8; ++q) W[(size_t)(3072 + part * 256 + n0 + n) * 1024 + k0 + r0 + 8 * q] = (bf16_t)f2bf(s[q]);
    __syncthreads();
  }
}

namespace pg8 {
#define PG8_LAS __attribute__((address_space(3)))
typedef unsigned short bf16_t;
typedef short bf16x8 __attribute__((ext_vector_type(8)));
typedef float f32x4 __attribute__((ext_vector_type(4)));
typedef unsigned u32x4 __attribute__((ext_vector_type(4)));
constexpr int BM = 256, BK = 64, HALF = 128, HTB = HALF * BK * 2  , STAGE_BYTES = 8 * HTB, NXCD = 8, WGM = 8;

__host__ __device__ __forceinline__ int lds_byte(int r, int c) { const int st = (r >> 4) * 2 + (c >> 5), rr = r & 15, cc = c & 31, ob = rr * 64 + cc * 2; return st * 1024 + (ob ^ (((ob >> 9) & 1) << 5)); }
__host__ __device__ __forceinline__ void stage_rc(int b, int& R, int& C) { const int st = b / 1024, sb = b % 1024, swz = sb ^ (((sb >> 9) & 1) << 5); R = (st >> 1) * 16 + swz / 64; C = (st & 1) * 32 + (swz % 64) / 2; }
__host__ __device__ __forceinline__ int perm32(int rho) { const int n = rho >> 4, i = rho & 15; return 8 * (i >> 2) + 4 * n + (i & 3); }

struct Unit { int pm, pn; };
struct Gemm { const bf16_t* A; const bf16_t* Bt; int M, N, K; };
__device__ __forceinline__ unsigned cvt_pk_bf16(float lo, float hi) { unsigned r; asm volatile("v_cvt_pk_bf16_f32 %0, %1, %2" : "=v"(r) : "v"(lo), "v"(hi)); return r; }
}

namespace pg8 {

struct StaticOrder {
    int nM, nN, nwg, G, c;
    __host__ __device__ void init(int M, int N, int G_, int c_) { nM = M / BM; nN = N / BM; nwg = nM * nN; G = G_; c = c_; }
    __host__ __device__ bool next(int i, Unit& u) const {
        const long L = (long)i * G + c; if (L >= nwg) return false;
        int wgid = (int)L; { const int q = nwg / NXCD, r = nwg % NXCD, xcd = wgid % NXCD, off = wgid / NXCD; wgid = (xcd < r ? xcd * (q + 1) : r * (q + 1) + (xcd - r) * q) + off; }
        const int nig = WGM * nN, gid = wgid / nig, fm = gid * WGM, gsz = (nM - fm) < WGM ? (nM - fm) : WGM;
        u.pm = fm + ((wgid % nig) % gsz); u.pn = (wgid % nig) / gsz; return true;
    }
    __device__ __forceinline__ void a_ready(const Unit&) const {}
    __device__ __forceinline__ void done(const Unit&) const {}
};

struct SchedIn0 {
  int G, c;
  __device__ __forceinline__ bool next(int i, Unit& u) const { const int l = i * G + c; if (l >= 642) return false;
    if (l < 2) { u.pm = 0; u.pn = 5 + l; } else { const int v = l - 2; u.pm = 1 + v / 10; u.pn = v % 10; } return true; }
  __device__ __forceinline__ void a_ready(const Unit&) const {}
  __device__ __forceinline__ void done(const Unit&) const {}
};
struct SchedRow {
  int nN, total, G, c;
  __device__ __forceinline__ bool next(int i, Unit& u) const { const int l = i * G + c; if (l >= total) return false; u.pm = l / nN; u.pn = l % nN; return true; }
  __device__ __forceinline__ void a_ready(const Unit&) const {}
  __device__ __forceinline__ void done(const Unit&) const {}
};
struct SchedCol {
  int nM, total, G, c;
  __device__ __forceinline__ bool next(int i, Unit& u) const { const int l = i * G + c; if (l >= total) return false; u.pn = l / nM; u.pm = l % nM; return true; }
  __device__ __forceinline__ void a_ready(const Unit&) const {}
  __device__ __forceinline__ void done(const Unit&) const {}
};
struct EpiIn0 {
  static constexpr bool PERM = true, AFTER_DRAIN = false;
  float* AV; bf16_t *AG, *Q, *K, *V, *BG; const float *qg, *kg; const float2* rope; float* xs;
  __device__ __forceinline__ void operator()(const f32x4 (&acc)[2][2][4][2], const Unit& u, int wr, int wc, int fr, int fq) const {
    const int pn = u.pn, rl0 = wr * 64 + fr, row0 = u.pm * 256 + rl0, cl = wc * 32 + 8 * fq;
    if (u.pm == 0 && pn != 5 && pn != 6) return;
    if (pn == 0) {
#pragma unroll
      for (int ai = 0; ai < 2; ++ai)
#pragma unroll
        for (int m = 0; m < 4; ++m) { float* p = AV + (size_t)(row0 + ai * 128 + m * 16 - 256) * 256 + cl;
#pragma unroll
          for (int bj = 0; bj < 2; ++bj) { *(f32x4*)(p + bj * 128) = acc[ai][bj][m][0]; *(f32x4*)(p + bj * 128 + 4) = acc[ai][bj][m][1]; } }
    } else if (pn == 1 || pn >= 6) {
      bf16_t* dst; int ld, roff = 256, coff = 0; bool act = true;
      size_t hstride = 128;
      if (pn == 1) { dst = AG; ld = 256; } else if (pn == 6) { dst = V; ld = 128; roff = 0; act = false; hstride = (size_t)LK * 128; } else { dst = BG; ld = 768; coff = (pn - 7) * 256; }
#pragma unroll
      for (int ai = 0; ai < 2; ++ai)
#pragma unroll
        for (int m = 0; m < 4; ++m) { bf16_t* p = dst + (size_t)(row0 + ai * 128 + m * 16 - roff) * ld + coff + cl;
#pragma unroll
          for (int bj = 0; bj < 2; ++bj) { f32x4 v0 = acc[ai][bj][m][0], v1 = acc[ai][bj][m][1];
            if (act) { v0.x = siluf(v0.x); v0.y = siluf(v0.y); v0.z = siluf(v0.z); v0.w = siluf(v0.w); v1.x = siluf(v1.x); v1.y = siluf(v1.y); v1.z = siluf(v1.z); v1.w = siluf(v1.w); }
            u32x4 w; w.x = pk2(v0.x, v0.y); w.y = pk2(v0.z, v0.w); w.z = pk2(v1.x, v1.y); w.w = pk2(v1.z, v1.w);
            *(u32x4*)(p + bj * hstride) = w; } }
    } else {
#pragma unroll
      for (int ai = 0; ai < 2; ++ai)
#pragma unroll
        for (int m = 0; m < 4; ++m)
#pragma unroll
          for (int bj = 0; bj < 2; ++bj) { const f32x4 x0 = acc[ai][bj][m][0], x1 = acc[ai][bj][m][1];
            float s = x0.x * x0.x + x0.y * x0.y + x0.z * x0.z + x0.w * x0.w + x1.x * x1.x + x1.y * x1.y + x1.z * x1.z + x1.w * x1.w;
            s += __shfl_xor(s, 16); s += __shfl_xor(s, 32);
            if (fq == 0) xs[(bj * 256 + ai * 128 + m * 16 + rl0) * 4 + wc] = s; }
      __syncthreads();
      const bool isk = (pn == 5); const float* gw = isk ? kg : qg;
      const int axis = wc >> 1, f0 = 4 * ((4 * wc + fq) & 7);
      const f32x4 g0 = *(const f32x4*)(gw + axis * 64 + f0), g1 = *(const f32x4*)(gw + axis * 64 + 32 + f0);
      bf16_t* dst = isk ? K : Q; const int ld = isk ? 128 : 768, coff = isk ? 0 : (pn - 2) * 256, roff = isk ? 0 : 256; const size_t hstride = isk ? (size_t)LK * 128 : 128;
#pragma unroll
      for (int ai = 0; ai < 2; ++ai)
#pragma unroll
        for (int m = 0; m < 4; ++m) { const int row = row0 + ai * 128 + m * 16, tok = row - 256;
          f32x4 cs0 = {1.f, 0.f, 1.f, 0.f}, cs1 = {1.f, 0.f, 1.f, 0.f};
          if (tok >= 0) { const int pos = axis ? (tok & 63) : (tok >> 6); const float* rp = (const float*)(rope + pos * 32 + f0); cs0 = *(const f32x4*)rp; cs1 = *(const f32x4*)(rp + 4); }
#pragma unroll
          for (int bj = 0; bj < 2; ++bj) { const f32x4 t = *(const f32x4*)(xs + (bj * 256 + ai * 128 + m * 16 + rl0) * 4);
            const float rinv = rsqrtf((t.x + t.y + t.z + t.w) * (1.f / 128.f) + EPS);
            const f32x4 av = acc[ai][bj][m][0] * rinv * g0, bv = acc[ai][bj][m][1] * rinv * g1;
            const float o00 = av.x * cs0.x - bv.x * cs0.y, o10 = bv.x * cs0.x + av.x * cs0.y;
            const float o01 = av.y * cs0.z - bv.y * cs0.w, o11 = bv.y * cs0.z + av.y * cs0.w;
            const float o02 = av.z * cs1.x - bv.z * cs1.y, o12 = bv.z * cs1.x + av.z * cs1.y;
            const float o03 = av.w * cs1.z - bv.w * cs1.w, o13 = bv.w * cs1.z + av.w * cs1.w;
            u32x4 w; w.x = pk2(o00, o01); w.y = pk2(o02, o03); w.z = pk2(o10, o11); w.w = pk2(o12, o13);
            *(u32x4*)(dst + (size_t)(row - roff) * ld + coff + bj * hstride + cl) = w; } }
    }
  }
};
struct EpiRes {
  static constexpr bool PERM = true, AFTER_DRAIN = false;
  const float* base; float* out; const float* gate;
  __device__ __forceinline__ void operator()(const f32x4 (&acc)[2][2][4][2], const Unit& u, int wr, int wc, int fr, int fq) const {
    const int row0 = u.pm * 256 + wr * 64 + fr, col0 = u.pn * 256 + wc * 32 + 8 * fq;
#pragma unroll
    for (int bj = 0; bj < 2; ++bj) { const f32x4 g0 = *(const f32x4*)(gate + col0 + bj * 128), g1 = *(const f32x4*)(gate + col0 + bj * 128 + 4);
#pragma unroll
      for (int ai = 0; ai < 2; ++ai)
#pragma unroll
        for (int m = 0; m < 4; ++m) { const size_t o = (size_t)(row0 + ai * 128 + m * 16) * 1024 + col0 + bj * 128;
          const f32x4 b0 = *(const f32x4*)(base + o), b1 = *(const f32x4*)(base + o + 4);
          *(f32x4*)(out + o) = b0 + g0 * acc[ai][bj][m][0]; *(f32x4*)(out + o + 4) = b1 + g1 * acc[ai][bj][m][1]; } }
  }
};
template <int MODE> struct EpiResNorm {
  static constexpr bool PERM = true, AFTER_DRAIN = false; static constexpr int mode = MODE;
  const float* base; float* out; const float* gate; const float* g; const float* mod; bf16_t* H; float* psq; unsigned* cnt; float* xs;
  __device__ __forceinline__ void operator()(const f32x4 (&acc)[2][2][4][2], const Unit& u, int wr, int wc, int fr, int fq) const {
    const int rl0 = wr * 64 + fr, row0 = u.pm * 256 + rl0, col0 = u.pn * 256 + wc * 32 + 8 * fq, tid = (wr * 4 + wc) * 64 + fq * 16 + fr;
#pragma unroll
    for (int ai = 0; ai < 2; ++ai)
#pragma unroll
      for (int m = 0; m < 4; ++m) { float s = 0.f;
#pragma unroll
        for (int bj = 0; bj < 2; ++bj) { int cc = col0 + bj * 128; asm volatile("" : "+v"(cc)); const size_t o = (size_t)(row0 + ai * 128 + m * 16) * 1024 + cc;
          const f32x4 x0 = *(const f32x4*)(base + o) + *(const f32x4*)(gate + cc) * acc[ai][bj][m][0], x1 = *(const f32x4*)(base + o + 4) + *(const f32x4*)(gate + cc + 4) * acc[ai][bj][m][1];
          if (mode == 2) { *(f32x4*)(out + o) = x0; *(f32x4*)(out + o + 4) = x1; }
          s += x0.x * x0.x + x0.y * x0.y + x0.z * x0.z + x0.w * x0.w + x1.x * x1.x + x1.y * x1.y + x1.z * x1.z + x1.w * x1.w; }
        s += __shfl_xor(s, 16); s += __shfl_xor(s, 32); if (fq == 0) xs[(ai * 128 + m * 16 + rl0) * 4 + wc] = s;
        __builtin_amdgcn_sched_barrier(0); }
    __syncthreads();
    if (tid < 256) { const f32x4 t = *(const f32x4*)(xs + tid * 4); psq[(size_t)(u.pm * 256 + tid) * 4 + u.pn] = (t.x + t.y) + (t.z + t.w); }
    __threadfence(); __syncthreads();
    if (tid == 0) { __hip_atomic_fetch_add(cnt + u.pm, 1u, __ATOMIC_RELAXED, __HIP_MEMORY_SCOPE_AGENT);
      for (int it = 0; it < (1 << 22) && __hip_atomic_load(cnt + u.pm, __ATOMIC_RELAXED, __HIP_MEMORY_SCOPE_AGENT) < 4u; ++it) __builtin_amdgcn_s_sleep(1);
      __threadfence(); }
    __syncthreads();
#pragma unroll
    for (int ai = 0; ai < 2; ++ai)
#pragma unroll
      for (int m = 0; m < 4; ++m) { const float* pq = psq + (size_t)(row0 + ai * 128 + m * 16) * 4;
        const float t = (__builtin_nontemporal_load(pq) + __builtin_nontemporal_load(pq + 1)) + (__builtin_nontemporal_load(pq + 2) + __builtin_nontemporal_load(pq + 3));
        const float ri = rsqrtf(t * (1.f / 1024.f) + EPS);
#pragma unroll
        for (int bj = 0; bj < 2; ++bj) { int cc = col0 + bj * 128; asm volatile("" : "+v"(cc)); const size_t o = (size_t)(row0 + ai * 128 + m * 16) * 1024 + cc;
          const f32x4 x0 = *(const f32x4*)(base + o) + *(const f32x4*)(gate + cc) * acc[ai][bj][m][0], x1 = *(const f32x4*)(base + o + 4) + *(const f32x4*)(gate + cc + 4) * acc[ai][bj][m][1];
          f32x4 y0 = x0 * ri * *(const f32x4*)(g + cc), y1 = x1 * ri * *(const f32x4*)(g + cc + 4);
          if (mode == 2) { y0 = y0 * (*(const f32x4*)(mod + 1024 + cc) + 1.f) + *(const f32x4*)(mod + cc); y1 = y1 * (*(const f32x4*)(mod + 1024 + cc + 4) + 1.f) + *(const f32x4*)(mod + cc + 4);
            u32x4 w; w.x = pk2(y0.x, y0.y); w.y = pk2(y0.z, y0.w); w.z = pk2(y1.x, y1.y); w.w = pk2(y1.z, y1.w); *(u32x4*)(H + o) = w; }
          else { *(f32x4*)(out + o) = y0; *(f32x4*)(out + o + 4) = y1; } }
        __builtin_amdgcn_sched_barrier(0); }
  }
};
struct EpiT {
  static constexpr bool PERM = true, AFTER_DRAIN = false;
  bf16_t* O; int gated;
  __device__ __forceinline__ void operator()(const f32x4 (&acc)[2][2][4][2], const Unit& u, int wr, int wc, int fr, int fq) const {
    const int row0 = u.pm * 256 + wr * 64 + fr, col0 = u.pn * 256 + wc * 32 + 8 * fq; const bool act = gated && ((u.pm >= 9 && u.pm <= 11) || u.pm == 14);
#pragma unroll
    for (int ai = 0; ai < 2; ++ai)
#pragma unroll
      for (int m = 0; m < 4; ++m) { bf16_t* p = O + (size_t)(row0 + ai * 128 + m * 16) * L + col0;
#pragma unroll
        for (int bj = 0; bj < 2; ++bj) { f32x4 v0 = acc[ai][bj][m][0], v1 = acc[ai][bj][m][1];
          if (act) { v0.x = siluf(v0.x); v0.y = siluf(v0.y); v0.z = siluf(v0.z); v0.w = siluf(v0.w); v1.x = siluf(v1.x); v1.y = siluf(v1.y); v1.z = siluf(v1.z); v1.w = siluf(v1.w); }
          u32x4 w; w.x = pk2(v0.x, v0.y); w.y = pk2(v0.z, v0.w); w.z = pk2(v1.x, v1.y); w.w = pk2(v1.z, v1.w);
          *(u32x4*)(p + bj * 128) = w; } }
  }
};
}
namespace pg8 {
template <class Epi, class Sched, bool ALIGN_EPI = false, bool SP2 = false>
__device__ __forceinline__ void gemm_phase(PG8_LAS unsigned char* lds, const Gemm g, const Sched& S, const Epi& E, int tid_in) {
    const int tid = tid_in, wid = __builtin_amdgcn_readfirstlane(tid >> 6), lane = tid & 63, wr = wid >> 2, wc = wid & 3, fr = lane & 15, fq = lane >> 4;
    const int K = g.K, nt = K / BK;
    unsigned voffA[2], voffB[2];
#pragma unroll
    for (int i = 0; i < 2; ++i) { int R, C; stage_rc(tid * 16 + i * 8192, R, C); const int Rb = Epi::PERM ? ((R & ~31) + perm32(R & 31)) : R;
        voffA[i] = (unsigned)(R * K + C) * 2u; voffB[i] = (unsigned)(Rb * K + C) * 2u; }
    const size_t kstep = (size_t)(BK * 2);
    const size_t hstep = (size_t)HALF * K * 2;
    const size_t tstep = 2 * hstep;
    const unsigned ldsw = (unsigned)wid * 1024u;
    const int aoff = lds_byte(wr * 64 + fr, fq * 8), boff = lds_byte(wc * 32 + fr, fq * 8);
#define PG8_SA(b, h) (((b) * 2 + (h)) * HTB)
#define PG8_SB(b, h) ((4 + (b) * 2 + (h)) * HTB)
#define PG8_STAGE(bufoff, gbase, voff) do { _Pragma("unroll") for (int _i = 0; _i < 2; ++_i) \
        __builtin_amdgcn_global_load_lds((const unsigned*)((const char*)(gbase) + (voff)[_i]), (PG8_LAS unsigned*)(lds + (bufoff) + ldsw + _i * 8192), 16, 0, 0); } while (0)
#define PG8_LDA(dst, b, h) do { _Pragma("unroll") for (int m = 0; m < 4; ++m) _Pragma("unroll") for (int k = 0; k < 2; ++k) dst[m][k] = *(const PG8_LAS bf16x8*)(lds + PG8_SA(b, h) + aoff + m * 2048 + k * 1024); } while (0)
#define PG8_LDB(dst, b, h) do { _Pragma("unroll") for (int n = 0; n < 2; ++n) _Pragma("unroll") for (int k = 0; k < 2; ++k) dst[n][k] = *(const PG8_LAS bf16x8*)(lds + PG8_SB(b, h) + boff + n * 2048 + k * 1024); } while (0)
#define PG8_MMA(ai, bj, At, Bt) do { __builtin_amdgcn_s_setprio(1); _Pragma("unroll") for (int m = 0; m < 4; ++m) _Pragma("unroll") for (int n = 0; n < 2; ++n) _Pragma("unroll") for (int k = 0; k < 2; ++k) \
        acc[ai][bj][m][n] = __builtin_amdgcn_mfma_f32_16x16x32_bf16(Bt[n][k], At[m][k], acc[ai][bj][m][n], 0, 0, 0); __builtin_amdgcn_s_setprio(0); } while (0)
#define PG8_WAIT_V(n) asm volatile("s_waitcnt vmcnt(" #n ")" ::: "memory")
#define PG8_WAIT_L(n) asm volatile("s_waitcnt lgkmcnt(" #n ")" ::: "memory")
#define PG8_BAR __builtin_amdgcn_s_barrier()
#define PG8_SCHED __builtin_amdgcn_sched_barrier(0)
    Unit cur, nxt; int ui = 0;
    if (!S.next(0, cur)) return;
    f32x4 acc[2][2][4][2];
#pragma unroll
    for (int a = 0; a < 2; ++a)
#pragma unroll
        for (int b = 0; b < 2; ++b)
#pragma unroll
            for (int m = 0; m < 4; ++m)
#pragma unroll
                for (int n = 0; n < 2; ++n) acc[a][b][m][n] = (f32x4){0.f, 0.f, 0.f, 0.f};
    bf16x8 At[4][2], B0[2][2], B1[2][2];
    const char* cA = (const char*)g.A + (size_t)cur.pm * tstep; const char* cB = (const char*)g.Bt + (size_t)cur.pn * tstep;
    S.a_ready(cur);
    if constexpr (SP2) {
        PG8_STAGE(PG8_SB(0, 0), cB, voffB); PG8_STAGE(PG8_SB(0, 1), cB + hstep, voffB); PG8_STAGE(PG8_SA(0, 0), cA, voffA); PG8_STAGE(PG8_SA(0, 1), cA + hstep, voffA);
        if (wr == 1) PG8_BAR;
        PG8_WAIT_V(2); PG8_BAR;
        PG8_STAGE(PG8_SB(1, 0), cB + kstep, voffB); PG8_STAGE(PG8_SA(1, 0), cA + kstep, voffA); PG8_STAGE(PG8_SB(1, 1), cB + hstep + kstep, voffB);
        PG8_WAIT_V(6); PG8_BAR;
    } else {
        PG8_STAGE(PG8_SB(0, 0), cB, voffB); PG8_STAGE(PG8_SA(0, 0), cA, voffA); PG8_STAGE(PG8_SB(0, 1), cB + hstep, voffB); PG8_STAGE(PG8_SA(0, 1), cA + hstep, voffA);
        if (wr == 1) PG8_BAR;
        PG8_WAIT_V(4); PG8_BAR;
        PG8_STAGE(PG8_SB(1, 0), cB + kstep, voffB); PG8_STAGE(PG8_SA(1, 0), cA + kstep, voffA); PG8_STAGE(PG8_SB(1, 1), cB + hstep + kstep, voffB);
        PG8_WAIT_V(6); PG8_BAR;
    }
    for (;;) {
        const bool has_next = S.next(ui + 1, nxt);
        const char* nA = has_next ? (const char*)g.A + (size_t)nxt.pm * tstep : cA; const char* nB = has_next ? (const char*)g.Bt + (size_t)nxt.pn * tstep : cB;
        for (int t = 0; t < nt; t += 2) {
            const bool last = (t == nt - 2);
            const char* a1 = cA + (size_t)(t + 1) * kstep;
            const char* a2 = last ? nA : cA + (size_t)(t + 2) * kstep; const char* b2 = last ? nB : cB + (size_t)(t + 2) * kstep;
            const char* a3 = a2 + kstep; const char* b3 = b2 + kstep;
            if (last && has_next) S.a_ready(nxt);
            if constexpr (SP2) {
            PG8_LDB(B0, 0, 0); PG8_LDB(B1, 0, 1); PG8_SCHED; PG8_LDA(At, 0, 0); PG8_STAGE(PG8_SA(1, 1), a1 + hstep, voffA);
            PG8_WAIT_V(8); PG8_WAIT_L(0); PG8_BAR; PG8_MMA(0, 0, At, B0); PG8_MMA(0, 1, At, B1); PG8_BAR; PG8_SCHED;
            PG8_LDA(At, 0, 1); PG8_STAGE(PG8_SB(0, 0), b2, voffB); PG8_STAGE(PG8_SB(0, 1), b2 + hstep, voffB); PG8_STAGE(PG8_SA(0, 0), a2, voffA);
            PG8_WAIT_V(8); PG8_WAIT_L(0); PG8_BAR; PG8_MMA(1, 0, At, B0); PG8_MMA(1, 1, At, B1); PG8_BAR; PG8_SCHED;
            PG8_LDB(B0, 1, 0); PG8_LDB(B1, 1, 1); PG8_SCHED; PG8_LDA(At, 1, 0); PG8_STAGE(PG8_SA(0, 1), a2 + hstep, voffA);
            PG8_WAIT_V(8); PG8_WAIT_L(0); PG8_BAR; PG8_MMA(0, 0, At, B0); PG8_MMA(0, 1, At, B1); PG8_BAR; PG8_SCHED;
            PG8_LDA(At, 1, 1); PG8_STAGE(PG8_SB(1, 0), b3, voffB); PG8_STAGE(PG8_SB(1, 1), b3 + hstep, voffB); PG8_STAGE(PG8_SA(1, 0), a3, voffA);
            PG8_WAIT_V(8); PG8_WAIT_L(0); PG8_BAR; PG8_MMA(1, 0, At, B0); PG8_MMA(1, 1, At, B1); PG8_BAR; PG8_SCHED;
            } else {
            PG8_LDB(B0, 0, 0); PG8_SCHED; PG8_LDA(At, 0, 0); PG8_STAGE(PG8_SA(1, 1), a1 + hstep, voffA);
            PG8_WAIT_L(8); PG8_BAR; PG8_WAIT_L(0); PG8_MMA(0, 0, At, B0); PG8_BAR; PG8_SCHED;
            PG8_LDB(B1, 0, 1); PG8_STAGE(PG8_SB(0, 0), b2, voffB);
            PG8_BAR; PG8_WAIT_L(0); PG8_MMA(0, 1, At, B1); PG8_BAR;
            PG8_LDA(At, 0, 1); PG8_STAGE(PG8_SA(0, 0), a2, voffA);
            PG8_BAR; PG8_WAIT_L(0); PG8_MMA(1, 0, At, B0); PG8_BAR; PG8_SCHED;
            PG8_STAGE(PG8_SB(0, 1), b2 + hstep, voffB);
            PG8_WAIT_V(6); PG8_BAR; PG8_MMA(1, 1, At, B1); PG8_BAR;
            PG8_LDB(B0, 1, 0); PG8_SCHED; PG8_LDA(At, 1, 0); PG8_STAGE(PG8_SA(0, 1), a2 + hstep, voffA);
            PG8_WAIT_L(8); PG8_BAR; PG8_WAIT_L(0); PG8_MMA(0, 0, At, B0); PG8_BAR; PG8_SCHED;
            PG8_LDB(B1, 1, 1); PG8_STAGE(PG8_SB(1, 0), b3, voffB);
            PG8_BAR; PG8_WAIT_L(0); PG8_MMA(0, 1, At, B1); PG8_BAR;
            PG8_LDA(At, 1, 1); PG8_STAGE(PG8_SA(1, 0), a3, voffA);
            PG8_BAR; PG8_WAIT_L(0); PG8_MMA(1, 0, At, B0); PG8_BAR; PG8_SCHED;
            PG8_STAGE(PG8_SB(1, 1), b3 + hstep, voffB);
            PG8_WAIT_V(6); PG8_BAR; PG8_MMA(1, 1, At, B1); PG8_BAR;
            }
        }
        if constexpr (ALIGN_EPI) { if (wr == 0) PG8_BAR; }
        if constexpr (!Epi::AFTER_DRAIN) { E(acc, cur, wr, wc, fr, fq); S.done(cur); }
        if (!has_next) break;
#pragma unroll
        for (int a = 0; a < 2; ++a)
#pragma unroll
            for (int b = 0; b < 2; ++b)
#pragma unroll
                for (int m = 0; m < 4; ++m)
#pragma unroll
                    for (int n = 0; n < 2; ++n) acc[a][b][m][n] = (f32x4){0.f, 0.f, 0.f, 0.f};
        cur = nxt; cA = nA; cB = nB; ++ui;
        if constexpr (ALIGN_EPI) { if (wr == 1) PG8_BAR; }
    }
    PG8_WAIT_V(0);
    if constexpr (!ALIGN_EPI) { if (wr == 0) PG8_BAR; }
    PG8_BAR;
    if constexpr (Epi::AFTER_DRAIN) { E.fused(acc, cur, wr, wc, fr, fq, lds, wid, lane); S.done(cur); }
#undef PG8_SA
#undef PG8_SB
#undef PG8_STAGE
#undef PG8_LDA
#undef PG8_LDB
#undef PG8_MMA
#undef PG8_WAIT_V
#undef PG8_WAIT_L
#undef PG8_BAR
#undef PG8_SCHED
}
}

namespace attn {
using bf16 = __hip_bfloat16;
constexpr int   D = 128, NW = 8, QBLK = 32, KVBLK = 64;
constexpr float SCALE = 0.088388347648318440f;
constexpr float THR = 8.f;
constexpr int SDEPTH = 2;
constexpr int LDQ = 768, LDK = 128, LDO = 1024, LDG = 768;
constexpr size_t SHM_V = KVBLK * D * 2, SHM_K = KVBLK * D * 2, SHM_ATTN = 2 * SHM_V + 2 * SHM_K + NW * 64 * 4;
using bf16x8 = __attribute__((ext_vector_type(8))) short;
using s16x4  = __attribute__((ext_vector_type(4))) short;
using f32x16 = __attribute__((ext_vector_type(16))) float;
using f32x8  = __attribute__((ext_vector_type(8))) float;
using u32x4  = __attribute__((ext_vector_type(4))) unsigned;
#define KSWZ(row, colB) ((row) * 256 + ((colB) ^ (((row) & 7) << 4)))
#define SBAR() __builtin_amdgcn_sched_barrier(0)
__device__ __forceinline__ int crow(int r, int hi) { return (r & 3) + 8 * (r >> 2) + 4 * hi; }
__device__ __forceinline__ unsigned cvtpk(float lo, float hi) {
  unsigned r; asm volatile("v_cvt_pk_bf16_f32 %0, %1, %2" : "=v"(r) : "v"(lo), "v"(hi)); return r;
}
template <typename TIn> struct Stage;
template <> struct Stage<bf16>  { using T = bf16x8;
  __device__ static __forceinline__ T ld8(const bf16* p) { return *reinterpret_cast<const bf16x8*>(p); }
  __device__ static __forceinline__ bf16x8 tobf(T x) { return x; } };
template <> struct Stage<float> { using T = f32x8;
  __device__ static __forceinline__ T ld8(const float* p) { return *reinterpret_cast<const f32x8*>(p); }
  __device__ static __forceinline__ bf16x8 tobf(T x) {
    u32x4 w = {cvtpk(x[0], x[1]), cvtpk(x[2], x[3]), cvtpk(x[4], x[5]), cvtpk(x[6], x[7])}; return *reinterpret_cast<bf16x8*>(&w); } };

__device__ __forceinline__ void partialSM(f32x16& p0, f32x16& p1, float& m_reg, float& mn, float& alpha) {
  constexpr float C = SCALE * 1.4426950408889634f;
  float pmax = p0[0]; for (int r = 1; r < 16; ++r) pmax = fmaxf(pmax, p0[r]); for (int r = 0; r < 16; ++r) pmax = fmaxf(pmax, p1[r]);
  { auto rr = __builtin_amdgcn_permlane32_swap(__float_as_uint(pmax), __float_as_uint(pmax), false, false);
    pmax = fmaxf(__uint_as_float(rr[0]), __uint_as_float(rr[1])); }
  if (__builtin_expect(__all(pmax - m_reg <= THR / SCALE), 1)) { mn = m_reg; alpha = 1.f; }
  else { mn = fmaxf(m_reg, pmax); alpha = __builtin_amdgcn_exp2f((m_reg - mn) * C); m_reg = mn; }
  float mnC = -mn * C;
  for (int r = 0; r < 16; ++r) p0[r] = fmaf(p0[r], C, mnC); for (int r = 0; r < 16; ++r) p1[r] = fmaf(p1[r], C, mnC);
  for (int r = 0; r < 16; ++r) p0[r] = __builtin_amdgcn_exp2f(p0[r]);
}
__device__ __forceinline__ void finishSM(f32x16& p0, f32x16& p1, float alpha, float& l_reg, bf16x8& pa0, bf16x8& pa1, bf16x8& pa2, bf16x8& pa3) {
  for (int r = 0; r < 16; ++r) p1[r] = __builtin_amdgcn_exp2f(p1[r]);
  float ps = 0; for (int r = 0; r < 16; ++r) ps += p0[r]; for (int r = 0; r < 16; ++r) ps += p1[r];
  { auto rr = __builtin_amdgcn_permlane32_swap(__float_as_uint(ps), __float_as_uint(ps), false, false);
    ps = __uint_as_float(rr[0]) + __uint_as_float(rr[1]); }
  l_reg = l_reg * alpha + ps;
#define PK4(P, BASE, OUT) do { unsigned a0 = cvtpk(P[BASE + 0], P[BASE + 1]), a1 = cvtpk(P[BASE + 2], P[BASE + 3]);   \
    unsigned b0 = cvtpk(P[BASE + 4], P[BASE + 5]), b1 = cvtpk(P[BASE + 6], P[BASE + 7]);                              \
    auto r0 = __builtin_amdgcn_permlane32_swap(a0, b0, false, false); auto r1 = __builtin_amdgcn_permlane32_swap(a1, b1, false, false); \
    u32x4 w = {r0[0], r1[0], r0[1], r1[1]}; OUT = *reinterpret_cast<bf16x8*>(&w); } while (0)
  PK4(p0, 0, pa0); PK4(p0, 8, pa1); PK4(p1, 0, pa2); PK4(p1, 8, pa3);
#undef PK4
}
__device__ __forceinline__ void qkt(f32x16& p0, f32x16& p1, const bf16* Ks, const bf16x8* qr, int r32, int hi) {
  p0 = f32x16{}; p1 = f32x16{};
  for (int d0 = 0; d0 < 8; ++d0) { int cb = (d0 * 16 + hi * 8) * 2;
    bf16x8 b0 = *reinterpret_cast<const bf16x8*>((const char*)Ks + KSWZ(r32, cb));
    bf16x8 b1 = *reinterpret_cast<const bf16x8*>((const char*)Ks + KSWZ(32 + r32, cb));
    p0 = __builtin_amdgcn_mfma_f32_32x32x16_bf16(b0, qr[d0], p0, 0, 0, 0);
    p1 = __builtin_amdgcn_mfma_f32_32x32x16_bf16(b1, qr[d0], p1, 0, 0, 0); }
}
__device__ __forceinline__ int v_st(int k, int c) { const int kk = (k & ~0xC) | ((k & 4) << 1) | ((k & 8) >> 1); return ((kk >> 3) * 4 + (c >> 5)) * 512 + ((kk & 7) * 32 + (c & 31)) * 2; }
__device__ __forceinline__ int v_rd_base(int lane) { return ((lane & 3) << 3) | (((lane >> 2) & 3) << 6) | (((lane >> 4) & 1) << 5) | (((lane >> 5) & 1) << 8); }
constexpr int v_rd_off(int d0, int ks, int half) { return d0 * 512 + ks * 4096 + half * 2048; }
template <int OFF> __device__ __forceinline__ s16x4 tr_read(int vb) {
  s16x4 r; asm volatile("ds_read_b64_tr_b16 %0, %1 offset:%2" : "=&v"(r) : "v"(vb), "i"(OFF) : "memory"); return r;
}
template <int D0> __device__ __forceinline__ void pv_one(f32x16& od, int vb, bf16x8 pa0, bf16x8 pa1, bf16x8 pa2, bf16x8 pa3) {
  const s16x4 l0 = tr_read<v_rd_off(D0, 0, 0)>(vb), h0 = tr_read<v_rd_off(D0, 0, 1)>(vb), l1 = tr_read<v_rd_off(D0, 1, 0)>(vb), h1 = tr_read<v_rd_off(D0, 1, 1)>(vb);
  const s16x4 l2 = tr_read<v_rd_off(D0, 2, 0)>(vb), h2 = tr_read<v_rd_off(D0, 2, 1)>(vb), l3 = tr_read<v_rd_off(D0, 3, 0)>(vb), h3 = tr_read<v_rd_off(D0, 3, 1)>(vb);
  asm volatile("s_waitcnt lgkmcnt(0)" ::: "memory"); SBAR();
#define PK(L, H) (bf16x8){L[0], L[1], L[2], L[3], H[0], H[1], H[2], H[3]}
  od = __builtin_amdgcn_mfma_f32_32x32x16_bf16(pa0, PK(l0, h0), od, 0, 0, 0);
  od = __builtin_amdgcn_mfma_f32_32x32x16_bf16(pa1, PK(l1, h1), od, 0, 0, 0);
  od = __builtin_amdgcn_mfma_f32_32x32x16_bf16(pa2, PK(l2, h2), od, 0, 0, 0);
  od = __builtin_amdgcn_mfma_f32_32x32x16_bf16(pa3, PK(l3, h3), od, 0, 0, 0);
#undef PK
}
__device__ __forceinline__ void pv_d0(f32x16* o, int vb, bf16x8 pa0, bf16x8 pa1, bf16x8 pa2, bf16x8 pa3) {
  pv_one<0>(o[0], vb, pa0, pa1, pa2, pa3); pv_one<1>(o[1], vb, pa0, pa1, pa2, pa3); pv_one<2>(o[2], vb, pa0, pa1, pa2, pa3); pv_one<3>(o[3], vb, pa0, pa1, pa2, pa3);
}

template <bool PARTIAL>
__device__ __forceinline__ void attn_dense_body(const bf16* __restrict__ Qb, const bf16* __restrict__ Kh, const bf16* __restrict__ Vh,
                                                const bf16_t* __restrict__ Gb, bf16_t* __restrict__ Ob, int seq, char* lds,
                                                float* Pself, const float* Pother, unsigned* cnt, int tid_) {
  using TQ = bf16;
  using St = Stage<bf16>; using SQ = Stage<TQ>;
  asm volatile("" : "+v"(tid_));
  const int tid = tid_, wid = tid >> 6, lane = tid & 63, r32 = lane & 31, hi = lane >> 5;
  bf16* V_lds = (bf16*)lds; bf16* K_lds = (bf16*)(lds + 2 * SHM_V);
  float* ws = (float*)(lds + 2 * SHM_V + 2 * SHM_K) + wid * 64; float* li_l = ws; float* al_l = ws + 32;
  float m_reg = -1e30f, l_reg = 0; f32x16 o[4] = {}; bf16x8 qr[8];
  const TQ* Qw = Qb + (long)(wid * QBLK + r32) * LDQ + hi * 8;
#pragma unroll
  for (int d0 = 0; d0 < 8; ++d0) qr[d0] = SQ::tobf(SQ::ld8(Qw + d0 * 16));
  const int sr = tid >> 4, sc = (tid & 15) * 8, vst0 = v_st(sr, sc), vst1 = v_st(32 + sr, sc);
  const int vb0 = (int)(uintptr_t)V_lds + v_rd_base(lane);
  struct { typename St::T vs0, vs1, ks0, ks1; } sr_[SDEPTH];
  const unsigned so0 = (unsigned)(sr * LDK + sc), so1 = (unsigned)((32 + sr) * LDK + sc);
#define SLOAD(i, k0) do { const bf16* Vt_ = Vh + (long)(k0) * LDK; const bf16* Kt_ = Kh + (long)(k0) * LDK; \
    sr_[i].vs0 = St::ld8(Vt_ + so0); sr_[i].vs1 = St::ld8(Vt_ + so1); sr_[i].ks0 = St::ld8(Kt_ + so0); sr_[i].ks1 = St::ld8(Kt_ + so1); } while (0)
#define SWRITE(b, i) do { *(bf16x8*)((char*)V_lds + (b) * SHM_V + vst0) = St::tobf(sr_[i].vs0);          \
    *(bf16x8*)((char*)V_lds + (b) * SHM_V + vst1) = St::tobf(sr_[i].vs1); int kc = sc * 2;               \
    *(bf16x8*)((char*)K_lds + (b) * SHM_K + KSWZ(sr, kc)) = St::tobf(sr_[i].ks0);                       \
    *(bf16x8*)((char*)K_lds + (b) * SHM_K + KSWZ(32 + sr, kc)) = St::tobf(sr_[i].ks1); } while (0)
#define SWAIT() do { if constexpr (SDEPTH == 2) asm volatile("s_waitcnt vmcnt(4)" ::: "memory"); else asm volatile("s_waitcnt vmcnt(0)" ::: "memory"); } while (0)
#define RESC(a) do { if (__any((a) < 1.f)) { if (hi == 0) al_l[r32] = (a); asm volatile("s_waitcnt lgkmcnt(0)" ::: "memory"); \
    for (int d = 0; d < 4; ++d) for (int r = 0; r < 16; ++r) o[d][r] *= al_l[crow(r, hi)]; } } while (0)
  f32x16 pA0, pA1, pB0, pB1; float mnA, mnB, alA, alB; bf16x8 pa0, pa1, pa2, pa3; const int NT = seq / KVBLK;
  constexpr int SE = 0, SO = SDEPTH - 1;
  SLOAD(SE, 0); asm volatile("s_waitcnt vmcnt(0)" ::: "memory"); SWRITE(0, SE); __syncthreads();
  qkt(pA0, pA1, K_lds, qr, r32, hi); partialSM(pA0, pA1, m_reg, mnA, alA);
  SLOAD(SO, KVBLK); if constexpr (SDEPTH == 2) { if (2 < NT) SLOAD(SE, 2 * KVBLK); }
  SWAIT(); SWRITE(1, SO); __syncthreads();
  for (int j = 1; j + 1 < NT; j += 2) {
    SBAR(); qkt(pB0, pB1, (bf16*)((char*)K_lds + SHM_K), qr, r32, hi);
    finishSM(pA0, pA1, alA, l_reg, pa0, pa1, pa2, pa3); SBAR();
    SLOAD(SO, (j + SDEPTH) * KVBLK); SBAR();
    pv_d0(o, vb0, pa0, pa1, pa2, pa3); partialSM(pB0, pB1, m_reg, mnB, alB);
    __syncthreads(); SWAIT(); SWRITE(0, SE);
    RESC(alB); __syncthreads();
    SBAR(); qkt(pA0, pA1, K_lds, qr, r32, hi);
    finishSM(pB0, pB1, alB, l_reg, pa0, pa1, pa2, pa3); SBAR();
    if (SDEPTH == 1 || j + 3 < NT) SLOAD(SE, (j + 1 + SDEPTH) * KVBLK); SBAR();
    pv_d0(o, vb0 + (int)SHM_V, pa0, pa1, pa2, pa3); partialSM(pA0, pA1, m_reg, mnA, alA);
    __syncthreads(); SWAIT(); SWRITE(1, SO);
    RESC(alA); __syncthreads();
  }
  SBAR(); qkt(pB0, pB1, (bf16*)((char*)K_lds + SHM_K), qr, r32, hi);
  finishSM(pA0, pA1, alA, l_reg, pa0, pa1, pa2, pa3); SBAR();
  pv_d0(o, vb0, pa0, pa1, pa2, pa3); partialSM(pB0, pB1, m_reg, mnB, alB);
  __syncthreads(); RESC(alB);
  finishSM(pB0, pB1, alB, l_reg, pa0, pa1, pa2, pa3); SBAR();
  pv_d0(o, vb0 + (int)SHM_V, pa0, pa1, pa2, pa3);
  if constexpr (!PARTIAL) {
  if (hi == 0) li_l[r32] = l_reg; asm volatile("s_waitcnt lgkmcnt(0)" ::: "memory");
  float rli[16];
#pragma unroll
  for (int r = 0; r < 16; ++r) rli[r] = __builtin_amdgcn_rcpf(li_l[crow(r, hi)]);
  const bf16_t* Gw = Gb + (long)(wid * QBLK) * LDG; bf16_t* Ow = Ob + (long)(wid * QBLK) * LDO;
#pragma unroll
  for (int r = 0; r < 16; ++r) { int orow = crow(r, hi);
    for (int d0 = 0; d0 < 4; ++d0) { const float gt = bf2f(Gw[(long)orow * LDG + d0 * 32 + r32]); Ow[(long)orow * LDO + d0 * 32 + r32] = (bf16_t)f2bf(o[d0][r] * rli[r] * gt); }
    if ((r & 3) == 3) __builtin_amdgcn_sched_barrier(0); }
  } else {
    constexpr float C = SCALE * 1.4426950408889634f;
    { float* Pw = Pself + (long)(wid * QBLK) * 128;
#pragma unroll
      for (int r = 0; r < 16; ++r) { const int orow = crow(r, hi);
        for (int d0 = 0; d0 < 4; ++d0) Pw[orow * 128 + d0 * 32 + r32] = o[d0][r];
        if ((r & 3) == 3) __builtin_amdgcn_sched_barrier(0); }
      if (hi == 0) { Pself[256 * 128 + wid * QBLK + r32] = m_reg; Pself[256 * 128 + 256 + wid * QBLK + r32] = l_reg; } }
    __threadfence(); __syncthreads();
    volatile unsigned* flag = (volatile unsigned*)(lds + SHM_ATTN);
    if (tid == 0) *flag = atomicAdd(cnt, 1u);
    __syncthreads();
    if (*flag == 1u) {
      __threadfence();
      const float m2 = __builtin_nontemporal_load(Pother + 256 * 128 + wid * QBLK + r32), l2 = __builtin_nontemporal_load(Pother + 256 * 128 + 256 + wid * QBLK + r32);
      const float M = fmaxf(m_reg, m2), a1 = __builtin_amdgcn_exp2f((m_reg - M) * C), a2 = __builtin_amdgcn_exp2f((m2 - M) * C), inv = __builtin_amdgcn_rcpf(l_reg * a1 + l2 * a2);
      if (hi == 0) { li_l[r32] = a1 * inv; al_l[r32] = a2 * inv; } asm volatile("s_waitcnt lgkmcnt(0)" ::: "memory");
      const float* Po = Pother + (long)(wid * QBLK) * 128; const bf16_t* Gw = Gb + (long)(wid * QBLK) * LDG; bf16_t* Ow = Ob + (long)(wid * QBLK) * LDO;
#pragma unroll
      for (int r = 0; r < 16; ++r) { const int orow = crow(r, hi); const float w1 = li_l[orow], w2 = al_l[orow];
        for (int d0 = 0; d0 < 4; ++d0) { const float gt = bf2f(Gw[(long)orow * LDG + d0 * 32 + r32]); const float ov = __builtin_nontemporal_load(Po + orow * 128 + d0 * 32 + r32);
          Ow[(long)orow * LDO + d0 * 32 + r32] = (bf16_t)f2bf((o[d0][r] * w1 + ov * w2) * gt); }
        if ((r & 3) == 3) __builtin_amdgcn_sched_barrier(0); }
    }
    __syncthreads();
  }
#undef SLOAD
#undef SWRITE
#undef SWAIT
#undef RESC
}

#undef KSWZ
#undef SBAR
}

__device__ __forceinline__ void pool_phase(const float* __restrict__ AV, const bf16_t* __restrict__ AG, bf16_t* __restrict__ MIX, unsigned* ctr, volatile unsigned* slot, int tid) {
  const int c4 = (tid & 63) * 4, tg = tid >> 6, w2 = 1 << (c4 >> 6);
  for (;;) {
    __syncthreads();
    if (tid == 0) *slot = atomicAdd(ctr, 1u);
    __syncthreads();
    const int item = (int)*slot;
    if (item >= L / 32) break;
#pragma unroll 1
    for (int q = 0; q < 4; ++q) { const int t = item * 32 + tg * 4 + q;
      const int lo = max(t - w2, 0), hi = min(t + w2, L);
      f32x4 s = {0.f, 0.f, 0.f, 0.f};
      for (int u = lo; u < hi; ++u) s += *(const f32x4*)(AV + (size_t)u * 256 + c4);
      const f32x4 me = *(const f32x4*)(AV + (size_t)t * 256 + c4); const float ic = 1.f / (float)(hi - lo);
      const u32x2 gw = *(const u32x2*)(AG + (size_t)t * 256 + c4);
      const float g0 = __uint_as_float(gw.x << 16), g1 = __uint_as_float(gw.x & 0xffff0000u), g2 = __uint_as_float(gw.y << 16), g3 = __uint_as_float(gw.y & 0xffff0000u);
      u32x2 w; w.x = pk2((s.x * ic - me.x) * g0, (s.y * ic - me.y) * g1); w.y = pk2((s.z * ic - me.z) * g2, (s.w * ic - me.w) * g3);
      *(u32x2*)(MIX + (size_t)t * 1024 + c4) = w; }
  }
}

__device__ __forceinline__ void prep_queue(const Args& a, unsigned* ctr, volatile unsigned* slot, float* lds, int tid) {
  for (;;) {
    __syncthreads();
    if (tid == 0) *slot = atomicAdd(ctr, 1u);
    __syncthreads();
    int item = (int)*slot;
    if (item < 128) { fold_item(a, item, lds, tid); continue; }
    item -= 128;
    if (item >= prep::N_LATE) break;
    prep_item(a, prep::late_item(item), lds, tid);
  }
}

#define PADI(i) ((i) + ((i) >> 5))
__device__ __forceinline__ float2 cadd(float2 a, float2 b) { return make_float2(a.x + b.x, a.y + b.y); }
__device__ __forceinline__ float2 csub(float2 a, float2 b) { return make_float2(a.x - b.x, a.y - b.y); }
__device__ __forceinline__ float2 cmul(float2 a, float2 b) { return make_float2(a.x * b.x - a.y * b.y, a.x * b.y + a.y * b.x); }
__device__ constexpr float W32C[16] = {1.f, 0.98078528040323043f, 0.92387953251128674f, 0.83146961230254524f, 0.70710678118654752f, 0.55557023301960218f, 0.38268343236508977f, 0.19509032201612825f,
                                       0.f, -0.19509032201612825f, -0.38268343236508977f, -0.55557023301960218f, -0.70710678118654752f, -0.83146961230254524f, -0.92387953251128674f, -0.98078528040323043f};
__device__ constexpr float W32S[16] = {0.f, 0.19509032201612825f, 0.38268343236508977f, 0.55557023301960218f, 0.70710678118654752f, 0.83146961230254524f, 0.92387953251128674f, 0.98078528040323043f,
                                       1.f, 0.98078528040323043f, 0.92387953251128674f, 0.83146961230254524f, 0.70710678118654752f, 0.55557023301960218f, 0.38268343236508977f, 0.19509032201612825f};
template <int S, bool INV>
__device__ __forceinline__ void fft_pass8(float2* cb, const float2* twL, int tid) {
  static_assert(S % 32 == 0, "constant LDS offsets need S % 32 == 0");
  constexpr float R = 0.70710678118654752f;
  constexpr int ES = S + S / 32;
#pragma unroll 2
  for (int it = 0; it < 4; ++it) {
    const int u = it * 512 + tid, j = u & (S - 1), base = ((u & ~(S - 1)) << 3) + j;
    float2* p = cb + PADI(base);
    float2 x[8];
#pragma unroll
    for (int e = 0; e < 8; ++e) x[e] = p[e * ES];
    float2 t1 = twL[j * (2048 / S)]; if (INV) t1.y = -t1.y;
    const float2 t2 = cmul(t1, t1), t3 = cmul(t2, t2);
    float2 w8[4]; w8[0] = t1;
    if (!INV) { w8[1] = cmul(t1, make_float2(R, -R)); w8[2] = make_float2(t1.y, -t1.x); w8[3] = cmul(t1, make_float2(-R, -R)); }
    else      { w8[1] = cmul(t1, make_float2(R, R));  w8[2] = make_float2(-t1.y, t1.x); w8[3] = cmul(t1, make_float2(-R, R)); }
    float2 w4[2]; w4[0] = t2; w4[1] = INV ? make_float2(-t2.y, t2.x) : make_float2(t2.y, -t2.x);
    if (!INV) {
#pragma unroll
      for (int e = 0; e < 4; ++e) { const float2 a = x[e], c = x[e + 4]; x[e] = cadd(a, c); x[e + 4] = cmul(csub(a, c), w8[e]); }
#pragma unroll
      for (int q = 0; q < 8; q += 4)
#pragma unroll
        for (int e = 0; e < 2; ++e) { const float2 a = x[q + e], c = x[q + e + 2]; x[q + e] = cadd(a, c); x[q + e + 2] = cmul(csub(a, c), w4[e]); }
#pragma unroll
      for (int q = 0; q < 8; q += 2) { const float2 a = x[q], c = x[q + 1]; x[q] = cadd(a, c); x[q + 1] = cmul(csub(a, c), t3); }
    } else {
#pragma unroll
      for (int q = 0; q < 8; q += 2) { const float2 a = x[q], c = cmul(x[q + 1], t3); x[q] = cadd(a, c); x[q + 1] = csub(a, c); }
#pragma unroll
      for (int q = 0; q < 8; q += 4)
#pragma unroll
        for (int e = 0; e < 2; ++e) { const float2 a = x[q + e], c = cmul(x[q + e + 2], w4[e]); x[q + e] = cadd(a, c); x[q + e + 2] = csub(a, c); }
#pragma unroll
      for (int e = 0; e < 4; ++e) { const float2 a = x[e], c = cmul(x[e + 4], w8[e]); x[e] = cadd(a, c); x[e + 4] = csub(a, c); }
    }
#pragma unroll
    for (int e = 0; e < 8; ++e) p[e * ES] = x[e];
  }
  __syncthreads();
}
template <bool INV>
__device__ __forceinline__ void fft_pass32(float2* cb, int tid) {
  float2* p = cb + 33 * tid;
  float2 x[32];
#pragma unroll
  for (int e = 0; e < 32; ++e) x[e] = p[e];
  if (!INV) {
#pragma unroll
    for (int h = 16; h >= 1; h >>= 1)
#pragma unroll
      for (int b = 0; b < 32; b += 2 * h)
#pragma unroll
        for (int q = 0; q < h; ++q) { const float2 a = x[b + q], c = x[b + q + h], d = csub(a, c); x[b + q] = cadd(a, c);
          const int k = q * (16 / h);
          if (k == 0) x[b + q + h] = d; else if (k == 8) x[b + q + h] = make_float2(d.y, -d.x); else x[b + q + h] = cmul(d, make_float2(W32C[k], -W32S[k])); }
  } else {
#pragma unroll
    for (int h = 1; h <= 16; h <<= 1)
#pragma unroll
      for (int b = 0; b < 32; b += 2 * h)
#pragma unroll
        for (int q = 0; q < h; ++q) { const float2 a = x[b + q], c0 = x[b + q + h]; float2 c;
          const int k = q * (16 / h);
          if (k == 0) c = c0; else if (k == 8) c = make_float2(-c0.y, c0.x); else c = cmul(c0, make_float2(W32C[k], W32S[k]));
          x[b + q] = cadd(a, c); x[b + q + h] = csub(a, c); }
  }
#pragma unroll
  for (int e = 0; e < 32; ++e) p[e] = x[e];
  __syncthreads();
}
__device__ __forceinline__ void fft_fwd(float2* cb, const float2* twL, int tid) {
  fft_pass8<2048, false>(cb, twL, tid); fft_pass8<256, false>(cb, twL, tid); fft_pass8<32, false>(cb, twL, tid); fft_pass32<false>(cb, tid);
}
__device__ __forceinline__ void fft_inv(float2* cb, const float2* twL, int tid) {
  fft_pass32<true>(cb, tid); fft_pass8<32, true>(cb, twL, tid); fft_pass8<256, true>(cb, twL, tid); fft_pass8<2048, true>(cb, twL, tid);
}
template <bool ODD>
__device__ __forceinline__ void fft_pointwise(float2* cb, int tid) {
#pragma unroll 1
  for (int j = 0; j < (ODD ? 16 : 32); ++j) {
    const int p = j * 512 + tid;
    int pp;
    if (ODD) pp = 16383 - p; else pp = (p < 2) ? p : (p ^ ((1 << (31 - __clz(p))) - 1));
    if (p <= pp) {
      const float2 C = cb[PADI(p)], C2 = cb[PADI(pp)];
      const float2 Z = make_float2(0.5f * (C.x + C2.x), 0.5f * (C.y - C2.y)), K = make_float2(0.5f * (C.y + C2.y), -0.5f * (C.x - C2.x));
      const float2 Y = cmul(Z, K);
      cb[PADI(p)] = Y; cb[PADI(pp)] = make_float2(Y.x, -Y.y);
    }
  }
  __syncthreads();
}
__device__ __forceinline__ float conv3_at(const bf16_t* __restrict__ row, int t, float w0, float w1, float w2, float b) {
  const unsigned tm = (unsigned)max(t - 1, 0), tp = (unsigned)min(t + 1, L - 1); float um = bf2f(row[tm]), up = bf2f(row[tp]); const float u0 = bf2f(row[(unsigned)t]);
  um = t > 0 ? um : 0.f; up = t < L - 1 ? up : 0.f;
  return w0 * um + w1 * u0 + w2 * up + b;
}


namespace mf {
typedef short bf16x8 __attribute__((ext_vector_type(8)));
typedef short bf16x4 __attribute__((ext_vector_type(4)));
constexpr int RS = 272, PL = 128 * RS;
constexpr int O_DRE = 0, O_DIM = PL, O_FRE = 2 * PL, O_FIM = 3 * PL, O_TWA = 4 * PL, O_TWB = 4 * PL + 1024, O_RED = 4 * PL + 2048;
__device__ __forceinline__ bf16x4 tr_rd(unsigned addr) { bf16x4 r; asm volatile("ds_read_b64_tr_b16 %0, %1" : "=&v"(r) : "v"(addr) : "memory"); return r; }
__device__ __forceinline__ bf16x8 negv(bf16x8 v) { u32x4 t = __builtin_bit_cast(u32x4, v); t.x ^= 0x80008000u; t.y ^= 0x80008000u; t.z ^= 0x80008000u; t.w ^= 0x80008000u; return __builtin_bit_cast(bf16x8, t); }
__device__ __forceinline__ bf16x8 cat(bf16x4 a, bf16x4 b) { return (bf16x8){a[0], a[1], a[2], a[3], b[0], b[1], b[2], b[3]}; }
__device__ __forceinline__ float2 twid(const char* lds, int idx, bool inv) {
  const float2 ta = ((const float2*)(lds + O_TWA))[idx >> 7], tb = ((const float2*)(lds + O_TWB))[idx & 127];
  float2 w = make_float2(ta.x * tb.x - ta.y * tb.y, ta.x * tb.y + ta.y * tb.x); if (inv) w.y = -w.y; return w;
}
template <bool INV, bool TW, int OUT>
__device__ __forceinline__ void dft_cols(char* lds, const float2* __restrict__ TW2, int tid) {
  const int lane = tid & 63, w = tid >> 6, g = lane >> 4, n16 = lane & 15, q = n16 >> 2, p = lane & 3;
  const unsigned base = (unsigned)(uintptr_t)lds;
  bf16x8 bre[4], bim[4];
  { bf16x4 t0[4], t1[4], u0[4], u1[4];
#pragma unroll
    for (int ks = 0; ks < 4; ++ks) { const unsigned a0 = base + RS * (32 * ks + 8 * g + q) + 16 * (2 * w + (p >> 1)) + 8 * (p & 1), a1 = a0 + 4 * RS;
      t0[ks] = tr_rd(a0 + O_DRE); t1[ks] = tr_rd(a1 + O_DRE); u0[ks] = tr_rd(a0 + O_DIM); u1[ks] = tr_rd(a1 + O_DIM); }
    asm volatile("s_waitcnt lgkmcnt(0)" ::: "memory"); __builtin_amdgcn_sched_barrier(0);
#pragma unroll
    for (int ks = 0; ks < 4; ++ks) { bre[ks] = cat(t0[ks], t1[ks]); bim[ks] = cat(u0[ks], u1[ks]); } }
  if (OUT != 0) __syncthreads();
  bf16x8 x2[4], x3[4];
#pragma unroll
  for (int ks = 0; ks < 4; ++ks) { x2[ks] = INV ? bim[ks] : negv(bim[ks]); x3[ks] = INV ? negv(bre[ks]) : bre[ks]; }
#pragma unroll 2
  for (int rb = 0; rb < 8; ++rb) {
    f32x4 dre = {0.f, 0.f, 0.f, 0.f}, dim = {0.f, 0.f, 0.f, 0.f};
    const char* fr = lds + O_FRE + RS * (n16 + 16 * rb) + 16 * g; const char* fi = fr + PL;
#pragma unroll
    for (int ks = 0; ks < 4; ++ks) { const bf16x8 afr = *(const bf16x8*)(fr + 64 * ks), afi = *(const bf16x8*)(fi + 64 * ks);
      dre = __builtin_amdgcn_mfma_f32_16x16x32_bf16(bre[ks], afr, dre, 0, 0, 0); dre = __builtin_amdgcn_mfma_f32_16x16x32_bf16(x2[ks], afi, dre, 0, 0, 0);
      if (OUT != 1) { dim = __builtin_amdgcn_mfma_f32_16x16x32_bf16(bim[ks], afr, dim, 0, 0, 0); dim = __builtin_amdgcn_mfma_f32_16x16x32_bf16(x3[ks], afi, dim, 0, 0, 0); } }
    const int row = 16 * rb + n16, c0 = 16 * w + 4 * g;
    float vr[4], vi[4];
#pragma unroll
    for (int r = 0; r < 4; ++r) { vr[r] = dre[r]; vi[r] = dim[r];
      if (TW) { const float2 t = twid(lds, row * (c0 + r), INV); const float a = vr[r] * t.x - vi[r] * t.y, b = vr[r] * t.y + vi[r] * t.x; vr[r] = a; vi[r] = b; } }
    if (OUT == 0) { u32x2 wr_, wi_; wr_.x = pk2(vr[0], vr[1]); wr_.y = pk2(vr[2], vr[3]); wi_.x = pk2(vi[0], vi[1]); wi_.y = pk2(vi[2], vi[3]);
      *(u32x2*)(lds + O_DRE + RS * row + 2 * c0) = wr_; *(u32x2*)(lds + O_DIM + RS * row + 2 * c0) = wi_; }
    else if (OUT == 1) { *(f32x4*)((float*)lds + 128 * row + c0) = (f32x4){vr[0], vr[1], vr[2], vr[3]}; }
    else { const f32x4 ta = *(const f32x4*)(TW2 + 128 * row + c0), tb = *(const f32x4*)(TW2 + 128 * row + c0 + 2);
      *(f32x4*)((float*)lds + 128 * row + c0) = (f32x4){vr[0] * ta.x + vi[0] * ta.y, vr[1] * ta.z + vi[1] * ta.w, vr[2] * tb.x + vi[2] * tb.y, vr[3] * tb.z + vi[3] * tb.w}; }
  }
  __syncthreads();
}
template <bool INV, bool TW>
__device__ __forceinline__ void dft_rows(char* lds, int tid) {
  const int lane = tid & 63, w = tid >> 6, g = lane >> 4, n16 = lane & 15;
  bf16x8 are[4], aim[4], x2[4], x3[4];
  { const char* pr = lds + O_DRE + RS * (n16 + 16 * w) + 16 * g; const char* pi = pr + PL;
#pragma unroll
    for (int ks = 0; ks < 4; ++ks) { are[ks] = *(const bf16x8*)(pr + 64 * ks); aim[ks] = *(const bf16x8*)(pi + 64 * ks); x2[ks] = INV ? aim[ks] : negv(aim[ks]); x3[ks] = INV ? negv(are[ks]) : are[ks]; } }
#pragma unroll 2
  for (int cbk = 0; cbk < 8; ++cbk) {
    f32x4 dre = {0.f, 0.f, 0.f, 0.f}, dim = {0.f, 0.f, 0.f, 0.f};
    const char* fr = lds + O_FRE + RS * (n16 + 16 * cbk) + 16 * g; const char* fi = fr + PL;
#pragma unroll
    for (int ks = 0; ks < 4; ++ks) { const bf16x8 bfr = *(const bf16x8*)(fr + 64 * ks), bfi = *(const bf16x8*)(fi + 64 * ks);
      dre = __builtin_amdgcn_mfma_f32_16x16x32_bf16(bfr, are[ks], dre, 0, 0, 0); dre = __builtin_amdgcn_mfma_f32_16x16x32_bf16(bfi, x2[ks], dre, 0, 0, 0);
      dim = __builtin_amdgcn_mfma_f32_16x16x32_bf16(bfi, x3[ks], dim, 0, 0, 0); dim = __builtin_amdgcn_mfma_f32_16x16x32_bf16(bfr, aim[ks], dim, 0, 0, 0); }
    const int row = 16 * w + n16, c0 = 16 * cbk + 4 * g;
    float vr[4], vi[4];
#pragma unroll
    for (int r = 0; r < 4; ++r) { vr[r] = dre[r]; vi[r] = dim[r];
      if (TW) { const float2 t = twid(lds, row * (c0 + r), INV); const float a = vr[r] * t.x - vi[r] * t.y, b = vr[r] * t.y + vi[r] * t.x; vr[r] = a; vi[r] = b; } }
    u32x2 wr_, wi_; wr_.x = pk2(vr[0], vr[1]); wr_.y = pk2(vr[2], vr[3]); wi_.x = pk2(vi[0], vi[1]); wi_.y = pk2(vi[2], vi[3]);
    *(u32x2*)(lds + O_DRE + RS * row + 2 * c0) = wr_; *(u32x2*)(lds + O_DIM + RS * row + 2 * c0) = wi_;
  }
  __syncthreads();
}
template <bool ODD>
__device__ __forceinline__ void pointwise(char* lds, int tid) {
#pragma unroll 1
  for (int j = 0; j < (ODD ? 16 : 17); ++j) {
    const int pq = j * 512 + tid;
    int k1, k2, q1, q2; bool act = true;
    if (ODD) { k1 = pq >> 7; k2 = pq & 127; q1 = 127 - k1; q2 = 127 - k2; }
    else if (pq < 8064) { k1 = 1 + (pq >> 7); k2 = pq & 127; q1 = 128 - k1; q2 = 127 - k2; }
    else if (pq < 8192) { k1 = 0; k2 = pq - 8064; q1 = 0; q2 = (128 - k2) & 127; act = k2 <= q2; }
    else if (pq < 8320) { k1 = 64; k2 = pq - 8192; q1 = 64; q2 = 127 - k2; act = k2 <= q2; }
    else { k1 = k2 = q1 = q2 = 0; act = false; }
    if (act) {
      bf16_t* r0 = (bf16_t*)(lds + O_DRE + RS * k1 + 2 * k2); bf16_t* i0 = (bf16_t*)(lds + O_DIM + RS * k1 + 2 * k2);
      bf16_t* r1 = (bf16_t*)(lds + O_DRE + RS * q1 + 2 * q2); bf16_t* i1 = (bf16_t*)(lds + O_DIM + RS * q1 + 2 * q2);
      const float cx = bf2f(*r0), cy = bf2f(*i0), dx = bf2f(*r1), dy = bf2f(*i1);
      const float zx = 0.5f * (cx + dx), zy = 0.5f * (cy - dy), kx = 0.5f * (cy + dy), ky = -0.5f * (cx - dx);
      const float yx = zx * kx - zy * ky, yy = zx * ky + zy * kx;
      *r0 = (bf16_t)f2bf(yx); *i0 = (bf16_t)f2bf(yy); *r1 = (bf16_t)f2bf(yx); *i1 = (bf16_t)f2bf(-yy);
    }
  }
  __syncthreads();
}
}

__device__ __forceinline__ void conv3_pair(const bf16_t* __restrict__ row, int n0, float w0, float w1, float w2, float b, float& o0, float& o1) {
  const unsigned pr = *(const unsigned*)(row + (unsigned)n0); const float u0 = __uint_as_float(pr << 16), u1 = __uint_as_float(pr & 0xffff0000u);
  float um = bf2f(row[(unsigned)max(n0 - 1, 0)]), up = bf2f(row[(unsigned)min(n0 + 2, L - 1)]); um = n0 > 0 ? um : 0.f; up = (n0 + 2 < L) ? up : 0.f;
  o0 = w0 * um + w1 * u0 + w2 * u1 + b; o1 = w0 * u0 + w1 * u1 + w2 * up + b;
}
__device__ __forceinline__ void hyena_mfma_items(const Args& a, char* lds, int tid) {
  bf16_t* P1T = (bf16_t*)(a.ws + WS_P1T); const bf16_t* HT = (const bf16_t*)(a.ws + WS_HT);
  const float2* TW2 = (const float2*)(a.ws + WS_TW2);
  float* red = (float*)(lds + mf::O_RED); float* outf = (float*)lds;
  for (int idx = tid; idx < 16384; idx += 512) { const int r = idx >> 7, c = idx & 127, m = (r * c) & 127; float s, co; sincospif((float)m / 64.f, &s, &co);
    *(bf16_t*)(lds + mf::O_FRE + mf::RS * r + 2 * c) = (bf16_t)f2bf(co); *(bf16_t*)(lds + mf::O_FIM + mf::RS * r + 2 * c) = (bf16_t)f2bf(-s); }
  if (tid < 128) { float s, co; sincospif((float)tid / 64.f, &s, &co); ((float2*)(lds + mf::O_TWA))[tid] = make_float2(co, -s); ((float2*)(lds + mf::O_TWB))[tid] = TW2[2 * tid]; }
  __syncthreads();
  const float* cw = a.in[15]; const float* cbias = a.in[16]; const float* skip = a.in[23];
#ifndef HY_PROBE
#define HY_PROBE 0
#endif
#pragma unroll 1
  for (int pass = HY_PROBE ? 0 : 1; pass < 2; ++pass)
  for (int item = blockIdx.x; item < (pass ? 768 : 256); item += gridDim.x) {
    asm volatile("" : "+v"(tid));
    const int c = item;
    const float ad = fabsf(-3.0701134573f + (-15.350567286f + 3.0701134573f) * ((float)c * (1.f / 767.f))) * (1.f / 16383.f);
    const float dr1 = __expf(-ad);
    float z[32], acc[32];
    { const bf16_t* vr = P1T + (size_t)c * L; const float w0 = cw[c], w1 = cw[2304 + c], w2 = cw[4608 + c], b = cbias[c];
asm volatile("" : "+v"(tid));
#pragma unroll
      for (int jp = 0; jp < 16; ++jp) { if ((jp & 15) == 0) __builtin_amdgcn_sched_barrier(0); conv3_pair(vr, jp * 1024 + 2 * tid, w0, w1, w2, b, z[2 * jp], z[2 * jp + 1]); } }
#pragma unroll 1
    for (int o = 0; o < 2; ++o) {
      const bf16_t* hf = HT + (size_t)((o * 2 + 0) * 768 + c) * L; const bf16_t* hb = HT + (size_t)((o * 2 + 1) * 768 + c) * L;
      float ssum = 0.f; unsigned kst[16];
asm volatile("" : "+v"(tid));
#pragma unroll
      for (int jp = 0; jp < 16; ++jp) { if ((jp & 15) == 0) __builtin_amdgcn_sched_barrier(0); const int n0 = jp * 1024 + 2 * tid; const int nb0 = (L - n0) & (L - 1), nb1 = L - 1 - n0;
        const unsigned pf = *(const unsigned*)(hf + (unsigned)n0); const float e0 = __expf(-ad * (float)n0);
        const float f0 = __uint_as_float(pf << 16) * e0, f1 = __uint_as_float(pf & 0xffff0000u) * (e0 * dr1);
        float b0 = bf2f(hb[(unsigned)nb0]) * __expf(-ad * (float)nb0); const float b1 = bf2f(hb[(unsigned)nb1]) * __expf(-ad * (float)nb1);
        ssum += (fabsf(f0) + fabsf(b0)) + (fabsf(f1) + fabsf(b1)); b0 = n0 ? b0 : 0.f; const int off = mf::RS * (n0 >> 7) + 2 * (n0 & 127);
        *(unsigned*)(lds + mf::O_DRE + off) = pk2(z[2 * jp], z[2 * jp + 1]); *(unsigned*)(lds + mf::O_DIM + off) = pk2(f0 + b0, f1 + b1); kst[jp] = pk2(f0 - b0, f1 - b1); }
      ssum = wave_sum(ssum); if ((tid & 63) == 0) red[tid >> 6] = ssum;
      __syncthreads();
      const float nrm = EPS + ((red[0] + red[1]) + (red[2] + red[3])) + ((red[4] + red[5]) + (red[6] + red[7]));
      mf::dft_cols<false, true, 0>(lds, TW2, tid); mf::dft_rows<false, false>(lds, tid); mf::pointwise<false>(lds, tid);
      mf::dft_rows<true, true>(lds, tid); mf::dft_cols<true, false, 1>(lds, TW2, tid);
asm volatile("" : "+v"(tid));
#pragma unroll
      for (int jp = 0; jp < 16; ++jp) { if ((jp & 15) == 0) __builtin_amdgcn_sched_barrier(0); const float2 v = *(const float2*)(outf + jp * 1024 + 2 * tid); acc[2 * jp] = v.x; acc[2 * jp + 1] = v.y; }
      __syncthreads();
asm volatile("" : "+v"(tid));
#pragma unroll
      for (int jp = 0; jp < 16; ++jp) { if ((jp & 15) == 0) __builtin_amdgcn_sched_barrier(0); const int n0 = jp * 1024 + 2 * tid;
        const float k0 = __uint_as_float(kst[jp] << 16), k1 = __uint_as_float(kst[jp] & 0xffff0000u); const f32x4 w = *(const f32x4*)(TW2 + n0);
        const int off = mf::RS * (n0 >> 7) + 2 * (n0 & 127);
        *(unsigned*)(lds + mf::O_DRE + off) = pk2(z[2 * jp] * w.x - k0 * w.y, z[2 * jp + 1] * w.z - k1 * w.w);
        *(unsigned*)(lds + mf::O_DIM + off) = pk2(z[2 * jp] * w.y + k0 * w.x, z[2 * jp + 1] * w.w + k1 * w.z); }
      __syncthreads();
      mf::dft_cols<false, true, 0>(lds, TW2, tid); mf::dft_rows<false, false>(lds, tid); mf::pointwise<true>(lds, tid);
      mf::dft_rows<true, true>(lds, tid); mf::dft_cols<true, false, 2>(lds, TW2, tid);
      const bf16_t* gr = P1T + (size_t)((o + 1) * 768 + c) * L; const int gc = (o + 1) * 768 + c;
      const float w0 = cw[gc], w1 = cw[2304 + gc], w2 = cw[4608 + gc], b = cbias[gc], sk = skip[o * 768 + c], sc = (1.f / 32768.f) / nrm;
asm volatile("" : "+v"(tid));
#pragma unroll
      for (int jp = 0; jp < 16; ++jp) { if ((jp & 15) == 0) __builtin_amdgcn_sched_barrier(0); const int n0 = jp * 1024 + 2 * tid; const float2 v = *(const float2*)(outf + n0);
        float g0, g1; conv3_pair(gr, n0, w0, w1, w2, b, g0, g1);
        z[2 * jp] = g0 * ((acc[2 * jp] + v.x) * sc + sk * z[2 * jp]); z[2 * jp + 1] = g1 * ((acc[2 * jp + 1] + v.y) * sc + sk * z[2 * jp + 1]); }
      __syncthreads();
    }
    { const bf16_t* gt = P1T + (size_t)(2304 + c) * L; bf16_t* orow = pass ? P1T + (size_t)c * L : (bf16_t*)(a.ws + 126 * MiB) + (size_t)c * L;
asm volatile("" : "+v"(tid));
#pragma unroll
      for (int jp = 0; jp < 16; ++jp) { if ((jp & 15) == 0) __builtin_amdgcn_sched_barrier(0); const int n0 = jp * 1024 + 2 * tid; const unsigned pg = *(const unsigned*)(gt + (unsigned)n0);
        *(unsigned*)(orow + (unsigned)n0) = pk2(z[2 * jp] * __uint_as_float(pg << 16), z[2 * jp + 1] * __uint_as_float(pg & 0xffff0000u)); } }
#ifdef HY_EXTRA
    __syncthreads();
    for (int xr = 0; xr < HY_EXTRA; ++xr) { mf::dft_cols<false, true, 0>(lds, TW2, tid); mf::dft_rows<false, false>(lds, tid); mf::pointwise<false>(lds, tid); mf::dft_rows<true, true>(lds, tid); mf::dft_cols<true, false, 1>(lds, TW2, tid); }
#endif
  }
}

__device__ __forceinline__ void hyena_fourier_phase(const Args& a, char* lds, int tid) {
  float2* cb = (float2*)lds; float2* twL = (float2*)(lds + 135168); float* red = (float*)(lds + 135168 + 16384);
  bf16_t* P1T = (bf16_t*)(a.ws + WS_P1T); const bf16_t* HT = (const bf16_t*)(a.ws + WS_HT);
  const float2* TW2 = (const float2*)(a.ws + WS_TW2);
  for (int i = tid; i < 2048; i += 512) twL[i] = TW2[2 * i];
  __syncthreads();
  const float* cw = a.in[15]; const float* cbias = a.in[16]; const float* skip = a.in[23];
#ifndef HY_MFMA
#define HY_MFMA 1
#endif
  for (int item = (HY_MFMA ? 768 : 0) + blockIdx.x; item < 1024; item += gridDim.x) {
    asm volatile("" : "+v"(tid));
    if (item < 768) {
      const int c = item;
      const float ad = fabsf(-3.0701134573f + (-15.350567286f + 3.0701134573f) * ((float)c * (1.f / 767.f))) * (1.f / 16383.f);
      float z[32], acc[32];
      { const bf16_t* vr = P1T + (size_t)c * L; const float w0 = cw[c], w1 = cw[2304 + c], w2 = cw[4608 + c], b = cbias[c];
asm volatile("" : "+v"(tid));
#pragma unroll
        for (int j = 0; j < 32; ++j) { if ((j & 15) == 0) __builtin_amdgcn_sched_barrier(0); z[j] = conv3_at(vr, j * 512 + tid, w0, w1, w2, b); } }
#pragma unroll 1
      for (int o = 0; o < 2; ++o) {
        const bf16_t* hf = HT + (size_t)((o * 2 + 0) * 768 + c) * L; const bf16_t* hb = HT + (size_t)((o * 2 + 1) * 768 + c) * L;
        float ssum = 0.f;
asm volatile("" : "+v"(tid));
#pragma unroll
        for (int j = 0; j < 32; ++j) { if ((j & 15) == 0) __builtin_amdgcn_sched_barrier(0); const int n = j * 512 + tid; const int nb = (L - n) & (L - 1); const float f = bf2f(hf[(unsigned)n]) * __expf(-ad * (float)n); float b = bf2f(hb[(unsigned)nb]) * __expf(-ad * (float)nb);
          ssum += fabsf(f) + fabsf(b); b = n ? b : 0.f; cb[PADI(n)] = make_float2(z[j], f + b); }
        ssum = wave_sum(ssum); if ((tid & 63) == 0) red[tid >> 6] = ssum;
        __syncthreads();
        const float nrm = EPS + ((red[0] + red[1]) + (red[2] + red[3])) + ((red[4] + red[5]) + (red[6] + red[7]));
        fft_fwd(cb, twL, tid); fft_pointwise<false>(cb, tid); fft_inv(cb, twL, tid);
asm volatile("" : "+v"(tid));
#pragma unroll
        for (int j = 0; j < 32; ++j) { if ((j & 15) == 0) __builtin_amdgcn_sched_barrier(0); acc[j] = cb[PADI(j * 512 + tid)].x; }
        __syncthreads();
asm volatile("" : "+v"(tid));
#pragma unroll
        for (int j = 0; j < 32; ++j) { if ((j & 15) == 0) __builtin_amdgcn_sched_barrier(0); const int n = j * 512 + tid; const int nb = (L - n) & (L - 1); const float f = bf2f(hf[(unsigned)n]) * __expf(-ad * (float)n); float b = bf2f(hb[(unsigned)nb]) * __expf(-ad * (float)nb); b = n ? b : 0.f; const float kk = f - b; const float2 w = TW2[n];
          cb[PADI(n)] = make_float2(z[j] * w.x - kk * w.y, z[j] * w.y + kk * w.x); }
        __syncthreads();
        fft_fwd(cb, twL, tid); fft_pointwise<true>(cb, tid); fft_inv(cb, twL, tid);
        const bf16_t* gr = P1T + (size_t)((o + 1) * 768 + c) * L; const int gc = (o + 1) * 768 + c;
        const float w0 = cw[gc], w1 = cw[2304 + gc], w2 = cw[4608 + gc], b = cbias[gc], sk = skip[o * 768 + c], sc = (1.f / 32768.f) / nrm;
asm volatile("" : "+v"(tid));
#pragma unroll
        for (int j = 0; j < 32; ++j) { if ((j & 15) == 0) __builtin_amdgcn_sched_barrier(0); const int n = j * 512 + tid; const float2 r = cb[PADI(n)], w = TW2[n];
          const float cv = (acc[j] + r.x * w.x + r.y * w.y) * sc;
          z[j] = conv3_at(gr, n, w0, w1, w2, b) * (cv + sk * z[j]); }
        __syncthreads();
      }
      { const bf16_t* gt = P1T + (size_t)(2304 + c) * L; bf16_t* orow = P1T + (size_t)c * L;
asm volatile("" : "+v"(tid));
#pragma unroll
        for (int j = 0; j < 32; ++j) { if ((j & 15) == 0) __builtin_amdgcn_sched_barrier(0); const int n = j * 512 + tid; orow[n] = (bf16_t)f2bf(z[j] * bf2f(gt[n])); } }
#ifdef HY_EXTRA
      __syncthreads();
      for (int xr = 0; xr < 2; ++xr) { fft_fwd(cb, twL, tid); fft_pointwise<false>(cb, tid); fft_inv(cb, twL, tid); fft_fwd(cb, twL, tid); fft_pointwise<true>(cb, tid); fft_inv(cb, twL, tid); }
#endif
    } else {
      const int k = item - 768;
      const bf16_t* ar = P1T + (size_t)(3072 + k) * L; const bf16_t* ai = P1T + (size_t)(3328 + k) * L; const bf16_t* gt = P1T + (size_t)(3584 + k) * L;
asm volatile("" : "+v"(tid));
#pragma unroll
      for (int j = 0; j < 32; ++j) { if ((j & 15) == 0) __builtin_amdgcn_sched_barrier(0); const int n = j * 512 + tid; cb[PADI(n)] = make_float2(bf2f(ar[n]), bf2f(ai[n])); }
      __syncthreads();
      fft_fwd(cb, twL, tid);
      bf16_t* orow = P1T + (size_t)(3072 + k) * L;
asm volatile("" : "+v"(tid));
#pragma unroll
      for (int j = 0; j < 32; ++j) { if ((j & 15) == 0) __builtin_amdgcn_sched_barrier(0); const int n = j * 512 + tid; const int p = (int)(__brev((unsigned)n) >> 18); orow[n] = (bf16_t)f2bf(cb[PADI(p)].x * bf2f(gt[n])); }
      __syncthreads();
    }
  }
#if HY_MFMA
  __syncthreads();
  hyena_mfma_items(a, lds, tid);
#endif
}

__device__ __forceinline__ void transpose_phase(const bf16_t* __restrict__ P1T, bf16_t* __restrict__ MIX, char* lds, int tid) {
  bf16_t* tl = (bf16_t*)lds;
  for (int item = blockIdx.x; item < 16 * 256; item += gridDim.x) {
    const int ct = item & 15, tt = item >> 4, c0 = ct * 64, t0 = tt * 64;
    { const int ch = tid >> 3, tq = (tid & 7) * 8; const int srow = (c0 + ch) < 768 ? (c0 + ch) : (3072 + c0 + ch - 768);
      *(u32x4*)(tl + ch * 72 + tq) = *(const u32x4*)(P1T + (size_t)srow * L + t0 + tq); }
    __syncthreads();
    { const int tok = tid >> 3, cq = (tid & 7) * 8; unsigned short v[8];
#pragma unroll
      for (int e = 0; e < 8; ++e) v[e] = tl[(cq + e) * 72 + tok];
      u32x4 w; w.x = v[0] | ((unsigned)v[1] << 16); w.y = v[2] | ((unsigned)v[3] << 16); w.z = v[4] | ((unsigned)v[5] << 16); w.w = v[6] | ((unsigned)v[7] << 16);
      *(u32x4*)(MIX + (size_t)(t0 + tok) * 1024 + c0 + cq) = w; }
    __syncthreads();
  }
}

__device__ __forceinline__ void ht_phase(const bf16_t* __restrict__ W3T, const bf16_t* __restrict__ HD2, bf16_t* __restrict__ HT, int tid) {
  typedef short bf16x8 __attribute__((ext_vector_type(8)));
  typedef float f32x16 __attribute__((ext_vector_type(16)));
  const int lane = tid & 63, wid = tid >> 6, r32 = lane & 31, hi = lane >> 5;
  for (int item = blockIdx.x; item < 96 * 8; item += gridDim.x) {
    const int rb = item >> 3, tc = item & 7;
    bf16x8 af[4];
#pragma unroll
    for (int ks = 0; ks < 4; ++ks) af[ks] = *(const bf16x8*)(W3T + (size_t)(rb * 32 + r32) * 64 + ks * 16 + hi * 8);
#pragma unroll 2
    for (int tt = 0; tt < 8; ++tt) {
      const int t0 = tc * 2048 + wid * 256 + tt * 32;
      f32x16 acc = {};
#pragma unroll
      for (int ks = 0; ks < 4; ++ks) { const bf16x8 bfr = *(const bf16x8*)(HD2 + (size_t)(t0 + r32) * 64 + ks * 16 + hi * 8);
        acc = __builtin_amdgcn_mfma_f32_32x32x16_bf16(af[ks], bfr, acc, 0, 0, 0); }
#pragma unroll
      for (int r = 0; r < 16; ++r) { const int row = rb * 32 + (r & 3) + 8 * (r >> 2) + 4 * hi; HT[(size_t)row * L + t0 + r32] = (bf16_t)f2bf(acc[r]); }
    }
  }
}
#define LAS __attribute__((address_space(3)))
#define XB_TMO      128
#define XB_XCNT(j)  (256  + 64 * (j))
#define XB_XSUB(j)  (1280 + 64 * (j))
#define XB_XGEN(j)  (2304 + 64 * (j))
#define XB_TOP      3328
#define XB_TOPGEN   3392
#define XCD_BAR_WORDS 3456
#define XB_SPIN_CAP (1u << 18)

__device__ __forceinline__ unsigned xb_ld(unsigned* p)              { return __hip_atomic_load(p, __ATOMIC_RELAXED, __HIP_MEMORY_SCOPE_AGENT); }
__device__ __forceinline__ unsigned xb_add(unsigned* p, unsigned v) { return __hip_atomic_fetch_add(p, v, __ATOMIC_RELAXED, __HIP_MEMORY_SCOPE_AGENT); }
__device__ __forceinline__ unsigned xb_xcc_id() { return (unsigned)__builtin_amdgcn_s_getreg((3 << 11) | 20) & 0xFu; }
#define XB_SPIN(cond, bar) do { unsigned _sp = 0; while (cond) { __builtin_amdgcn_s_sleep(1); \
    if ((++_sp & 255u) == 0u) { if (xb_ld(&(bar)[XB_TMO])) break; if (_sp > XB_SPIN_CAP) { atomicAdd(&(bar)[XB_TMO], 1u); break; } } } } while (0)

struct XcdBarrier {
    unsigned* bar; unsigned x;
    volatile LAS unsigned* st;
};

__device__ __forceinline__ XcdBarrier xcd_barrier_post(unsigned* bar, volatile LAS unsigned* st, bool tid0) {
    XcdBarrier b; b.bar = bar; b.x = xb_xcc_id(); b.st = st;
    if (tid0) (void)xb_add(&bar[XB_XCNT(b.x)], 1u);
    return b;
}
__device__ __forceinline__ void xcd_barrier_complete(unsigned* bar, unsigned x, unsigned& nloc, unsigned& nx) {
    const unsigned G = gridDim.x * gridDim.y * gridDim.z;
    unsigned sum, cnt, mine, sp = 0u;
    for (;;) {
        sum = 0u; cnt = 0u; mine = 0u;
#pragma unroll
        for (unsigned j = 0; j < 16; ++j) { const unsigned c = xb_ld(&bar[XB_XCNT(j)]); sum += c; cnt += (c > 0u) ? 1u : 0u; mine = (j == x) ? c : mine; }
        if (sum == G) break;
        __builtin_amdgcn_s_sleep(1);
        if ((++sp & 255u) == 0u) { if (xb_ld(&bar[XB_TMO])) break; if (sp > XB_SPIN_CAP) { atomicAdd(&bar[XB_TMO], 1u); break; } }
    }
    nloc = mine > 0u ? mine : 1u; nx = cnt > 0u ? cnt : 1u;
}

__device__ __forceinline__ void xcd_barrier(const XcdBarrier& b, bool tid0) {
    asm volatile("s_waitcnt vmcnt(0)" ::: "memory");
    __syncthreads();
    if (tid0) {
        unsigned* bar = b.bar;
        __builtin_amdgcn_s_waitcnt(0);
        unsigned nloc = b.st[0], nx = b.st[1];
        if (nloc == 0u) { xcd_barrier_complete(bar, b.x, nloc, nx); b.st[0] = nloc; b.st[1] = nx; }
        const unsigned old = xb_add(&bar[XB_XSUB(b.x)], 1u);
        const unsigned gen = old / nloc;
        if (old + 1u == (gen + 1u) * nloc) {
            __builtin_amdgcn_fence(__ATOMIC_RELEASE, "agent");
            asm volatile("s_waitcnt vmcnt(0)" ::: "memory");
            const unsigned og = xb_add(&bar[XB_TOP], 1u);
            const unsigned tg = og / nx;
            if (og + 1u == (tg + 1u) * nx) xb_add(&bar[XB_TOPGEN], 1u);
            else XB_SPIN(xb_ld(&bar[XB_TOPGEN]) == tg, bar);
            __builtin_amdgcn_fence(__ATOMIC_ACQUIRE, "agent");
            xb_add(&bar[XB_XGEN(b.x)], 1u);
            asm volatile("s_waitcnt vmcnt(0)" ::: "memory");
        } else {
            XB_SPIN(xb_ld(&bar[XB_XGEN(b.x)]) == gen, bar);
            __builtin_amdgcn_fence(__ATOMIC_ACQUIRE, "agent");
            asm volatile("s_waitcnt vmcnt(0)" ::: "memory");
        }
    }
    __syncthreads();
}
__device__ __forceinline__ int lane_id_opaque() {
  int l; asm volatile("v_mbcnt_lo_u32_b32 %0, -1, 0\n\tv_mbcnt_hi_u32_b32 %0, -1, %0" : "=v"(l)); return l;
}
__global__ void __launch_bounds__(512, 2) mega_fwd(Args a) {
  extern __shared__ __attribute__((aligned(16))) unsigned char lds_raw[];
  const int wid_s = __builtin_amdgcn_readfirstlane((int)threadIdx.x >> 6);
#define MK_TID() (wid_s * 64 + lane_id_opaque())
  int tid;
  unsigned char* ws = a.ws;
  PG8_LAS unsigned char* ldsl = (PG8_LAS unsigned char*)lds_raw;
  float* xs = (float*)(lds_raw + XS_OFF);
  const float* MOD = (const float*)(ws + WS_MOD);
  const int lo = a.ph_lo, hi = a.ph_hi, G = gridDim.x, bc = blockIdx.x;
#ifndef MK_FUSE_NORM
#define MK_FUSE_NORM 0
#endif
  const bool fuse = MK_FUSE_NORM && (G == 256) && !MK_MULTI;
#ifndef PH_MASK
#define PH_MASK 0xFFF
#endif
#define IN(k) ((((PH_MASK) >> (k)) & 1) && lo <= (k) && (k) < hi)
#ifndef DBL_MASK
#define DBL_MASK 0
#endif
#define NREP(k) ((((DBL_MASK) >> (k)) & 1) ? 2 : 1)
  volatile LAS unsigned* xst = (volatile LAS unsigned*)((LAS unsigned char*)lds_raw + 155000);
  if (MK_TID() == 0) { xst[0] = 0u; xst[1] = 0u; }
  __syncthreads();
  XcdBarrier xbar = xcd_barrier_post((unsigned*)(ws + WS_BAR), xst, MK_TID() == 0);
  if (a.ph_hi < 0) cg::this_grid().sync();
#define SEAM(k) do { if (IN(k) && IN((k) + 1)) xcd_barrier(xbar, MK_TID() == 0); } while (0)
  if (IN(0)) for (int rep = 0; rep < NREP(0); ++rep) { tid = MK_TID(); asm volatile("" : "+v"(tid)); p0_prep(a, (float*)lds_raw, tid); } SEAM(0);
  if (IN(1)) for (int rep = 0; rep < NREP(1); ++rep) { tid = MK_TID(); asm volatile("" : "+v"(tid)); rows_norm_mod(a.in[0], a.in[2], CTX, LK, a.in[6], MOD, MOD + 3072, (bf16_t*)(ws + WS_H), tid); } SEAM(1);
  if (IN(2)) for (int rep = 0; rep < NREP(2); ++rep) { tid = MK_TID(); asm volatile("" : "+v"(tid));
    pg8::Gemm g; g.A = (const bf16_t*)(ws + WS_H); g.Bt = (const bf16_t*)(ws + WS_WIN0); g.M = LK; g.N = 2560; g.K = 1024;
    pg8::SchedIn0 S; S.G = G; S.c = bc;
    pg8::EpiIn0 E; E.AV = (float*)(ws + WS_AV); E.AG = (bf16_t*)(ws + WS_AG); E.Q = (bf16_t*)(ws + WS_Q); E.K = (bf16_t*)(ws + WS_K); E.V = (bf16_t*)(ws + WS_V); E.BG = (bf16_t*)(ws + WS_BG);
    E.qg = a.in[11]; E.kg = a.in[12]; E.rope = (const float2*)(ws + WS_ROPE); E.xs = xs;
    pg8::gemm_phase<pg8::EpiIn0, pg8::SchedIn0, true, false>(ldsl, g, S, E, tid);
    tid = MK_TID(); asm volatile("" : "+v"(tid));
    prep_queue(a, (unsigned*)(ws + WS_CNT) + 388 + rep, (volatile unsigned*)(lds_raw + 154000), (float*)lds_raw, tid);
  } SEAM(2);
  if (IN(3)) for (int rep = 0; rep < NREP(3); ++rep) { tid = MK_TID(); asm volatile("" : "+v"(tid));
    if (G == 256) {
      const int vb = ((bc & 7) >> 2) * 128 + (bc >> 3) * 4 + (bc & 3);
      const int kvh = vb >> 7, pk = (vb & 127) >> 1, side = vb & 1, cidx = vb >> 1;
      { const int w = 3 * pk + side, h = kvh * 3 + (w % 3), qb = w / 3;
        __syncthreads();
        attn::attn_dense_body<false>((const attn::bf16*)(ws + WS_Q) + (size_t)qb * 256 * 768 + h * 128, (const attn::bf16*)(ws + WS_K) + (size_t)kvh * LK * 128, (const attn::bf16*)(ws + WS_V) + (size_t)kvh * LK * 128,
                              (const bf16_t*)(ws + WS_BG) + (size_t)qb * 256 * 768 + h * 128, (bf16_t*)(ws + WS_H) + (size_t)qb * 256 * 1024 + 256 + h * 128, LK, (char*)lds_raw, nullptr, nullptr, nullptr, MK_TID()); }
      { const int w = 3 * pk + 2, h = kvh * 3 + (w % 3), qb = w / 3; const size_t koff = (size_t)side * (LK / 2) * 128;
        float* pbase = (float*)(ws + WS_PARTIAL) + (size_t)cidx * 2 * PARTIAL_FLOATS;
        __syncthreads();
        attn::attn_dense_body<true>((const attn::bf16*)(ws + WS_Q) + (size_t)qb * 256 * 768 + h * 128, (const attn::bf16*)(ws + WS_K) + koff + (size_t)kvh * LK * 128, (const attn::bf16*)(ws + WS_V) + koff + (size_t)kvh * LK * 128,
                              (const bf16_t*)(ws + WS_BG) + (size_t)qb * 256 * 768 + h * 128, (bf16_t*)(ws + WS_H) + (size_t)qb * 256 * 1024 + 256 + h * 128, LK / 2, (char*)lds_raw,
                              pbase + (size_t)side * PARTIAL_FLOATS, pbase + (size_t)(side ^ 1) * PARTIAL_FLOATS, (unsigned*)(ws + WS_CNT) + cidx, MK_TID()); }
    } else {
      for (int item = bc; item < 384; item += G) {
        const int h = item % 6, qb = item / 6, kvh = h / 3;
        __syncthreads();
        attn::attn_dense_body<false>((const attn::bf16*)(ws + WS_Q) + (size_t)qb * 256 * 768 + h * 128, (const attn::bf16*)(ws + WS_K) + (size_t)kvh * LK * 128, (const attn::bf16*)(ws + WS_V) + (size_t)kvh * LK * 128,
                              (const bf16_t*)(ws + WS_BG) + (size_t)qb * 256 * 768 + h * 128, (bf16_t*)(ws + WS_H) + (size_t)qb * 256 * 1024 + 256 + h * 128, LK, (char*)lds_raw, nullptr, nullptr, nullptr, MK_TID());
      }
    }
    tid = MK_TID(); asm volatile("" : "+v"(tid));
    pool_phase((const float*)(ws + WS_AV), (const bf16_t*)(ws + WS_AG), (bf16_t*)(ws + WS_H), (unsigned*)(ws + WS_CNT) + 384 + rep, (volatile unsigned*)(lds_raw + 70000), tid);
  } SEAM(3);
  if (IN(4)) for (int rep = 0; rep < NREP(4); ++rep) { tid = MK_TID(); asm volatile("" : "+v"(tid));
    pg8::Gemm g; g.A = (const bf16_t*)(ws + WS_H); g.Bt = (const bf16_t*)(ws + WS_WOUT0); g.M = L; g.N = 1024; g.K = 1024;
    pg8::SchedRow S; S.nN = 4; S.total = 256; S.G = G; S.c = bc;
    if (fuse) { pg8::EpiResNorm<2> E; E.base = a.in[0]; E.out = a.out; E.gate = MOD + 2048; E.g = a.in[6] + 1024; E.mod = MOD + 2 * 3072; E.H = (bf16_t*)(ws + WS_H2);
      E.psq = (float*)(ws + WS_PART); E.cnt = (unsigned*)(ws + WS_CNT) + 256; E.xs = xs;
      pg8::gemm_phase<pg8::EpiResNorm<2>, pg8::SchedRow, true, false>(ldsl, g, S, E, tid); }
    else { pg8::EpiRes E; E.base = a.in[0]; E.out = a.out; E.gate = MOD + 2048;
      pg8::gemm_phase<pg8::EpiRes, pg8::SchedRow, true, false>(ldsl, g, S, E, tid); }
  } SEAM(4);
  if (IN(5)) for (int rep = 0; rep < NREP(5); ++rep) { tid = MK_TID(); asm volatile("" : "+v"(tid)); if (!fuse) rows_norm_mod(a.out, a.out, 0, L, a.in[6] + 1024, MOD + 2 * 3072, MOD + 2 * 3072, (bf16_t*)(ws + WS_H2), tid); } SEAM(5);
  if (IN(6)) for (int rep = 0; rep < NREP(6); ++rep) { tid = MK_TID(); asm volatile("" : "+v"(tid));
    pg8::Gemm g; g.A = (const bf16_t*)(ws + WS_WIN1); g.Bt = (const bf16_t*)(ws + WS_H2); g.M = 3840; g.N = L; g.K = 1024;
    pg8::SchedCol S; S.nM = 15; S.total = 15 * 64; S.G = G; S.c = bc;
    pg8::EpiT E; E.O = (bf16_t*)(ws + WS_P1T); E.gated = 1;
    pg8::gemm_phase<pg8::EpiT, pg8::SchedCol, true, false>(ldsl, g, S, E, tid);
  } SEAM(6);
  if (IN(7)) for (int rep = 0; rep < NREP(7); ++rep) { tid = MK_TID(); asm volatile("" : "+v"(tid));
    ht_phase((const bf16_t*)(ws + WS_W3T), (const bf16_t*)(ws + WS_HD2B), (bf16_t*)(ws + WS_HT), tid);
  } SEAM(7);
  if (IN(8)) for (int rep = 0; rep < NREP(8); ++rep) { tid = MK_TID(); asm volatile("" : "+v"(tid)); hyena_fourier_phase(a, (char*)lds_raw, tid); } SEAM(8);
  if (IN(9)) for (int rep = 0; rep < NREP(9); ++rep) { tid = MK_TID(); asm volatile("" : "+v"(tid)); transpose_phase((const bf16_t*)(ws + WS_P1T), (bf16_t*)(ws + WS_H), (char*)lds_raw, tid); } SEAM(9);
  if (IN(10)) for (int rep = 0; rep < NREP(10); ++rep) { tid = MK_TID(); asm volatile("" : "+v"(tid));
    pg8::Gemm g; g.A = (const bf16_t*)(ws + WS_H); g.Bt = (const bf16_t*)(ws + WS_WOUT1); g.M = L; g.N = 1024; g.K = 1024;
    pg8::SchedRow S; S.nN = 4; S.total = 256; S.G = G; S.c = bc;
    if (fuse) { pg8::EpiResNorm<1> E; E.base = a.out; E.out = a.out; E.gate = MOD + 2 * 3072 + 2048; E.g = a.in[25]; E.mod = MOD; E.H = nullptr;
      E.psq = (float*)(ws + WS_PART) + 65536; E.cnt = (unsigned*)(ws + WS_CNT) + 320; E.xs = xs;
      pg8::gemm_phase<pg8::EpiResNorm<1>, pg8::SchedRow, true, false>(ldsl, g, S, E, tid); }
    else { pg8::EpiRes E; E.base = a.out; E.out = a.out; E.gate = MOD + 2 * 3072 + 2048;
      pg8::gemm_phase<pg8::EpiRes, pg8::SchedRow, true, false>(ldsl, g, S, E, tid); }
  } SEAM(10);
  if (IN(11)) for (int rep = 0; rep < NREP(11); ++rep) { tid = MK_TID(); asm volatile("" : "+v"(tid)); if (!fuse) rows_final(a.out, a.in[25], tid); }
#undef IN
#undef SEAM
}

extern "C" void kernel_launch(void* const* d_in, const int* in_sizes, int n_in, void* d_out, int out_size, void* d_ws, size_t ws_size, hipStream_t stream) {
  static int grid = 0;
  if (grid == 0) {
    if (n_in != 26 || in_sizes[0] != L * DM || out_size != L * DM || ws_size < WS_END) {
      fprintf(stderr, "kernel_launch: unexpected shapes: n_in %d in0 %d out %d ws %zu (need >= %zu)\n", n_in, n_in > 0 ? in_sizes[0] : -1, out_size, ws_size, (size_t)WS_END); grid = -1; return; }
    int dev = 0, cus = 0, per_cu = 0;
    if (hipGetDevice(&dev) != hipSuccess || hipDeviceGetAttribute(&cus, hipDeviceAttributeMultiprocessorCount, dev) != hipSuccess) { fprintf(stderr, "kernel_launch: device query failed\n"); grid = -1; return; }
    if (hipFuncSetAttribute((const void*)mega_fwd, hipFuncAttributeMaxDynamicSharedMemorySize, LDS_BYTES) != hipSuccess) { fprintf(stderr, "kernel_launch: hipFuncSetAttribute failed\n"); grid = -1; return; }
    if (hipOccupancyMaxActiveBlocksPerMultiprocessor(&per_cu, (const void*)mega_fwd, 512, LDS_BYTES) != hipSuccess || per_cu < 1) { fprintf(stderr, "kernel_launch: occupancy query says %d\n", per_cu); per_cu = 1; }
    (void)hipGetLastError();
    grid = cus * per_cu;
    fprintf(stderr, "kernel_launch: grid %d (cus %d x %d)\n", grid, cus, per_cu);
  }
  if (grid < 0) return;
  if (hipMemsetAsync((unsigned char*)d_ws + WS_BAR, 0, 16384, stream) != hipSuccess) { fprintf(stderr, "kernel_launch: memset failed\n"); return; }
  Args a{};
  for (int i = 0; i < 26; ++i) a.in[i] = (const float*)d_in[i];
  a.out = (float*)d_out; a.ws = (unsigned char*)d_ws;
#if MK_MULTI
  for (int ph = 0; ph < NPH; ++ph) { a.ph_lo = ph; a.ph_hi = ph + 1; hipLaunchKernelGGL(mega_fwd, dim3(grid), dim3(512), LDS_BYTES, stream, a); }
#else
  a.ph_lo = 0; a.ph_hi = NPH;
  void* args[] = {&a};
  hipError_t e = hipLaunchCooperativeKernel((const void*)mega_fwd, dim3(grid), dim3(512), args, LDS_BYTES, stream);
  if (e != hipSuccess) fprintf(stderr, "kernel_launch: cooperative launch failed: %s (grid %d)\n", hipGetErrorString(e), grid);
#endif
}
```

```cpp
#include <hip/hip_runtime.h>
#include <hip/hip_bf16.h>
#include <hip/hip_cooperative_groups.h>
#include <cstdio>
#include <cstdint>
namespace cg = cooperative_groups;

#ifndef MK_FUSE_NORM
#define MK_FUSE_NORM 0
#endif
#ifndef MK_MULTI
#define MK_MULTI 0
#endif

constexpr int L = 16384, DM = 1024, CTX = 256, LK = L + CTX;
constexpr int NPH = 12;
constexpr float EPS = 1e-6f;
constexpr size_t MiB = (size_t)1 << 20, KiB = 1024;
constexpr size_t WS_MOD = 0, WS_ROPE = 64 * KiB, WS_TW2 = 128 * KiB, WS_T = 256 * KiB, WS_PART = 768 * KiB;
constexpr size_t WS_WIN0 = 2 * MiB, WS_WOUT0 = 7 * MiB, WS_WIN1 = 9 * MiB, WS_WOUT1 = 17 * MiB, WS_W3T = 19 * MiB, WS_HD2B = 21 * MiB;
constexpr size_t WS_H = 30 * MiB, WS_AV = 63 * MiB, WS_AG = 79 * MiB, WS_Q = 87 * MiB, WS_K = 111 * MiB, WS_V = 120 * MiB, WS_BG = 129 * MiB;
constexpr size_t WS_BAR = 1600 * KiB; constexpr size_t WS_CNT = 1536 * KiB, WS_PARTIAL = 160 * MiB; constexpr size_t PARTIAL_FLOATS = 256 * 128 + 512;
constexpr size_t WS_H2 = MK_FUSE_NORM ? 63 * MiB : 30 * MiB;
constexpr size_t WS_P1T = 136 * MiB, WS_HT = 30 * MiB, WS_END = 256 * MiB;
constexpr int LDS_BYTES = 155648;
constexpr int XS_OFF = 131072;

typedef unsigned short bf16_t;
typedef float f32x4 __attribute__((ext_vector_type(4)));
typedef unsigned u32x4 __attribute__((ext_vector_type(4)));
typedef unsigned u32x2 __attribute__((ext_vector_type(2)));

struct Args { const float* in[26]; float* out; unsigned char* ws; int ph_lo, ph_hi; };

__device__ __forceinline__ float bf2f(bf16_t v) { return __uint_as_float((unsigned)v << 16); }
__device__ __forceinline__ unsigned f2bf(float f) { unsigned u = __float_as_uint(f); return (u + 0x7fffu + ((u >> 16) & 1u)) >> 16; }
__device__ __forceinline__ unsigned pk2(float lo, float hi) { return f2bf(lo) | (f2bf(hi) << 16); }
__device__ __forceinline__ float siluf(float v) { return v / (1.f + __expf(-v)); }
__device__ __forceinline__ float wave_sum(float v) {
#pragma unroll
  for (int o = 32; o >= 1; o >>= 1) v += __shfl_xor(v, o);
  return v;
}

__device__ __forceinline__ int qk_srccol(int j) {
  if (j < 512 || j >= 1536) return j;
  const int base = j & ~127, p = j & 127, g = p >> 3, e = p & 7;
  const int axis = g >> 3, f = 4 * (g & 7) + (e & 3), half = e >> 2;
  return base + axis * 64 + half * 32 + f;
}
template <int MODE>
__device__ __forceinline__ void wt_tile(const float* __restrict__ src, int ldn, int off, bf16_t* __restrict__ dst, int j0, int k0, float* tl, int tid) {
  const int cc = tid & 63, r0 = tid >> 6;
  const int sc = (MODE == 1) ? qk_srccol(j0 + cc) : (off + j0 + cc);
#pragma unroll
  for (int i = 0; i < 8; ++i) { const int r = r0 + 8 * i; tl[r * 65 + cc] = src[(size_t)(k0 + r) * ldn + sc]; }
  __syncthreads();
  const int n = tid >> 3, kq = (tid & 7) * 8;
  u32x4 w;
  w.x = pk2(tl[(kq + 0) * 65 + n], tl[(kq + 1) * 65 + n]); w.y = pk2(tl[(kq + 2) * 65 + n], tl[(kq + 3) * 65 + n]);
  w.z = pk2(tl[(kq + 4) * 65 + n], tl[(kq + 5) * 65 + n]); w.w = pk2(tl[(kq + 6) * 65 + n], tl[(kq + 7) * 65 + n]);
  *(u32x4*)(dst + (size_t)(j0 + n) * 1024 + k0 + kq) = w;
  __syncthreads();
}
template <int MODE>
__device__ __forceinline__ void wt_quad(const float* __restrict__ src, int ldn, int off, bf16_t* __restrict__ dst, int j0, int k0, float* tl, int tid) {
  const int cc = tid & 63, r0 = tid >> 6;
  const int sc = (MODE == 1) ? qk_srccol(j0 + cc) : (off + j0 + cc);
  float v[32];
#pragma unroll
  for (int i = 0; i < 32; ++i) v[i] = src[(size_t)(k0 + r0 + 8 * i) * ldn + sc];
#pragma unroll
  for (int i = 0; i < 32; ++i) tl[(r0 + 8 * i) * 65 + cc] = v[i];
  __syncthreads();
  const int n = tid >> 3, kq = (tid & 7) * 8;
#pragma unroll
  for (int s = 0; s < 4; ++s) { const float* t = tl + (s * 64 + kq) * 65 + n; u32x4 w;
    w.x = pk2(t[0], t[65]); w.y = pk2(t[130], t[195]); w.z = pk2(t[260], t[325]); w.w = pk2(t[390], t[455]);
    *(u32x4*)(dst + (size_t)(j0 + n) * 1024 + k0 + s * 64 + kq) = w; }
  __syncthreads();
}
__device__ __forceinline__ void wt_pool_tile(const float* __restrict__ src, const float* __restrict__ pw, const float* __restrict__ pscale, bf16_t* __restrict__ dst, int j0, int k0, float* lds, int tid) {
  float* A = lds; float* Bm = lds + 64 * 65; float* tl = lds + 2 * 64 * 65;
  const int cc = tid & 63, r0 = tid >> 6, g = j0 >> 6;
#pragma unroll
  for (int i = 0; i < 8; ++i) { const int r = r0 + 8 * i; A[r * 65 + cc] = src[(size_t)(k0 + r) * 2560 + g * 64 + cc]; Bm[r * 65 + cc] = pw[(g * 64 + r) * 64 + cc]; }
  __syncthreads();
  const float sc = pscale[j0 + cc];
#pragma unroll
  for (int i = 0; i < 8; ++i) { const int r = r0 + 8 * i; float s = 0.f;
    for (int q = 0; q < 64; ++q) s += A[r * 65 + q] * Bm[q * 65 + cc];
    tl[r * 65 + cc] = s * sc; }
  __syncthreads();
  const int n = tid >> 3, kq = (tid & 7) * 8;
  u32x4 w;
  w.x = pk2(tl[(kq + 0) * 65 + n], tl[(kq + 1) * 65 + n]); w.y = pk2(tl[(kq + 2) * 65 + n], tl[(kq + 3) * 65 + n]);
  w.z = pk2(tl[(kq + 4) * 65 + n], tl[(kq + 5) * 65 + n]); w.w = pk2(tl[(kq + 6) * 65 + n], tl[(kq + 7) * 65 + n]);
  *(u32x4*)(dst + (size_t)(j0 + n) * 1024 + k0 + kq) = w;
  __syncthreads();
}

namespace prep {
constexpr int N_MOD = 192, N_WIN0 = 208, N_WOUT = 64, N_WIN1A = 192, N_WIN1B = 16, N_T = 256, N_HD2 = 256, N_W3T = 48, N_ROPE = 16, N_TW2 = 32;
constexpr int O_WIN0 = N_MOD, O_WOUT0 = O_WIN0 + N_WIN0, O_WOUT1 = O_WOUT0 + N_WOUT, O_WIN1A = O_WOUT1 + N_WOUT, O_WIN1B = O_WIN1A + N_WIN1A,
                O_T = O_WIN1B + N_WIN1B, O_HD2 = O_T + N_T, O_W3T = O_HD2 + N_HD2, O_ROPE = O_W3T + N_W3T, O_TW2 = O_ROPE + N_ROPE, O_END = O_TW2 + N_TW2;
constexpr int N_EARLY = O_WOUT1 + N_T + N_ROPE + N_TW2, N_LATE = (O_T - O_WOUT1) + (O_ROPE - O_HD2);
__host__ __device__ constexpr int early_item(int e) { return e < O_WOUT1 ? e : (e < O_WOUT1 + N_T ? O_T + (e - O_WOUT1) : O_ROPE + (e - O_WOUT1 - N_T)); }
__host__ __device__ constexpr int late_item(int q) { return q < O_T - O_WOUT1 ? O_WOUT1 + q : O_HD2 + (q - (O_T - O_WOUT1)); }
}
__device__ __forceinline__ void prep_item(const Args& a, int item, float* lds, int tid) {
  using namespace prep;
  unsigned char* ws = a.ws;
  {
    asm volatile("" : "+v"(tid));
    if (item < O_WIN0) {
      const int layer = item / 96, chunk = item % 96, col = chunk * 32 + (tid & 31), rg = tid >> 5;
      const float* wm = a.in[4] + (size_t)layer * 1024 * 3072; const float* cv = a.in[1]; const float* cc = a.in[3];
      float s0 = 0.f, s1 = 0.f;
      for (int r = rg; r < 1024; r += 16) { const float w = wm[(size_t)r * 3072 + col]; s0 += siluf(cv[r]) * w; if (layer == 0) s1 += siluf(cc[r]) * w; }
      lds[tid] = s0; lds[512 + tid] = s1; __syncthreads();
      if (tid < 32) { float t0 = 0.f, t1 = 0.f; for (int q = 0; q < 16; ++q) { t0 += lds[q * 32 + tid]; t1 += lds[512 + q * 32 + tid]; }
        const float bm = a.in[5][layer * 3072 + col]; float* MOD = (float*)(ws + WS_MOD);
        if (layer == 0) { MOD[col] = t0 + bm; MOD[3072 + col] = t1 + bm; } else MOD[2 * 3072 + col] = t0 + bm; }
      __syncthreads();
    } else if (item < O_WOUT0) {
      const int ti = item - O_WIN0;
      if (ti < 64) wt_pool_tile(a.in[7], a.in[9], a.in[10], (bf16_t*)(ws + WS_WIN0), (ti / 16) * 64, (ti % 16) * 64, lds, tid);
      else { const int tq = ti - 64; wt_quad<1>(a.in[7], 2560, 0, (bf16_t*)(ws + WS_WIN0), (4 + tq / 4) * 64, (tq % 4) * 256, lds, tid); }
    } else if (item < O_WOUT1) { const int ti = item - O_WOUT0; wt_quad<0>(a.in[8], 1024, 0, (bf16_t*)(ws + WS_WOUT0), (ti / 4) * 64, (ti % 4) * 256, lds, tid);
    } else if (item < O_WIN1A) { const int ti = item - O_WOUT1; wt_quad<0>(a.in[14], 1024, 0, (bf16_t*)(ws + WS_WOUT1), (ti / 4) * 64, (ti % 4) * 256, lds, tid);
    } else if (item < O_WIN1B) { const int ti = item - O_WIN1A; wt_quad<0>(a.in[13], 3584, 0, (bf16_t*)(ws + WS_WIN1), (ti / 4) * 64, (ti % 4) * 256, lds, tid);
    } else if (item < O_T) {     const int ti = item - O_WIN1B; wt_quad<0>(a.in[13], 3584, 3328 - 3584, (bf16_t*)(ws + WS_WIN1), 3584 + (ti / 4) * 64, (ti % 4) * 256, lds, tid);
    } else if (item < O_HD2) {
      const int i = item - O_T;
      if (tid < 256) lds[tid] = cospif((float)tid / 128.f);
      __syncthreads();
      const int n = tid & 255, part = tid >> 8; const float* fw = a.in[24];
      float s = 0.f;
      for (int j = 0; j < 256; ++j) { const int m = (i * j) & 255; const float tr = part ? lds[(m - 64) & 255] : lds[m]; s += tr * fw[j * 256 + n]; }
      ((float*)(ws + WS_T))[(part * 256 + i) * 256 + n] = (part ? -s : s) * (1.f / 2048.f);
      __syncthreads();
    } else if (item < O_W3T) {
      const int t0 = (item - O_HD2) * 64;
      float* e = lds; float* h1 = lds + 64 * 34;
      for (int idx = tid; idx < 64 * 33; idx += 512) { const int tl = idx / 33, q = idx % 33, t = t0 + tl; float v;
        if (q == 0) v = (float)t / 16383.f;
        else { const int b = (q - 1) & 15; const float f = 1e-4f + (float)b * ((15.f - 1e-4f) / 15.f); const float w = 6.2831855f * (float)t / 16384.f; const float ar = f * w;
          v = (q <= 16) ? cosf(ar) : -sinf(ar); }
        e[tl * 34 + q] = v; }
      __syncthreads();
      const int j = tid & 63, r0 = tid >> 6; const float fr = a.in[22][j];
#pragma unroll
      for (int i = 0; i < 8; ++i) { const int tl = r0 + 8 * i; float s = a.in[18][j];
        for (int q = 0; q < 33; ++q) s += e[tl * 34 + q] * a.in[17][q * 64 + j];
        h1[tl * 65 + j] = sinf(fr * s); }
      __syncthreads();
      bf16_t* HD = (bf16_t*)(ws + WS_HD2B);
#pragma unroll
      for (int i = 0; i < 8; ++i) { const int tl = r0 + 8 * i; float s = a.in[20][j];
        for (int q = 0; q < 64; ++q) s += h1[tl * 65 + q] * a.in[19][q * 64 + j];
        HD[(size_t)(t0 + tl) * 64 + j] = (bf16_t)f2bf(sinf(fr * s)); }
      __syncthreads();
    } else if (item < O_ROPE) {
      const int row = (item - O_W3T) * 64 + (tid >> 3), kg = (tid & 7) * 8; u32x4 w = {0u, 0u, 0u, 0u};
      { const float* w3 = a.in[21]; float v[8];
#pragma unroll
        for (int q = 0; q < 8; ++q) v[q] = w3[(size_t)(kg + q) * 3072 + row];
        w.x = pk2(v[0], v[1]); w.y = pk2(v[2], v[3]); w.z = pk2(v[4], v[5]); w.w = pk2(v[6], v[7]); }
      *(u32x4*)((bf16_t*)(ws + WS_W3T) + (size_t)row * 64 + kg) = w;
    } else if (item < O_TW2) {
      const int idx = (item - O_ROPE) * 512 + tid, pos = idx >> 5, f = idx & 31;
      const float inv = powf(10000.f, -(float)f / 32.f), ang = (float)pos * inv;
      ((float2*)(ws + WS_ROPE))[idx] = make_float2(cosf(ang), sinf(ang));
    } else {
      if (item == O_TW2 && tid < 392) ((unsigned*)(ws + WS_CNT))[tid] = 0u;
      const int n = (item - O_TW2) * 512 + tid; float s, c; sincospif((float)n / 16384.f, &s, &c);
      ((float2*)(ws + WS_TW2))[n] = make_float2(c, -s);
    }
  }
}
__device__ __forceinline__ void p0_prep(const Args& a, float* lds, int tid) {
  for (int e = blockIdx.x; e < prep::N_EARLY; e += gridDim.x) prep_item(a, prep::early_item(e), lds, tid);
}

__device__ __forceinline__ void rows_norm_mod(const float* __restrict__ X, const float* __restrict__ C, int nctx, int nrows, const float* __restrict__ g,
                                              const float* __restrict__ modx, const float* __restrict__ modc, bf16_t* __restrict__ H, int tid) {
  const int lane = tid & 63, wid = tid >> 6;
  for (int row = blockIdx.x * 8 + wid; row < nrows; row += gridDim.x * 8) {
    const float* src = row < nctx ? C + (size_t)row * 1024 : X + (size_t)(row - nctx) * 1024; const float* md = row < nctx ? modc : modx;
    f32x4 v[4]; float ss = 0.f;
#pragma unroll
    for (int i = 0; i < 4; ++i) { v[i] = *(const f32x4*)(src + (lane + 64 * i) * 4); ss += v[i].x * v[i].x + v[i].y * v[i].y + v[i].z * v[i].z + v[i].w * v[i].w; }
    ss = wave_sum(ss); const float rinv = rsqrtf(ss * (1.f / 1024.f) + EPS);
#pragma unroll
    for (int i = 0; i < 4; ++i) { const int c = (lane + 64 * i) * 4; const f32x4 gg = *(const f32x4*)(g + c), sh = *(const f32x4*)(md + c), sc = *(const f32x4*)(md + 1024 + c);
      const f32x4 y = v[i] * rinv * gg * (sc + 1.f) + sh;
      u32x2 w; w.x = pk2(y.x, y.y); w.y = pk2(y.z, y.w); *(u32x2*)(H + (size_t)row * 1024 + c) = w; }
  }
}
__device__ __forceinline__ void rows_final(float* __restrict__ X, const float* __restrict__ g, int tid) {
  const int lane = tid & 63, wid = tid >> 6;
  for (int row = blockIdx.x * 8 + wid; row < L; row += gridDim.x * 8) {
    float* src = X + (size_t)row * 1024; f32x4 v[4]; float ss = 0.f;
#pragma unroll
    for (int i = 0; i < 4; ++i) { v[i] = *(const f32x4*)(src + (lane + 64 * i) * 4); ss += v[i].x * v[i].x + v[i].y * v[i].y + v[i].z * v[i].z + v[i].w * v[i].w; }
    ss = wave_sum(ss); const float rinv = rsqrtf(ss * (1.f / 1024.f) + EPS);
#pragma unroll
    for (int i = 0; i < 4; ++i) { const int c = (lane + 64 * i) * 4; const f32x4 gg = *(const f32x4*)(g + c); *(f32x4*)(src + c) = v[i] * rinv * gg; }
  }
}
__device__ __forceinline__ void fold_item(const Args& a, int item, float* lds, int tid) {
  float* A = lds; float* Bm = lds + 64 * 257; const float* T = (const float*)(a.ws + WS_T); bf16_t* W = (bf16_t*)(a.ws + WS_WIN1);
  {
    const int kt = item >> 3, nt = item & 7, part = nt >> 2, n0 = (nt & 3) * 64, k0 = kt * 64;
    for (int idx = tid; idx < 64 * 256; idx += 512) { const int k = idx >> 8, i = idx & 255; A[k * 257 + i] = a.in[13][(size_t)(k0 + k) * 3584 + 3072 + i]; }
    for (int idx = tid; idx < 256 * 64; idx += 512) { const int i = idx >> 6, n = idx & 63; Bm[i * 64 + n] = T[(part * 256 + i) * 256 + n0 + n]; }
    __syncthreads();
    const int n = tid & 63, r0 = tid >> 6; float s[8];
#pragma unroll
    for (int q = 0; q < 8; ++q) s[q] = 0.f;
    for (int i = 0; i < 256; ++i) { const float b = Bm[i * 64 + n];
#pragma unroll
      for (int q = 0; q < 8; ++q) s[q] += A[(r0 + 8 * q) * 257 + i] * b; }
#pragma unroll
    for (int q = 0; q < 8; ++q) W[(size_t)(3072 + part * 256 + n0 + n) * 1024 + k0 + r0 + 8 * q] = (bf16_t)f2bf(s[q]);
    __syncthreads();
  }
}

namespace pg8 {
#define PG8_LAS __attribute__((address_space(3)))
typedef unsigned short bf16_t;
typedef short bf16x8 __attribute__((ext_vector_type(8)));
typedef float f32x4 __attribute__((ext_vector_type(4)));
typedef unsigned u32x4 __attribute__((ext_vector_type(4)));
constexpr int BM = 256, BK = 64, HALF = 128, HTB = HALF * BK * 2  , STAGE_BYTES = 8 * HTB, NXCD = 8, WGM = 8;

__host__ __device__ __forceinline__ int lds_byte(int r, int c) { const int st = (r >> 4) * 2 + (c >> 5), rr = r & 15, cc = c & 31, ob = rr * 64 + cc * 2; return st * 1024 + (ob ^ (((ob >> 9) & 1) << 5)); }
__host__ __device__ __forceinline__ void stage_rc(int b, int& R, int& C) { const int st = b / 1024, sb = b % 1024, swz = sb ^ (((sb >> 9) & 1) << 5); R = (st >> 1) * 16 + swz / 64; C = (st & 1) * 32 + (swz % 64) / 2; }
__host__ __device__ __forceinline__ int perm32(int rho) { const int n = rho >> 4, i = rho & 15; return 8 * (i >> 2) + 4 * n + (i & 3); }

struct Unit { int pm, pn; };
struct Gemm { const bf16_t* A; const bf16_t* Bt; int M, N, K; };
__device__ __forceinline__ unsigned cvt_pk_bf16(float lo, float hi) { unsigned r; asm volatile("v_cvt_pk_bf16_f32 %0, %1, %2" : "=v"(r) : "v"(lo), "v"(hi)); return r; }
}

namespace pg8 {

struct StaticOrder {
    int nM, nN, nwg, G, c;
    __host__ __device__ void init(int M, int N, int G_, int c_) { nM = M / BM; nN = N / BM; nwg = nM * nN; G = G_; c = c_; }
    __host__ __device__ bool next(int i, Unit& u) const {
        const long L = (long)i * G + c; if (L >= nwg) return false;
        int wgid = (int)L; { const int q = nwg / NXCD, r = nwg % NXCD, xcd = wgid % NXCD, off = wgid / NXCD; wgid = (xcd < r ? xcd * (q + 1) : r * (q + 1) + (xcd - r) * q) + off; }
        const int nig = WGM * nN, gid = wgid / nig, fm = gid * WGM, gsz = (nM - fm) < WGM ? (nM - fm) : WGM;
        u.pm = fm + ((wgid % nig) % gsz); u.pn = (wgid % nig) / gsz; return true;
    }
    __device__ __forceinline__ void a_ready(const Unit&) const {}
    __device__ __forceinline__ void done(const Unit&) const {}
};

struct SchedIn0 {
  int G, c;
  __device__ __forceinline__ bool next(int i, Unit& u) const { const int l = i * G + c; if (l >= 642) return false;
    if (l < 2) { u.pm = 0; u.pn = 5 + l; } else { const int v = l - 2; u.pm = 1 + v / 10; u.pn = v % 10; } return true; }
  __device__ __forceinline__ void a_ready(const Unit&) const {}
  __device__ __forceinline__ void done(const Unit&) const {}
};
struct SchedRow {
  int nN, total, G, c;
  __device__ __forceinline__ bool next(int i, Unit& u) const { const int l = i * G + c; if (l >= total) return false; u.pm = l / nN; u.pn = l % nN; return true; }
  __device__ __forceinline__ void a_ready(const Unit&) const {}
  __device__ __forceinline__ void done(const Unit&) const {}
};
struct SchedCol {
  int nM, total, G, c;
  __device__ __forceinline__ bool next(int i, Unit& u) const { const int l = i * G + c; if (l >= total) return false; u.pn = l / nM; u.pm = l % nM; return true; }
  __device__ __forceinline__ void a_ready(const Unit&) const {}
  __device__ __forceinline__ void done(const Unit&) const {}
};
struct EpiIn0 {
  static constexpr bool PERM = true, AFTER_DRAIN = false;
  float* AV; bf16_t *AG, *Q, *K, *V, *BG; const float *qg, *kg; const float2* rope; float* xs;
  __device__ __forceinline__ void operator()(const f32x4 (&acc)[2][2][4][2], const Unit& u, int wr, int wc, int fr, int fq) const {
    const int pn = u.pn, rl0 = wr * 64 + fr, row0 = u.pm * 256 + rl0, cl = wc * 32 + 8 * fq;
    if (u.pm == 0 && pn != 5 && pn != 6) return;
    if (pn == 0) {
#pragma unroll
      for (int ai = 0; ai < 2; ++ai)
#pragma unroll
        for (int m = 0; m < 4; ++m) { float* p = AV + (size_t)(row0 + ai * 128 + m * 16 - 256) * 256 + cl;
#pragma unroll
          for (int bj = 0; bj < 2; ++bj) { *(f32x4*)(p + bj * 128) = acc[ai][bj][m][0]; *(f32x4*)(p + bj * 128 + 4) = acc[ai][bj][m][1]; } }
    } else if (pn == 1 || pn >= 6) {
      bf16_t* dst; int ld, roff = 256, coff = 0; bool act = true;
      size_t hstride = 128;
      if (pn == 1) { dst = AG; ld = 256; } else if (pn == 6) { dst = V; ld = 128; roff = 0; act = false; hstride = (size_t)LK * 128; } else { dst = BG; ld = 768; coff = (pn - 7) * 256; }
#pragma unroll
      for (int ai = 0; ai < 2; ++ai)
#pragma unroll
        for (int m = 0; m < 4; ++m) { bf16_t* p = dst + (size_t)(row0 + ai * 128 + m * 16 - roff) * ld + coff + cl;
#pragma unroll
          for (int bj = 0; bj < 2; ++bj) { f32x4 v0 = acc[ai][bj][m][0], v1 = acc[ai][bj][m][1];
            if (act) { v0.x = siluf(v0.x); v0.y = siluf(v0.y); v0.z = siluf(v0.z); v0.w = siluf(v0.w); v1.x = siluf(v1.x); v1.y = siluf(v1.y); v1.z = siluf(v1.z); v1.w = siluf(v1.w); }
            u32x4 w; w.x = pk2(v0.x, v0.y); w.y = pk2(v0.z, v0.w); w.z = pk2(v1.x, v1.y); w.w = pk2(v1.z, v1.w);
            *(u32x4*)(p + bj * hstride) = w; } }
    } else {
#pragma unroll
      for (int ai = 0; ai < 2; ++ai)
#pragma unroll
        for (int m = 0; m < 4; ++m)
#pragma unroll
          for (int bj = 0; bj < 2; ++bj) { const f32x4 x0 = acc[ai][bj][m][0], x1 = acc[ai][bj][m][1];
            float s = x0.x * x0.x + x0.y * x0.y + x0.z * x0.z + x0.w * x0.w + x1.x * x1.x + x1.y * x1.y + x1.z * x1.z + x1.w * x1.w;
            s += __shfl_xor(s, 16); s += __shfl_xor(s, 32);
            if (fq == 0) xs[(bj * 256 + ai * 128 + m * 16 + rl0) * 4 + wc] = s; }
      __syncthreads();
      const bool isk = (pn == 5); const float* gw = isk ? kg : qg;
      const int axis = wc >> 1, f0 = 4 * ((4 * wc + fq) & 7);
      const f32x4 g0 = *(const f32x4*)(gw + axis * 64 + f0), g1 = *(const f32x4*)(gw + axis * 64 + 32 + f0);
      bf16_t* dst = isk ? K : Q; const int ld = isk ? 128 : 768, coff = isk ? 0 : (pn - 2) * 256, roff = isk ? 0 : 256; const size_t hstride = isk ? (size_t)LK * 128 : 128;
#pragma unroll
      for (int ai = 0; ai < 2; ++ai)
#pragma unroll
        for (int m = 0; m < 4; ++m) { const int row = row0 + ai * 128 + m * 16, tok = row - 256;
          f32x4 cs0 = {1.f, 0.f, 1.f, 0.f}, cs1 = {1.f, 0.f, 1.f, 0.f};
          if (tok >= 0) { const int pos = axis ? (tok & 63) : (tok >> 6); const float* rp = (const float*)(rope + pos * 32 + f0); cs0 = *(const f32x4*)rp; cs1 = *(const f32x4*)(rp + 4); }
#pragma unroll
          for (int bj = 0; bj < 2; ++bj) { const f32x4 t = *(const f32x4*)(xs + (bj * 256 + ai * 128 + m * 16 + rl0) * 4);
            const float rinv = rsqrtf((t.x + t.y + t.z + t.w) * (1.f / 128.f) + EPS);
            const f32x4 av = acc[ai][bj][m][0] * rinv * g0, bv = acc[ai][bj][m][1] * rinv * g1;
            const float o00 = av.x * cs0.x - bv.x * cs0.y, o10 = bv.x * cs0.x + av.x * cs0.y;
            const float o01 = av.y * cs0.z - bv.y * cs0.w, o11 = bv.y * cs0.z + av.y * cs0.w;
            const float o02 = av.z * cs1.x - bv.z * cs1.y, o12 = bv.z * cs1.x + av.z * cs1.y;
            const float o03 = av.w * cs1.z - bv.w * cs1.w, o13 = bv.w * cs1.z + av.w * cs1.w;
            u32x4 w; w.x = pk2(o00, o01); w.y = pk2(o02, o03); w.z = pk2(o10, o11); w.w = pk2(o12, o13);
            *(u32x4*)(dst + (size_t)(row - roff) * ld + coff + bj * hstride + cl) = w; } }
    }
  }
};
struct EpiRes {
  static constexpr bool PERM = true, AFTER_DRAIN = false;
  const float* base; float* out; const float* gate;
  __device__ __forceinline__ void operator()(const f32x4 (&acc)[2][2][4][2], const Unit& u, int wr, int wc, int fr, int fq) const {
    const int row0 = u.pm * 256 + wr * 64 + fr, col0 = u.pn * 256 + wc * 32 + 8 * fq;
#pragma unroll
    for (int bj = 0; bj < 2; ++bj) { const f32x4 g0 = *(const f32x4*)(gate + col0 + bj * 128), g1 = *(const f32x4*)(gate + col0 + bj * 128 + 4);
#pragma unroll
      for (int ai = 0; ai < 2; ++ai)
#pragma unroll
        for (int m = 0; m < 4; ++m) { const size_t o = (size_t)(row0 + ai * 128 + m * 16) * 1024 + col0 + bj * 128;
          const f32x4 b0 = *(const f32x4*)(base + o), b1 = *(const f32x4*)(base + o + 4);
          *(f32x4*)(out + o) = b0 + g0 * acc[ai][bj][m][0]; *(f32x4*)(out + o + 4) = b1 + g1 * acc[ai][bj][m][1]; } }
  }
};
template <int MODE> struct EpiResNorm {
  static constexpr bool PERM = true, AFTER_DRAIN = false; static constexpr int mode = MODE;
  const float* base; float* out; const float* gate; const float* g; const float* mod; bf16_t* H; float* psq; unsigned* cnt; float* xs;
  __device__ __forceinline__ void operator()(const f32x4 (&acc)[2][2][4][2], const Unit& u, int wr, int wc, int fr, int fq) const {
    const int rl0 = wr * 64 + fr, row0 = u.pm * 256 + rl0, col0 = u.pn * 256 + wc * 32 + 8 * fq, tid = (wr * 4 + wc) * 64 + fq * 16 + fr;
#pragma unroll
    for (int ai = 0; ai < 2; ++ai)
#pragma unroll
      for (int m = 0; m < 4; ++m) { float s = 0.f;
#pragma unroll
        for (int bj = 0; bj < 2; ++bj) { int cc = col0 + bj * 128; asm volatile("" : "+v"(cc)); const size_t o = (size_t)(row0 + ai * 128 + m * 16) * 1024 + cc;
          const f32x4 x0 = *(const f32x4*)(base + o) + *(const f32x4*)(gate + cc) * acc[ai][bj][m][0], x1 = *(const f32x4*)(base + o + 4) + *(const f32x4*)(gate + cc + 4) * acc[ai][bj][m][1];
          if (mode == 2) { *(f32x4*)(out + o) = x0; *(f32x4*)(out + o + 4) = x1; }
          s += x0.x * x0.x + x0.y * x0.y + x0.z * x0.z + x0.w * x0.w + x1.x * x1.x + x1.y * x1.y + x1.z * x1.z + x1.w * x1.w; }
        s += __shfl_xor(s, 16); s += __shfl_xor(s, 32); if (fq == 0) xs[(ai * 128 + m * 16 + rl0) * 4 + wc] = s;
        __builtin_amdgcn_sched_barrier(0); }
    __syncthreads();
    if (tid < 256) { const f32x4 t = *(const f32x4*)(xs + tid * 4); psq[(size_t)(u.pm * 256 + tid) * 4 + u.pn] = (t.x + t.y) + (t.z + t.w); }
    __threadfence(); __syncthreads();
    if (tid == 0) { __hip_atomic_fetch_add(cnt + u.pm, 1u, __ATOMIC_RELAXED, __HIP_MEMORY_SCOPE_AGENT);
      for (int it = 0; it < (1 << 22) && __hip_atomic_load(cnt + u.pm, __ATOMIC_RELAXED, __HIP_MEMORY_SCOPE_AGENT) < 4u; ++it) __builtin_amdgcn_s_sleep(1);
      __threadfence(); }
    __syncthreads();
#pragma unroll
    for (int ai = 0; ai < 2; ++ai)
#pragma unroll
      for (int m = 0; m < 4; ++m) { const float* pq = psq + (size_t)(row0 + ai * 128 + m * 16) * 4;
        const float t = (__builtin_nontemporal_load(pq) + __builtin_nontemporal_load(pq + 1)) + (__builtin_nontemporal_load(pq + 2) + __builtin_nontemporal_load(pq + 3));
        const float ri = rsqrtf(t * (1.f / 1024.f) + EPS);
#pragma unroll
        for (int bj = 0; bj < 2; ++bj) { int cc = col0 + bj * 128; asm volatile("" : "+v"(cc)); const size_t o = (size_t)(row0 + ai * 128 + m * 16) * 1024 + cc;
          const f32x4 x0 = *(const f32x4*)(base + o) + *(const f32x4*)(gate + cc) * acc[ai][bj][m][0], x1 = *(const f32x4*)(base + o + 4) + *(const f32x4*)(gate + cc + 4) * acc[ai][bj][m][1];
          f32x4 y0 = x0 * ri * *(const f32x4*)(g + cc), y1 = x1 * ri * *(const f32x4*)(g + cc + 4);
          if (mode == 2) { y0 = y0 * (*(const f32x4*)(mod + 1024 + cc) + 1.f) + *(const f32x4*)(mod + cc); y1 = y1 * (*(const f32x4*)(mod + 1024 + cc + 4) + 1.f) + *(const f32x4*)(mod + cc + 4);
            u32x4 w; w.x = pk2(y0.x, y0.y); w.y = pk2(y0.z, y0.w); w.z = pk2(y1.x, y1.y); w.w = pk2(y1.z, y1.w); *(u32x4*)(H + o) = w; }
          else { *(f32x4*)(out + o) = y0; *(f32x4*)(out + o + 4) = y1; } }
        __builtin_amdgcn_sched_barrier(0); }
  }
};
struct EpiT {
  static constexpr bool PERM = true, AFTER_DRAIN = false;
  bf16_t* O; int gated;
  __device__ __forceinline__ void operator()(const f32x4 (&acc)[2][2][4][2], const Unit& u, int wr, int wc, int fr, int fq) const {
    const int row0 = u.pm * 256 + wr * 64 + fr, col0 = u.pn * 256 + wc * 32 + 8 * fq; const bool act = gated && ((u.pm >= 9 && u.pm <= 11) || u.pm == 14);
#pragma unroll
    for (int ai = 0; ai < 2; ++ai)
#pragma unroll
      for (int m = 0; m < 4; ++m) { bf16_t* p = O + (size_t)(row0 + ai * 128 + m * 16) * L + col0;
#pragma unroll
        for (int bj = 0; bj < 2; ++bj) { f32x4 v0 = acc[ai][bj][m][0], v1 = acc[ai][bj][m][1];
          if (act) { v0.x = siluf(v0.x); v0.y = siluf(v0.y); v0.z = siluf(v0.z); v0.w = siluf(v0.w); v1.x = siluf(v1.x); v1.y = siluf(v1.y); v1.z = siluf(v1.z); v1.w = siluf(v1.w); }
          u32x4 w; w.x = pk2(v0.x, v0.y); w.y = pk2(v0.z, v0.w); w.z = pk2(v1.x, v1.y); w.w = pk2(v1.z, v1.w);
          *(u32x4*)(p + bj * 128) = w; } }
  }
};
}
namespace pg8 {
template <class Epi, class Sched, bool ALIGN_EPI = false, bool SP2 = false>
__device__ __forceinline__ void gemm_phase(PG8_LAS unsigned char* lds, const Gemm g, const Sched& S, const Epi& E, int tid_in) {
    const int tid = tid_in, wid = __builtin_amdgcn_readfirstlane(tid >> 6), lane = tid & 63, wr = wid >> 2, wc = wid & 3, fr = lane & 15, fq = lane >> 4;
    const int K = g.K, nt = K / BK;
    unsigned voffA[2], voffB[2];
#pragma unroll
    for (int i = 0; i < 2; ++i) { int R, C; stage_rc(tid * 16 + i * 8192, R, C); const int Rb = Epi::PERM ? ((R & ~31) + perm32(R & 31)) : R;
        voffA[i] = (unsigned)(R * K + C) * 2u; voffB[i] = (unsigned)(Rb * K + C) * 2u; }
    const size_t kstep = (size_t)(BK * 2);
    const size_t hstep = (size_t)HALF * K * 2;
    const size_t tstep = 2 * hstep;
    const unsigned ldsw = (unsigned)wid * 1024u;
    const int aoff = lds_byte(wr * 64 + fr, fq * 8), boff = lds_byte(wc * 32 + fr, fq * 8);
#define PG8_SA(b, h) (((b) * 2 + (h)) * HTB)
#define PG8_SB(b, h) ((4 + (b) * 2 + (h)) * HTB)
#define PG8_STAGE(bufoff, gbase, voff) do { _Pragma("unroll") for (int _i = 0; _i < 2; ++_i) \
        __builtin_amdgcn_global_load_lds((const unsigned*)((const char*)(gbase) + (voff)[_i]), (PG8_LAS unsigned*)(lds + (bufoff) + ldsw + _i * 8192), 16, 0, 0); } while (0)
#define PG8_LDA(dst, b, h) do { _Pragma("unroll") for (int m = 0; m < 4; ++m) _Pragma("unroll") for (int k = 0; k < 2; ++k) dst[m][k] = *(const PG8_LAS bf16x8*)(lds + PG8_SA(b, h) + aoff + m * 2048 + k * 1024); } while (0)
#define PG8_LDB(dst, b, h) do { _Pragma("unroll") for (int n = 0; n < 2; ++n) _Pragma("unroll") for (int k = 0; k < 2; ++k) dst[n][k] = *(const PG8_LAS bf16x8*)(lds + PG8_SB(b, h) + boff + n * 2048 + k * 1024); } while (0)
#define PG8_MMA(ai, bj, At, Bt) do { __builtin_amdgcn_s_setprio(1); _Pragma("unroll") for (int m = 0; m < 4; ++m) _Pragma("unroll") for (int n = 0; n < 2; ++n) _Pragma("unroll") for (int k = 0; k < 2; ++k) \
        acc[ai][bj][m][n] = __builtin_amdgcn_mfma_f32_16x16x32_bf16(Bt[n][k], At[m][k], acc[ai][bj][m][n], 0, 0, 0); __builtin_amdgcn_s_setprio(0); } while (0)
#define PG8_WAIT_V(n) asm volatile("s_waitcnt vmcnt(" #n ")" ::: "memory")
#define PG8_WAIT_L(n) asm volatile("s_waitcnt lgkmcnt(" #n ")" ::: "memory")
#define PG8_BAR __builtin_amdgcn_s_barrier()
#define PG8_SCHED __builtin_amdgcn_sched_barrier(0)
    Unit cur, nxt; int ui = 0;
    if (!S.next(0, cur)) return;
    f32x4 acc[2][2][4][2];
#pragma unroll
    for (int a = 0; a < 2; ++a)
#pragma unroll
        for (int b = 0; b < 2; ++b)
#pragma unroll
            for (int m = 0; m < 4; ++m)
#pragma unroll
                for (int n = 0; n < 2; ++n) acc[a][b][m][n] = (f32x4){0.f, 0.f, 0.f, 0.f};
    bf16x8 At[4][2], B0[2][2], B1[2][2];
    const char* cA = (const char*)g.A + (size_t)cur.pm * tstep; const char* cB = (const char*)g.Bt + (size_t)cur.pn * tstep;
    S.a_ready(cur);
    if constexpr (SP2) {
        PG8_STAGE(PG8_SB(0, 0), cB, voffB); PG8_STAGE(PG8_SB(0, 1), cB + hstep, voffB); PG8_STAGE(PG8_SA(0, 0), cA, voffA); PG8_STAGE(PG8_SA(0, 1), cA + hstep, voffA);
        if (wr == 1) PG8_BAR;
        PG8_WAIT_V(2); PG8_BAR;
        PG8_STAGE(PG8_SB(1, 0), cB + kstep, voffB); PG8_STAGE(PG8_SA(1, 0), cA + kstep, voffA); PG8_STAGE(PG8_SB(1, 1), cB + hstep + kstep, voffB);
        PG8_WAIT_V(6); PG8_BAR;
    } else {
        PG8_STAGE(PG8_SB(0, 0), cB, voffB); PG8_STAGE(PG8_SA(0, 0), cA, voffA); PG8_STAGE(PG8_SB(0, 1), cB + hstep, voffB); PG8_STAGE(PG8_SA(0, 1), cA + hstep, voffA);
        if (wr == 1) PG8_BAR;
        PG8_WAIT_V(4); PG8_BAR;
        PG8_STAGE(PG8_SB(1, 0), cB + kstep, voffB); PG8_STAGE(PG8_SA(1, 0), cA + kstep, voffA); PG8_STAGE(PG8_SB(1, 1), cB + hstep + kstep, voffB);
        PG8_WAIT_V(6); PG8_BAR;
    }
    for (;;) {
        const bool has_next = S.next(ui + 1, nxt);
        const char* nA = has_next ? (const char*)g.A + (size_t)nxt.pm * tstep : cA; const char* nB = has_next ? (const char*)g.Bt + (size_t)nxt.pn * tstep : cB;
        for (int t = 0; t < nt; t += 2) {
            const bool last = (t == nt - 2);
            const char* a1 = cA + (size_t)(t + 1) * kstep;
            const char* a2 = last ? nA : cA + (size_t)(t + 2) * kstep; const char* b2 = last ? nB : cB + (size_t)(t + 2) * kstep;
            const char* a3 = a2 + kstep; const char* b3 = b2 + kstep;
            if (last && has_next) S.a_ready(nxt);
            if constexpr (SP2) {
            PG8_LDB(B0, 0, 0); PG8_LDB(B1, 0, 1); PG8_SCHED; PG8_LDA(At, 0, 0); PG8_STAGE(PG8_SA(1, 1), a1 + hstep, voffA);
            PG8_WAIT_V(8); PG8_WAIT_L(0); PG8_BAR; PG8_MMA(0, 0, At, B0); PG8_MMA(0, 1, At, B1); PG8_BAR; PG8_SCHED;
            PG8_LDA(At, 0, 1); PG8_STAGE(PG8_SB(0, 0), b2, voffB); PG8_STAGE(PG8_SB(0, 1), b2 + hstep, voffB); PG8_STAGE(PG8_SA(0, 0), a2, voffA);
            PG8_WAIT_V(8); PG8_WAIT_L(0); PG8_BAR; PG8_MMA(1, 0, At, B0); PG8_MMA(1, 1, At, B1); PG8_BAR; PG8_SCHED;
            PG8_LDB(B0, 1, 0); PG8_LDB(B1, 1, 1); PG8_SCHED; PG8_LDA(At, 1, 0); PG8_STAGE(PG8_SA(0, 1), a2 + hstep, voffA);
            PG8_WAIT_V(8); PG8_WAIT_L(0); PG8_BAR; PG8_MMA(0, 0, At, B0); PG8_MMA(0, 1, At, B1); PG8_BAR; PG8_SCHED;
            PG8_LDA(At, 1, 1); PG8_STAGE(PG8_SB(1, 0), b3, voffB); PG8_STAGE(PG8_SB(1, 1), b3 + hstep, voffB); PG8_STAGE(PG8_SA(1, 0), a3, voffA);
            PG8_WAIT_V(8); PG8_WAIT_L(0); PG8_BAR; PG8_MMA(1, 0, At, B0); PG8_MMA(1, 1, At, B1); PG8_BAR; PG8_SCHED;
            } else {
            PG8_LDB(B0, 0, 0); PG8_SCHED; PG8_LDA(At, 0, 0); PG8_STAGE(PG8_SA(1, 1), a1 + hstep, voffA);
            PG8_WAIT_L(8); PG8_BAR; PG8_WAIT_L(0); PG8_MMA(0, 0, At, B0); PG8_BAR; PG8_SCHED;
            PG8_LDB(B1, 0, 1); PG8_STAGE(PG8_SB(0, 0), b2, voffB);
            PG8_BAR; PG8_WAIT_L(0); PG8_MMA(0, 1, At, B1); PG8_BAR;
            PG8_LDA(At, 0, 1); PG8_STAGE(PG8_SA(0, 0), a2, voffA);
            PG8_BAR; PG8_WAIT_L(0); PG8_MMA(1, 0, At, B0); PG8_BAR; PG8_SCHED;
            PG8_STAGE(PG8_SB(0, 1), b2 + hstep, voffB);
            PG8_WAIT_V(6); PG8_BAR; PG8_MMA(1, 1, At, B1); PG8_BAR;
            PG8_LDB(B0, 1, 0); PG8_SCHED; PG8_LDA(At, 1, 0); PG8_STAGE(PG8_SA(0, 1), a2 + hstep, voffA);
            PG8_WAIT_L(8); PG8_BAR; PG8_WAIT_L(0); PG8_MMA(0, 0, At, B0); PG8_BAR; PG8_SCHED;
            PG8_LDB(B1, 1, 1); PG8_STAGE(PG8_SB(1, 0), b3, voffB);
            PG8_BAR; PG8_WAIT_L(0); PG8_MMA(0, 1, At, B1); PG8_BAR;
            PG8_LDA(At, 1, 1); PG8_STAGE(PG8_SA(1, 0), a3, voffA);
            PG8_BAR; PG8_WAIT_L(0); PG8_MMA(1, 0, At, B0); PG8_BAR; PG8_SCHED;
            PG8_STAGE(PG8_SB(1, 1), b3 + hstep, voffB);
            PG8_WAIT_V(6); PG8_BAR; PG8_MMA(1, 1, At, B1); PG8_BAR;
            }
        }
        if constexpr (ALIGN_EPI) { if (wr == 0) PG8_BAR; }
        if constexpr (!Epi::AFTER_DRAIN) { E(acc, cur, wr, wc, fr, fq); S.done(cur); }
        if (!has_next) break;
#pragma unroll
        for (int a = 0; a < 2; ++a)
#pragma unroll
            for (int b = 0; b < 2; ++b)
#pragma unroll
                for (int m = 0; m < 4; ++m)
#pragma unroll
                    for (int n = 0; n < 2; ++n) acc[a][b][m][n] = (f32x4){0.f, 0.f, 0.f, 0.f};
        cur = nxt; cA = nA; cB = nB; ++ui;
        if constexpr (ALIGN_EPI) { if (wr == 1) PG8_BAR; }
    }
    PG8_WAIT_V(0);
    if constexpr (!ALIGN_EPI) { if (wr == 0) PG8_BAR; }
    PG8_BAR;
    if constexpr (Epi::AFTER_DRAIN) { E.fused(acc, cur, wr, wc, fr, fq, lds, wid, lane); S.done(cur); }
#undef PG8_SA
#undef PG8_SB
#undef PG8_STAGE
#undef PG8_LDA
#undef PG8_LDB
#undef PG8_MMA
#undef PG8_WAIT_V
#undef PG8_WAIT_L
#undef PG8_BAR
#undef PG8_SCHED
}
}

namespace attn {
using bf16 = __hip_bfloat16;
constexpr int   D = 128, NW = 8, QBLK = 32, KVBLK = 64;
constexpr float SCALE = 0.088388347648318440f;
constexpr float THR = 8.f;
constexpr int SDEPTH = 2;
constexpr int LDQ = 768, LDK = 128, LDO = 1024, LDG = 768;
constexpr size_t SHM_V = KVBLK * D * 2, SHM_K = KVBLK * D * 2, SHM_ATTN = 2 * SHM_V + 2 * SHM_K + NW * 64 * 4;
using bf16x8 = __attribute__((ext_vector_type(8))) short;
using s16x4  = __attribute__((ext_vector_type(4))) short;
using f32x16 = __attribute__((ext_vector_type(16))) float;
using f32x8  = __attribute__((ext_vector_type(8))) float;
using u32x4  = __attribute__((ext_vector_type(4))) unsigned;
#define KSWZ(row, colB) ((row) * 256 + ((colB) ^ (((row) & 7) << 4)))
#define SBAR() __builtin_amdgcn_sched_barrier(0)
__device__ __forceinline__ int crow(int r, int hi) { return (r & 3) + 8 * (r >> 2) + 4 * hi; }
__device__ __forceinline__ unsigned cvtpk(float lo, float hi) {
  unsigned r; asm volatile("v_cvt_pk_bf16_f32 %0, %1, %2" : "=v"(r) : "v"(lo), "v"(hi)); return r;
}
template <typename TIn> struct Stage;
template <> struct Stage<bf16>  { using T = bf16x8;
  __device__ static __forceinline__ T ld8(const bf16* p) { return *reinterpret_cast<const bf16x8*>(p); }
  __device__ static __forceinline__ bf16x8 tobf(T x) { return x; } };
template <> struct Stage<float> { using T = f32x8;
  __device__ static __forceinline__ T ld8(const float* p) { return *reinterpret_cast<const f32x8*>(p); }
  __device__ static __forceinline__ bf16x8 tobf(T x) {
    u32x4 w = {cvtpk(x[0], x[1]), cvtpk(x[2], x[3]), cvtpk(x[4], x[5]), cvtpk(x[6], x[7])}; return *reinterpret_cast<bf16x8*>(&w); } };

__device__ __forceinline__ void partialSM(f32x16& p0, f32x16& p1, float& m_reg, float& mn, float& alpha) {
  constexpr float C = SCALE * 1.4426950408889634f;
  float pmax = p0[0]; for (int r = 1; r < 16; ++r) pmax = fmaxf(pmax, p0[r]); for (int r = 0; r < 16; ++r) pmax = fmaxf(pmax, p1[r]);
  { auto rr = __builtin_amdgcn_permlane32_swap(__float_as_uint(pmax), __float_as_uint(pmax), false, false);
    pmax = fmaxf(__uint_as_float(rr[0]), __uint_as_float(rr[1])); }
  if (__builtin_expect(__all(pmax - m_reg <= THR / SCALE), 1)) { mn = m_reg; alpha = 1.f; }
  else { mn = fmaxf(m_reg, pmax); alpha = __builtin_amdgcn_exp2f((m_reg - mn) * C); m_reg = mn; }
  float mnC = -mn * C;
  for (int r = 0; r < 16; ++r) p0[r] = fmaf(p0[r], C, mnC); for (int r = 0; r < 16; ++r) p1[r] = fmaf(p1[r], C, mnC);
  for (int r = 0; r < 16; ++r) p0[r] = __builtin_amdgcn_exp2f(p0[r]);
}
__device__ __forceinline__ void finishSM(f32x16& p0, f32x16& p1, float alpha, float& l_reg, bf16x8& pa0, bf16x8& pa1, bf16x8& pa2, bf16x8& pa3) {
  for (int r = 0; r < 16; ++r) p1[r] = __builtin_amdgcn_exp2f(p1[r]);
  float ps = 0; for (int r = 0; r < 16; ++r) ps += p0[r]; for (int r = 0; r < 16; ++r) ps += p1[r];
  { auto rr = __builtin_amdgcn_permlane32_swap(__float_as_uint(ps), __float_as_uint(ps), false, false);
    ps = __uint_as_float(rr[0]) + __uint_as_float(rr[1]); }
  l_reg = l_reg * alpha + ps;
#define PK4(P, BASE, OUT) do { unsigned a0 = cvtpk(P[BASE + 0], P[BASE + 1]), a1 = cvtpk(P[BASE + 2], P[BASE + 3]);   \
    unsigned b0 = cvtpk(P[BASE + 4], P[BASE + 5]), b1 = cvtpk(P[BASE + 6], P[BASE + 7]);                              \
    auto r0 = __builtin_amdgcn_permlane32_swap(a0, b0, false, false); auto r1 = __builtin_amdgcn_permlane32_swap(a1, b1, false, false); \
    u32x4 w = {r0[0], r1[0], r0[1], r1[1]}; OUT = *reinterpret_cast<bf16x8*>(&w); } while (0)
  PK4(p0, 0, pa0); PK4(p0, 8, pa1); PK4(p1, 0, pa2); PK4(p1, 8, pa3);
#undef PK4
}
__device__ __forceinline__ void qkt(f32x16& p0, f32x16& p1, const bf16* Ks, const bf16x8* qr, int r32, int hi) {
  p0 = f32x16{}; p1 = f32x16{};
  for (int d0 = 0; d0 < 8; ++d0) { int cb = (d0 * 16 + hi * 8) * 2;
    bf16x8 b0 = *reinterpret_cast<const bf16x8*>((const char*)Ks + KSWZ(r32, cb));
    bf16x8 b1 = *reinterpret_cast<const bf16x8*>((const char*)Ks + KSWZ(32 + r32, cb));
    p0 = __builtin_amdgcn_mfma_f32_32x32x16_bf16(b0, qr[d0], p0, 0, 0, 0);
    p1 = __builtin_amdgcn_mfma_f32_32x32x16_bf16(b1, qr[d0], p1, 0, 0, 0); }
}
__device__ __forceinline__ int v_st(int k, int c) { const int kk = (k & ~0xC) | ((k & 4) << 1) | ((k & 8) >> 1); return ((kk >> 3) * 4 + (c >> 5)) * 512 + ((kk & 7) * 32 + (c & 31)) * 2; }
__device__ __forceinline__ int v_rd_base(int lane) { return ((lane & 3) << 3) | (((lane >> 2) & 3) << 6) | (((lane >> 4) & 1) << 5) | (((lane >> 5) & 1) << 8); }
constexpr int v_rd_off(int d0, int ks, int half) { return d0 * 512 + ks * 4096 + half * 2048; }
template <int OFF> __device__ __forceinline__ s16x4 tr_read(int vb) {
  s16x4 r; asm volatile("ds_read_b64_tr_b16 %0, %1 offset:%2" : "=&v"(r) : "v"(vb), "i"(OFF) : "memory"); return r;
}
template <int D0> __device__ __forceinline__ void pv_one(f32x16& od, int vb, bf16x8 pa0, bf16x8 pa1, bf16x8 pa2, bf16x8 pa3) {
  const s16x4 l0 = tr_read<v_rd_off(D0, 0, 0)>(vb), h0 = tr_read<v_rd_off(D0, 0, 1)>(vb), l1 = tr_read<v_rd_off(D0, 1, 0)>(vb), h1 = tr_read<v_rd_off(D0, 1, 1)>(vb);
  const s16x4 l2 = tr_read<v_rd_off(D0, 2, 0)>(vb), h2 = tr_read<v_rd_off(D0, 2, 1)>(vb), l3 = tr_read<v_rd_off(D0, 3, 0)>(vb), h3 = tr_read<v_rd_off(D0, 3, 1)>(vb);
  asm volatile("s_waitcnt lgkmcnt(0)" ::: "memory"); SBAR();
#define PK(L, H) (bf16x8){L[0], L[1], L[2], L[3], H[0], H[1], H[2], H[3]}
  od = __builtin_amdgcn_mfma_f32_32x32x16_bf16(pa0, PK(l0, h0), od, 0, 0, 0);
  od = __builtin_amdgcn_mfma_f32_32x32x16_bf16(pa1, PK(l1, h1), od, 0, 0, 0);
  od = __builtin_amdgcn_mfma_f32_32x32x16_bf16(pa2, PK(l2, h2), od, 0, 0, 0);
  od = __builtin_amdgcn_mfma_f32_32x32x16_bf16(pa3, PK(l3, h3), od, 0, 0, 0);
#undef PK
}
__device__ __forceinline__ void pv_d0(f32x16* o, int vb, bf16x8 pa0, bf16x8 pa1, bf16x8 pa2, bf16x8 pa3) {
  pv_one<0>(o[0], vb, pa0, pa1, pa2, pa3); pv_one<1>(o[1], vb, pa0, pa1, pa2, pa3); pv_one<2>(o[2], vb, pa0, pa1, pa2, pa3); pv_one<3>(o[3], vb, pa0, pa1, pa2, pa3);
}

template <bool PARTIAL>
__device__ __forceinline__ void attn_dense_body(const bf16* __restrict__ Qb, const bf16* __restrict__ Kh, const bf16* __restrict__ Vh,
                                                const bf16_t* __restrict__ Gb, bf16_t* __restrict__ Ob, int seq, char* lds,
                                                float* Pself, const float* Pother, unsigned* cnt, int tid_) {
  using TQ = bf16;
  using St = Stage<bf16>; using SQ = Stage<TQ>;
  asm volatile("" : "+v"(tid_));
  const int tid = tid_, wid = tid >> 6, lane = tid & 63, r32 = lane & 31, hi = lane >> 5;
  bf16* V_lds = (bf16*)lds; bf16* K_lds = (bf16*)(lds + 2 * SHM_V);
  float* ws = (float*)(lds + 2 * SHM_V + 2 * SHM_K) + wid * 64; float* li_l = ws; float* al_l = ws + 32;
  float m_reg = -1e30f, l_reg = 0; f32x16 o[4] = {}; bf16x8 qr[8];
  const TQ* Qw = Qb + (long)(wid * QBLK + r32) * LDQ + hi * 8;
#pragma unroll
  for (int d0 = 0; d0 < 8; ++d0) qr[d0] = SQ::tobf(SQ::ld8(Qw + d0 * 16));
  const int sr = tid >> 4, sc = (tid & 15) * 8, vst0 = v_st(sr, sc), vst1 = v_st(32 + sr, sc);
  const int vb0 = (int)(uintptr_t)V_lds + v_rd_base(lane);
  struct { typename St::T vs0, vs1, ks0, ks1; } sr_[SDEPTH];
  const unsigned so0 = (unsigned)(sr * LDK + sc), so1 = (unsigned)((32 + sr) * LDK + sc);
#define SLOAD(i, k0) do { const bf16* Vt_ = Vh + (long)(k0) * LDK; const bf16* Kt_ = Kh + (long)(k0) * LDK; \
    sr_[i].vs0 = St::ld8(Vt_ + so0); sr_[i].vs1 = St::ld8(Vt_ + so1); sr_[i].ks0 = St::ld8(Kt_ + so0); sr_[i].ks1 = St::ld8(Kt_ + so1); } while (0)
#define SWRITE(b, i) do { *(bf16x8*)((char*)V_lds + (b) * SHM_V + vst0) = St::tobf(sr_[i].vs0);          \
    *(bf16x8*)((char*)V_lds + (b) * SHM_V + vst1) = St::tobf(sr_[i].vs1); int kc = sc * 2;               \
    *(bf16x8*)((char*)K_lds + (b) * SHM_K + KSWZ(sr, kc)) = St::tobf(sr_[i].ks0);                       \
    *(bf16x8*)((char*)K_lds + (b) * SHM_K + KSWZ(32 + sr, kc)) = St::tobf(sr_[i].ks1); } while (0)
#define SWAIT() do { if constexpr (SDEPTH == 2) asm volatile("s_waitcnt vmcnt(4)" ::: "memory"); else asm volatile("s_waitcnt vmcnt(0)" ::: "memory"); } while (0)
#define RESC(a) do { if (__any((a) < 1.f)) { if (hi == 0) al_l[r32] = (a); asm volatile("s_waitcnt lgkmcnt(0)" ::: "memory"); \
    for (int d = 0; d < 4; ++d) for (int r = 0; r < 16; ++r) o[d][r] *= al_l[crow(r, hi)]; } } while (0)
  f32x16 pA0, pA1, pB0, pB1; float mnA, mnB, alA, alB; bf16x8 pa0, pa1, pa2, pa3; const int NT = seq / KVBLK;
  constexpr int SE = 0, SO = SDEPTH - 1;
  SLOAD(SE, 0); asm volatile("s_waitcnt vmcnt(0)" ::: "memory"); SWRITE(0, SE); __syncthreads();
  qkt(pA0, pA1, K_lds, qr, r32, hi); partialSM(pA0, pA1, m_reg, mnA, alA);
  SLOAD(SO, KVBLK); if constexpr (SDEPTH == 2) { if (2 < NT) SLOAD(SE, 2 * KVBLK); }
  SWAIT(); SWRITE(1, SO); __syncthreads();
  for (int j = 1; j + 1 < NT; j += 2) {
    SBAR(); qkt(pB0, pB1, (bf16*)((char*)K_lds + SHM_K), qr, r32, hi);
    finishSM(pA0, pA1, alA, l_reg, pa0, pa1, pa2, pa3); SBAR();
    SLOAD(SO, (j + SDEPTH) * KVBLK); SBAR();
    pv_d0(o, vb0, pa0, pa1, pa2, pa3); partialSM(pB0, pB1, m_reg, mnB, alB);
    __syncthreads(); SWAIT(); SWRITE(0, SE);
    RESC(alB); __syncthreads();
    SBAR(); qkt(pA0, pA1, K_lds, qr, r32, hi);
    finishSM(pB0, pB1, alB, l_reg, pa0, pa1, pa2, pa3); SBAR();
    if (SDEPTH == 1 || j + 3 < NT) SLOAD(SE, (j + 1 + SDEPTH) * KVBLK); SBAR();
    pv_d0(o, vb0 + (int)SHM_V, pa0, pa1, pa2, pa3); partialSM(pA0, pA1, m_reg, mnA, alA);
    __syncthreads(); SWAIT(); SWRITE(1, SO);
    RESC(alA); __syncthreads();
  }
  SBAR(); qkt(pB0, pB1, (bf16*)((char*)K_lds + SHM_K), qr, r32, hi);
  finishSM(pA0, pA1, alA, l_reg, pa0, pa1, pa2, pa3); SBAR();
  pv_d0(o, vb0, pa0, pa1, pa2, pa3); partialSM(pB0, pB1, m_reg, mnB, alB);
  __syncthreads(); RESC(alB);
  finishSM(pB0, pB1, alB, l_reg, pa0, pa1, pa2, pa3); SBAR();
  pv_d0(o, vb0 + (int)SHM_V, pa0, pa1, pa2, pa3);
  if constexpr (!PARTIAL) {
  if (hi == 0) li_l[r32] = l_reg; asm volatile("s_waitcnt lgkmcnt(0)" ::: "memory");
  float rli[16];
#pragma unroll
  for (int r = 0; r < 16; ++r) rli[r] = __builtin_amdgcn_rcpf(li_l[crow(r, hi)]);
  const bf16_t* Gw = Gb + (long)(wid * QBLK) * LDG; bf16_t* Ow = Ob + (long)(wid * QBLK) * LDO;
#pragma unroll
  for (int r = 0; r < 16; ++r) { int orow = crow(r, hi);
    for (int d0 = 0; d0 < 4; ++d0) { const float gt = bf2f(Gw[(long)orow * LDG + d0 * 32 + r32]); Ow[(long)orow * LDO + d0 * 32 + r32] = (bf16_t)f2bf(o[d0][r] * rli[r] * gt); }
    if ((r & 3) == 3) __builtin_amdgcn_sched_barrier(0); }
  } else {
    constexpr float C = SCALE * 1.4426950408889634f;
    { float* Pw = Pself + (long)(wid * QBLK) * 128;
#pragma unroll
      for (int r = 0; r < 16; ++r) { const int orow = crow(r, hi);
        for (int d0 = 0; d0 < 4; ++d0) Pw[orow * 128 + d0 * 32 + r32] = o[d0][r];
        if ((r & 3) == 3) __builtin_amdgcn_sched_barrier(0); }
      if (hi == 0) { Pself[256 * 128 + wid * QBLK + r32] = m_reg; Pself[256 * 128 + 256 + wid * QBLK + r32] = l_reg; } }
    __builtin_amdgcn_fence(__ATOMIC_RELEASE, "agent"); asm volatile("s_waitcnt vmcnt(0)" ::: "memory"); __syncthreads();
    volatile unsigned* flag = (volatile unsigned*)(lds + SHM_ATTN);
    if (tid == 0) *flag = atomicAdd(cnt, 1u);
    __syncthreads();
    if (*flag == 1u) {
      __builtin_amdgcn_fence(__ATOMIC_ACQUIRE, "agent");
      const float m2 = __builtin_nontemporal_load(Pother + 256 * 128 + wid * QBLK + r32), l2 = __builtin_nontemporal_load(Pother + 256 * 128 + 256 + wid * QBLK + r32);
      const float M = fmaxf(m_reg, m2), a1 = __builtin_amdgcn_exp2f((m_reg - M) * C), a2 = __builtin_amdgcn_exp2f((m2 - M) * C), inv = __builtin_amdgcn_rcpf(l_reg * a1 + l2 * a2);
      if (hi == 0) { li_l[r32] = a1 * inv; al_l[r32] = a2 * inv; } asm volatile("s_waitcnt lgkmcnt(0)" ::: "memory");
      const float* Po = Pother + (long)(wid * QBLK) * 128; const bf16_t* Gw = Gb + (long)(wid * QBLK) * LDG; bf16_t* Ow = Ob + (long)(wid * QBLK) * LDO;
#pragma unroll
      for (int r = 0; r < 16; ++r) { const int orow = crow(r, hi); const float w1 = li_l[orow], w2 = al_l[orow];
        for (int d0 = 0; d0 < 4; ++d0) { const float gt = bf2f(Gw[(long)orow * LDG + d0 * 32 + r32]); const float ov = __builtin_nontemporal_load(Po + orow * 128 + d0 * 32 + r32);
          Ow[(long)orow * LDO + d0 * 32 + r32] = (bf16_t)f2bf((o[d0][r] * w1 + ov * w2) * gt); }
        if ((r & 3) == 3) __builtin_amdgcn_sched_barrier(0); }
    }
    __syncthreads();
  }
#undef SLOAD
#undef SWRITE
#undef SWAIT
#undef RESC
}

#undef KSWZ
#undef SBAR
}

__device__ __forceinline__ void pool_phase(const float* __restrict__ AV, const bf16_t* __restrict__ AG, bf16_t* __restrict__ MIX, unsigned* ctr, volatile unsigned* slot, int tid) {
  const int c4 = (tid & 63) * 4, tg = tid >> 6, w2 = 1 << (c4 >> 6);
  for (;;) {
    __syncthreads();
    if (tid == 0) *slot = atomicAdd(ctr, 1u);
    __syncthreads();
    const int item = (int)*slot;
    if (item >= L / 32) break;
#pragma unroll 1
    for (int q = 0; q < 4; ++q) { const int t = item * 32 + tg * 4 + q;
      const int lo = max(t - w2, 0), hi = min(t + w2, L);
      f32x4 s = {0.f, 0.f, 0.f, 0.f};
      for (int u = lo; u < hi; ++u) s += *(const f32x4*)(AV + (size_t)u * 256 + c4);
      const f32x4 me = *(const f32x4*)(AV + (size_t)t * 256 + c4); const float ic = 1.f / (float)(hi - lo);
      const u32x2 gw = *(const u32x2*)(AG + (size_t)t * 256 + c4);
      const float g0 = __uint_as_float(gw.x << 16), g1 = __uint_as_float(gw.x & 0xffff0000u), g2 = __uint_as_float(gw.y << 16), g3 = __uint_as_float(gw.y & 0xffff0000u);
      u32x2 w; w.x = pk2((s.x * ic - me.x) * g0, (s.y * ic - me.y) * g1); w.y = pk2((s.z * ic - me.z) * g2, (s.w * ic - me.w) * g3);
      *(u32x2*)(MIX + (size_t)t * 1024 + c4) = w; }
  }
}

__device__ __forceinline__ void prep_queue(const Args& a, unsigned* ctr, volatile unsigned* slot, float* lds, int tid) {
  for (;;) {
    __syncthreads();
    if (tid == 0) *slot = atomicAdd(ctr, 1u);
    __syncthreads();
    int item = (int)*slot;
    if (item < 128) { fold_item(a, item, lds, tid); continue; }
    item -= 128;
    if (item >= prep::N_LATE) break;
    prep_item(a, prep::late_item(item), lds, tid);
  }
}

#define PADI(i) ((i) + ((i) >> 5))
__device__ __forceinline__ float2 cadd(float2 a, float2 b) { return make_float2(a.x + b.x, a.y + b.y); }
__device__ __forceinline__ float2 csub(float2 a, float2 b) { return make_float2(a.x - b.x, a.y - b.y); }
__device__ __forceinline__ float2 cmul(float2 a, float2 b) { return make_float2(a.x * b.x - a.y * b.y, a.x * b.y + a.y * b.x); }
__device__ constexpr float W32C[16] = {1.f, 0.98078528040323043f, 0.92387953251128674f, 0.83146961230254524f, 0.70710678118654752f, 0.55557023301960218f, 0.38268343236508977f, 0.19509032201612825f,
                                       0.f, -0.19509032201612825f, -0.38268343236508977f, -0.55557023301960218f, -0.70710678118654752f, -0.83146961230254524f, -0.92387953251128674f, -0.98078528040323043f};
__device__ constexpr float W32S[16] = {0.f, 0.19509032201612825f, 0.38268343236508977f, 0.55557023301960218f, 0.70710678118654752f, 0.83146961230254524f, 0.92387953251128674f, 0.98078528040323043f,
                                       1.f, 0.98078528040323043f, 0.92387953251128674f, 0.83146961230254524f, 0.70710678118654752f, 0.55557023301960218f, 0.38268343236508977f, 0.19509032201612825f};
template <int S, bool INV>
__device__ __forceinline__ void fft_pass8(float2* cb, const float2* twL, int tid) {
  static_assert(S % 32 == 0, "constant LDS offsets need S % 32 == 0");
  constexpr float R = 0.70710678118654752f;
  constexpr int ES = S + S / 32;
#pragma unroll 2
  for (int it = 0; it < 4; ++it) {
    const int u = it * 512 + tid, j = u & (S - 1), base = ((u & ~(S - 1)) << 3) + j;
    float2* p = cb + PADI(base);
    float2 x[8];
#pragma unroll
    for (int e = 0; e < 8; ++e) x[e] = p[e * ES];
    float2 t1 = twL[j * (2048 / S)]; if (INV) t1.y = -t1.y;
    const float2 t2 = cmul(t1, t1), t3 = cmul(t2, t2);
    float2 w8[4]; w8[0] = t1;
    if (!INV) { w8[1] = cmul(t1, make_float2(R, -R)); w8[2] = make_float2(t1.y, -t1.x); w8[3] = cmul(t1, make_float2(-R, -R)); }
    else      { w8[1] = cmul(t1, make_float2(R, R));  w8[2] = make_float2(-t1.y, t1.x); w8[3] = cmul(t1, make_float2(-R, R)); }
    float2 w4[2]; w4[0] = t2; w4[1] = INV ? make_float2(-t2.y, t2.x) : make_float2(t2.y, -t2.x);
    if (!INV) {
#pragma unroll
      for (int e = 0; e < 4; ++e) { const float2 a = x[e], c = x[e + 4]; x[e] = cadd(a, c); x[e + 4] = cmul(csub(a, c), w8[e]); }
#pragma unroll
      for (int q = 0; q < 8; q += 4)
#pragma unroll
        for (int e = 0; e < 2; ++e) { const float2 a = x[q + e], c = x[q + e + 2]; x[q + e] = cadd(a, c); x[q + e + 2] = cmul(csub(a, c), w4[e]); }
#pragma unroll
      for (int q = 0; q < 8; q += 2) { const float2 a = x[q], c = x[q + 1]; x[q] = cadd(a, c); x[q + 1] = cmul(csub(a, c), t3); }
    } else {
#pragma unroll
      for (int q = 0; q < 8; q += 2) { const float2 a = x[q], c = cmul(x[q + 1], t3); x[q] = cadd(a, c); x[q + 1] = csub(a, c); }
#pragma unroll
      for (int q = 0; q < 8; q += 4)
#pragma unroll
        for (int e = 0; e < 2; ++e) { const float2 a = x[q + e], c = cmul(x[q + e + 2], w4[e]); x[q + e] = cadd(a, c); x[q + e + 2] = csub(a, c); }
#pragma unroll
      for (int e = 0; e < 4; ++e) { const float2 a = x[e], c = cmul(x[e + 4], w8[e]); x[e] = cadd(a, c); x[e + 4] = csub(a, c); }
    }
#pragma unroll
    for (int e = 0; e < 8; ++e) p[e * ES] = x[e];
  }
  __syncthreads();
}
template <bool INV>
__device__ __forceinline__ void fft_pass32(float2* cb, int tid) {
  float2* p = cb + 33 * tid;
  float2 x[32];
#pragma unroll
  for (int e = 0; e < 32; ++e) x[e] = p[e];
  if (!INV) {
#pragma unroll
    for (int h = 16; h >= 1; h >>= 1)
#pragma unroll
      for (int b = 0; b < 32; b += 2 * h)
#pragma unroll
        for (int q = 0; q < h; ++q) { const float2 a = x[b + q], c = x[b + q + h], d = csub(a, c); x[b + q] = cadd(a, c);
          const int k = q * (16 / h);
          if (k == 0) x[b + q + h] = d; else if (k == 8) x[b + q + h] = make_float2(d.y, -d.x); else x[b + q + h] = cmul(d, make_float2(W32C[k], -W32S[k])); }
  } else {
#pragma unroll
    for (int h = 1; h <= 16; h <<= 1)
#pragma unroll
      for (int b = 0; b < 32; b += 2 * h)
#pragma unroll
        for (int q = 0; q < h; ++q) { const float2 a = x[b + q], c0 = x[b + q + h]; float2 c;
          const int k = q * (16 / h);
          if (k == 0) c = c0; else if (k == 8) c = make_float2(-c0.y, c0.x); else c = cmul(c0, make_float2(W32C[k], W32S[k]));
          x[b + q] = cadd(a, c); x[b + q + h] = csub(a, c); }
  }
#pragma unroll
  for (int e = 0; e < 32; ++e) p[e] = x[e];
  __syncthreads();
}
__device__ __forceinline__ void fft_fwd(float2* cb, const float2* twL, int tid) {
  fft_pass8<2048, false>(cb, twL, tid); fft_pass8<256, false>(cb, twL, tid); fft_pass8<32, false>(cb, twL, tid); fft_pass32<false>(cb, tid);
}
__device__ __forceinline__ void fft_inv(float2* cb, const float2* twL, int tid) {
  fft_pass32<true>(cb, tid); fft_pass8<32, true>(cb, twL, tid); fft_pass8<256, true>(cb, twL, tid); fft_pass8<2048, true>(cb, twL, tid);
}
template <bool ODD>
__device__ __forceinline__ void fft_pointwise(float2* cb, int tid) {
#pragma unroll 1
  for (int j = 0; j < (ODD ? 16 : 32); ++j) {
    const int p = j * 512 + tid;
    int pp;
    if (ODD) pp = 16383 - p; else pp = (p < 2) ? p : (p ^ ((1 << (31 - __clz(p))) - 1));
    if (p <= pp) {
      const float2 C = cb[PADI(p)], C2 = cb[PADI(pp)];
      const float2 Z = make_float2(0.5f * (C.x + C2.x), 0.5f * (C.y - C2.y)), K = make_float2(0.5f * (C.y + C2.y), -0.5f * (C.x - C2.x));
      const float2 Y = cmul(Z, K);
      cb[PADI(p)] = Y; cb[PADI(pp)] = make_float2(Y.x, -Y.y);
    }
  }
  __syncthreads();
}
__device__ __forceinline__ float conv3_at(const bf16_t* __restrict__ row, int t, float w0, float w1, float w2, float b) {
  const unsigned tm = (unsigned)max(t - 1, 0), tp = (unsigned)min(t + 1, L - 1); float um = bf2f(row[tm]), up = bf2f(row[tp]); const float u0 = bf2f(row[(unsigned)t]);
  um = t > 0 ? um : 0.f; up = t < L - 1 ? up : 0.f;
  return w0 * um + w1 * u0 + w2 * up + b;
}


namespace mf {
typedef short bf16x8 __attribute__((ext_vector_type(8)));
typedef short bf16x4 __attribute__((ext_vector_type(4)));
constexpr int RS = 272, PL = 128 * RS;
constexpr int O_DRE = 0, O_DIM = PL, O_FRE = 2 * PL, O_FIM = 3 * PL, O_TWA = 4 * PL, O_TWB = 4 * PL + 1024, O_RED = 4 * PL + 2048;
__device__ __forceinline__ bf16x4 tr_rd(unsigned addr) { bf16x4 r; asm volatile("ds_read_b64_tr_b16 %0, %1" : "=&v"(r) : "v"(addr) : "memory"); return r; }
__device__ __forceinline__ bf16x8 negv(bf16x8 v) { u32x4 t = __builtin_bit_cast(u32x4, v); t.x ^= 0x80008000u; t.y ^= 0x80008000u; t.z ^= 0x80008000u; t.w ^= 0x80008000u; return __builtin_bit_cast(bf16x8, t); }
__device__ __forceinline__ bf16x8 cat(bf16x4 a, bf16x4 b) { return (bf16x8){a[0], a[1], a[2], a[3], b[0], b[1], b[2], b[3]}; }
__device__ __forceinline__ float2 twid(const char* lds, int idx, bool inv) {
  const float2 ta = ((const float2*)(lds + O_TWA))[idx >> 7], tb = ((const float2*)(lds + O_TWB))[idx & 127];
  float2 w = make_float2(ta.x * tb.x - ta.y * tb.y, ta.x * tb.y + ta.y * tb.x); if (inv) w.y = -w.y; return w;
}
template <bool INV, bool TW, int OUT>
__device__ __forceinline__ void dft_cols(char* lds, const float2* __restrict__ TW2, int tid) {
  const int lane = tid & 63, w = tid >> 6, g = lane >> 4, n16 = lane & 15, q = n16 >> 2, p = lane & 3;
  const unsigned base = (unsigned)(uintptr_t)lds;
  bf16x8 bre[4], bim[4];
  { bf16x4 t0[4], t1[4], u0[4], u1[4];
#pragma unroll
    for (int ks = 0; ks < 4; ++ks) { const unsigned a0 = base + RS * (32 * ks + 8 * g + q) + 16 * (2 * w + (p >> 1)) + 8 * (p & 1), a1 = a0 + 4 * RS;
      t0[ks] = tr_rd(a0 + O_DRE); t1[ks] = tr_rd(a1 + O_DRE); u0[ks] = tr_rd(a0 + O_DIM); u1[ks] = tr_rd(a1 + O_DIM); }
    asm volatile("s_waitcnt lgkmcnt(0)" ::: "memory"); __builtin_amdgcn_sched_barrier(0);
#pragma unroll
    for (int ks = 0; ks < 4; ++ks) { bre[ks] = cat(t0[ks], t1[ks]); bim[ks] = cat(u0[ks], u1[ks]); } }
  if (OUT != 0) __syncthreads();
  bf16x8 x2[4], x3[4];
#pragma unroll
  for (int ks = 0; ks < 4; ++ks) { x2[ks] = INV ? bim[ks] : negv(bim[ks]); x3[ks] = INV ? negv(bre[ks]) : bre[ks]; }
#pragma unroll 2
  for (int rb = 0; rb < 8; ++rb) {
    f32x4 dre = {0.f, 0.f, 0.f, 0.f}, dim = {0.f, 0.f, 0.f, 0.f};
    const char* fr = lds + O_FRE + RS * (n16 + 16 * rb) + 16 * g; const char* fi = fr + PL;
#pragma unroll
    for (int ks = 0; ks < 4; ++ks) { const bf16x8 afr = *(const bf16x8*)(fr + 64 * ks), afi = *(const bf16x8*)(fi + 64 * ks);
      dre = __builtin_amdgcn_mfma_f32_16x16x32_bf16(bre[ks], afr, dre, 0, 0, 0); dre = __builtin_amdgcn_mfma_f32_16x16x32_bf16(x2[ks], afi, dre, 0, 0, 0);
      if (OUT != 1) { dim = __builtin_amdgcn_mfma_f32_16x16x32_bf16(bim[ks], afr, dim, 0, 0, 0); dim = __builtin_amdgcn_mfma_f32_16x16x32_bf16(x3[ks], afi, dim, 0, 0, 0); } }
    const int row = 16 * rb + n16, c0 = 16 * w + 4 * g;
    float vr[4], vi[4];
#pragma unroll
    for (int r = 0; r < 4; ++r) { vr[r] = dre[r]; vi[r] = dim[r];
      if (TW) { const float2 t = twid(lds, row * (c0 + r), INV); const float a = vr[r] * t.x - vi[r] * t.y, b = vr[r] * t.y + vi[r] * t.x; vr[r] = a; vi[r] = b; } }
    if (OUT == 0) { u32x2 wr_, wi_; wr_.x = pk2(vr[0], vr[1]); wr_.y = pk2(vr[2], vr[3]); wi_.x = pk2(vi[0], vi[1]); wi_.y = pk2(vi[2], vi[3]);
      *(u32x2*)(lds + O_DRE + RS * row + 2 * c0) = wr_; *(u32x2*)(lds + O_DIM + RS * row + 2 * c0) = wi_; }
    else if (OUT == 1) { *(f32x4*)((float*)lds + 128 * row + c0) = (f32x4){vr[0], vr[1], vr[2], vr[3]}; }
    else { const f32x4 ta = *(const f32x4*)(TW2 + 128 * row + c0), tb = *(const f32x4*)(TW2 + 128 * row + c0 + 2);
      *(f32x4*)((float*)lds + 128 * row + c0) = (f32x4){vr[0] * ta.x + vi[0] * ta.y, vr[1] * ta.z + vi[1] * ta.w, vr[2] * tb.x + vi[2] * tb.y, vr[3] * tb.z + vi[3] * tb.w}; }
  }
  __syncthreads();
}
template <bool INV, bool TW>
__device__ __forceinline__ void dft_rows(char* lds, int tid) {
  const int lane = tid & 63, w = tid >> 6, g = lane >> 4, n16 = lane & 15;
  bf16x8 are[4], aim[4], x2[4], x3[4];
  { const char* pr = lds + O_DRE + RS * (n16 + 16 * w) + 16 * g; const char* pi = pr + PL;
#pragma unroll
    for (int ks = 0; ks < 4; ++ks) { are[ks] = *(const bf16x8*)(pr + 64 * ks); aim[ks] = *(const bf16x8*)(pi + 64 * ks); x2[ks] = INV ? aim[ks] : negv(aim[ks]); x3[ks] = INV ? negv(are[ks]) : are[ks]; } }
#pragma unroll 2
  for (int cbk = 0; cbk < 8; ++cbk) {
    f32x4 dre = {0.f, 0.f, 0.f, 0.f}, dim = {0.f, 0.f, 0.f, 0.f};
    const char* fr = lds + O_FRE + RS * (n16 + 16 * cbk) + 16 * g; const char* fi = fr + PL;
#pragma unroll
    for (int ks = 0; ks < 4; ++ks) { const bf16x8 bfr = *(const bf16x8*)(fr + 64 * ks), bfi = *(const bf16x8*)(fi + 64 * ks);
      dre = __builtin_amdgcn_mfma_f32_16x16x32_bf16(bfr, are[ks], dre, 0, 0, 0); dre = __builtin_amdgcn_mfma_f32_16x16x32_bf16(bfi, x2[ks], dre, 0, 0, 0);
      dim = __builtin_amdgcn_mfma_f32_16x16x32_bf16(bfi, x3[ks], dim, 0, 0, 0); dim = __builtin_amdgcn_mfma_f32_16x16x32_bf16(bfr, aim[ks], dim, 0, 0, 0); }
    const int row = 16 * w + n16, c0 = 16 * cbk + 4 * g;
    float vr[4], vi[4];
#pragma unroll
    for (int r = 0; r < 4; ++r) { vr[r] = dre[r]; vi[r] = dim[r];
      if (TW) { const float2 t = twid(lds, row * (c0 + r), INV); const float a = vr[r] * t.x - vi[r] * t.y, b = vr[r] * t.y + vi[r] * t.x; vr[r] = a; vi[r] = b; } }
    u32x2 wr_, wi_; wr_.x = pk2(vr[0], vr[1]); wr_.y = pk2(vr[2], vr[3]); wi_.x = pk2(vi[0], vi[1]); wi_.y = pk2(vi[2], vi[3]);
    *(u32x2*)(lds + O_DRE + RS * row + 2 * c0) = wr_; *(u32x2*)(lds + O_DIM + RS * row + 2 * c0) = wi_;
  }
  __syncthreads();
}
template <bool ODD>
__device__ __forceinline__ void pointwise(char* lds, int tid) {
#pragma unroll 1
  for (int j = 0; j < (ODD ? 16 : 17); ++j) {
    const int pq = j * 512 + tid;
    int k1, k2, q1, q2; bool act = true;
    if (ODD) { k1 = pq >> 7; k2 = pq & 127; q1 = 127 - k1; q2 = 127 - k2; }
    else if (pq < 8064) { k1 = 1 + (pq >> 7); k2 = pq & 127; q1 = 128 - k1; q2 = 127 - k2; }
    else if (pq < 8192) { k1 = 0; k2 = pq - 8064; q1 = 0; q2 = (128 - k2) & 127; act = k2 <= q2; }
    else if (pq < 8320) { k1 = 64; k2 = pq - 8192; q1 = 64; q2 = 127 - k2; act = k2 <= q2; }
    else { k1 = k2 = q1 = q2 = 0; act = false; }
    if (act) {
      bf16_t* r0 = (bf16_t*)(lds + O_DRE + RS * k1 + 2 * k2); bf16_t* i0 = (bf16_t*)(lds + O_DIM + RS * k1 + 2 * k2);
      bf16_t* r1 = (bf16_t*)(lds + O_DRE + RS * q1 + 2 * q2); bf16_t* i1 = (bf16_t*)(lds + O_DIM + RS * q1 + 2 * q2);
      const float cx = bf2f(*r0), cy = bf2f(*i0), dx = bf2f(*r1), dy = bf2f(*i1);
      const float zx = 0.5f * (cx + dx), zy = 0.5f * (cy - dy), kx = 0.5f * (cy + dy), ky = -0.5f * (cx - dx);
      const float yx = zx * kx - zy * ky, yy = zx * ky + zy * kx;
      *r0 = (bf16_t)f2bf(yx); *i0 = (bf16_t)f2bf(yy); *r1 = (bf16_t)f2bf(yx); *i1 = (bf16_t)f2bf(-yy);
    }
  }
  __syncthreads();
}
}

__device__ __forceinline__ void conv3_pair(const bf16_t* __restrict__ row, int n0, float w0, float w1, float w2, float b, float& o0, float& o1) {
  const unsigned pr = *(const unsigned*)(row + (unsigned)n0); const float u0 = __uint_as_float(pr << 16), u1 = __uint_as_float(pr & 0xffff0000u);
  float um = bf2f(row[(unsigned)max(n0 - 1, 0)]), up = bf2f(row[(unsigned)min(n0 + 2, L - 1)]); um = n0 > 0 ? um : 0.f; up = (n0 + 2 < L) ? up : 0.f;
  o0 = w0 * um + w1 * u0 + w2 * u1 + b; o1 = w0 * u0 + w1 * u1 + w2 * up + b;
}
__device__ __forceinline__ void hyena_mfma_items(const Args& a, char* lds, int tid) {
  bf16_t* P1T = (bf16_t*)(a.ws + WS_P1T); const bf16_t* HT = (const bf16_t*)(a.ws + WS_HT);
  const float2* TW2 = (const float2*)(a.ws + WS_TW2);
  float* red = (float*)(lds + mf::O_RED); float* outf = (float*)lds;
  for (int idx = tid; idx < 16384; idx += 512) { const int r = idx >> 7, c = idx & 127, m = (r * c) & 127; float s, co; sincospif((float)m / 64.f, &s, &co);
    *(bf16_t*)(lds + mf::O_FRE + mf::RS * r + 2 * c) = (bf16_t)f2bf(co); *(bf16_t*)(lds + mf::O_FIM + mf::RS * r + 2 * c) = (bf16_t)f2bf(-s); }
  if (tid < 128) { float s, co; sincospif((float)tid / 64.f, &s, &co); ((float2*)(lds + mf::O_TWA))[tid] = make_float2(co, -s); ((float2*)(lds + mf::O_TWB))[tid] = TW2[2 * tid]; }
  __syncthreads();
  const float* cw = a.in[15]; const float* cbias = a.in[16]; const float* skip = a.in[23];
#ifndef HY_PROBE
#define HY_PROBE 0
#endif
#pragma unroll 1
  for (int pass = HY_PROBE ? 0 : 1; pass < 2; ++pass)
  for (int item = blockIdx.x; item < (pass ? 768 : 256); item += gridDim.x) {
    asm volatile("" : "+v"(tid));
    const int c = item;
    const float ad = fabsf(-3.0701134573f + (-15.350567286f + 3.0701134573f) * ((float)c * (1.f / 767.f))) * (1.f / 16383.f);
    const float dr1 = __expf(-ad);
    float z[32], acc[32];
    { const bf16_t* vr = P1T + (size_t)c * L; const float w0 = cw[c], w1 = cw[2304 + c], w2 = cw[4608 + c], b = cbias[c];
asm volatile("" : "+v"(tid));
#pragma unroll
      for (int jp = 0; jp < 16; ++jp) { if ((jp & 15) == 0) __builtin_amdgcn_sched_barrier(0); conv3_pair(vr, jp * 1024 + 2 * tid, w0, w1, w2, b, z[2 * jp], z[2 * jp + 1]); } }
#pragma unroll 1
    for (int o = 0; o < 2; ++o) {
      const bf16_t* hf = HT + (size_t)((o * 2 + 0) * 768 + c) * L; const bf16_t* hb = HT + (size_t)((o * 2 + 1) * 768 + c) * L;
      float ssum = 0.f; unsigned kst[16];
asm volatile("" : "+v"(tid));
#pragma unroll
      for (int jp = 0; jp < 16; ++jp) { if ((jp & 15) == 0) __builtin_amdgcn_sched_barrier(0); const int n0 = jp * 1024 + 2 * tid; const int nb0 = (L - n0) & (L - 1), nb1 = L - 1 - n0;
        const unsigned pf = *(const unsigned*)(hf + (unsigned)n0); const float e0 = __expf(-ad * (float)n0);
        const float f0 = __uint_as_float(pf << 16) * e0, f1 = __uint_as_float(pf & 0xffff0000u) * (e0 * dr1);
        float b0 = bf2f(hb[(unsigned)nb0]) * __expf(-ad * (float)nb0); const float b1 = bf2f(hb[(unsigned)nb1]) * __expf(-ad * (float)nb1);
        ssum += (fabsf(f0) + fabsf(b0)) + (fabsf(f1) + fabsf(b1)); b0 = n0 ? b0 : 0.f; const int off = mf::RS * (n0 >> 7) + 2 * (n0 & 127);
        *(unsigned*)(lds + mf::O_DRE + off) = pk2(z[2 * jp], z[2 * jp + 1]); *(unsigned*)(lds + mf::O_DIM + off) = pk2(f0 + b0, f1 + b1); kst[jp] = pk2(f0 - b0, f1 - b1); }
      ssum = wave_sum(ssum); if ((tid & 63) == 0) red[tid >> 6] = ssum;
      __syncthreads();
      const float nrm = EPS + ((red[0] + red[1]) + (red[2] + red[3])) + ((red[4] + red[5]) + (red[6] + red[7]));
      mf::dft_cols<false, true, 0>(lds, TW2, tid); mf::dft_rows<false, false>(lds, tid); mf::pointwise<false>(lds, tid);
      mf::dft_rows<true, true>(lds, tid); mf::dft_cols<true, false, 1>(lds, TW2, tid);
asm volatile("" : "+v"(tid));
#pragma unroll
      for (int jp = 0; jp < 16; ++jp) { if ((jp & 15) == 0) __builtin_amdgcn_sched_barrier(0); const float2 v = *(const float2*)(outf + jp * 1024 + 2 * tid); acc[2 * jp] = v.x; acc[2 * jp + 1] = v.y; }
      __syncthreads();
asm volatile("" : "+v"(tid));
#pragma unroll
      for (int jp = 0; jp < 16; ++jp) { if ((jp & 15) == 0) __builtin_amdgcn_sched_barrier(0); const int n0 = jp * 1024 + 2 * tid;
        const float k0 = __uint_as_float(kst[jp] << 16), k1 = __uint_as_float(kst[jp] & 0xffff0000u); const f32x4 w = *(const f32x4*)(TW2 + n0);
        const int off = mf::RS * (n0 >> 7) + 2 * (n0 & 127);
        *(unsigned*)(lds + mf::O_DRE + off) = pk2(z[2 * jp] * w.x - k0 * w.y, z[2 * jp + 1] * w.z - k1 * w.w);
        *(unsigned*)(lds + mf::O_DIM + off) = pk2(z[2 * jp] * w.y + k0 * w.x, z[2 * jp + 1] * w.w + k1 * w.z); }
      __syncthreads();
      mf::dft_cols<false, true, 0>(lds, TW2, tid); mf::dft_rows<false, false>(lds, tid); mf::pointwise<true>(lds, tid);
      mf::dft_rows<true, true>(lds, tid); mf::dft_cols<true, false, 2>(lds, TW2, tid);
      const bf16_t* gr = P1T + (size_t)((o + 1) * 768 + c) * L; const int gc = (o + 1) * 768 + c;
      const float w0 = cw[gc], w1 = cw[2304 + gc], w2 = cw[4608 + gc], b = cbias[gc], sk = skip[o * 768 + c], sc = (1.f / 32768.f) / nrm;
asm volatile("" : "+v"(tid));
#pragma unroll
      for (int jp = 0; jp < 16; ++jp) { if ((jp & 15) == 0) __builtin_amdgcn_sched_barrier(0); const int n0 = jp * 1024 + 2 * tid; const float2 v = *(const float2*)(outf + n0);
        float g0, g1; conv3_pair(gr, n0, w0, w1, w2, b, g0, g1);
        z[2 * jp] = g0 * ((acc[2 * jp] + v.x) * sc + sk * z[2 * jp]); z[2 * jp + 1] = g1 * ((acc[2 * jp + 1] + v.y) * sc + sk * z[2 * jp + 1]); }
      __syncthreads();
    }
    { const bf16_t* gt = P1T + (size_t)(2304 + c) * L; bf16_t* orow = pass ? P1T + (size_t)c * L : (bf16_t*)(a.ws + 126 * MiB) + (size_t)c * L;
asm volatile("" : "+v"(tid));
#pragma unroll
      for (int jp = 0; jp < 16; ++jp) { if ((jp & 15) == 0) __builtin_amdgcn_sched_barrier(0); const int n0 = jp * 1024 + 2 * tid; const unsigned pg = *(const unsigned*)(gt + (unsigned)n0);
        *(unsigned*)(orow + (unsigned)n0) = pk2(z[2 * jp] * __uint_as_float(pg << 16), z[2 * jp + 1] * __uint_as_float(pg & 0xffff0000u)); } }
#ifdef HY_EXTRA
    __syncthreads();
    for (int xr = 0; xr < HY_EXTRA; ++xr) { mf::dft_cols<false, true, 0>(lds, TW2, tid); mf::dft_rows<false, false>(lds, tid); mf::pointwise<false>(lds, tid); mf::dft_rows<true, true>(lds, tid); mf::dft_cols<true, false, 1>(lds, TW2, tid); }
#endif
  }
}

__device__ __forceinline__ void hyena_fourier_phase(const Args& a, char* lds, int tid) {
  float2* cb = (float2*)lds; float2* twL = (float2*)(lds + 135168); float* red = (float*)(lds + 135168 + 16384);
  bf16_t* P1T = (bf16_t*)(a.ws + WS_P1T); const bf16_t* HT = (const bf16_t*)(a.ws + WS_HT);
  const float2* TW2 = (const float2*)(a.ws + WS_TW2);
  for (int i = tid; i < 2048; i += 512) twL[i] = TW2[2 * i];
  __syncthreads();
  const float* cw = a.in[15]; const float* cbias = a.in[16]; const float* skip = a.in[23];
#ifndef HY_MFMA
#define HY_MFMA 1
#endif
  for (int item = (HY_MFMA ? 768 : 0) + blockIdx.x; item < 1024; item += gridDim.x) {
    asm volatile("" : "+v"(tid));
    if (item < 768) {
      const int c = item;
      const float ad = fabsf(-3.0701134573f + (-15.350567286f + 3.0701134573f) * ((float)c * (1.f / 767.f))) * (1.f / 16383.f);
      float z[32], acc[32];
      { const bf16_t* vr = P1T + (size_t)c * L; const float w0 = cw[c], w1 = cw[2304 + c], w2 = cw[4608 + c], b = cbias[c];
asm volatile("" : "+v"(tid));
#pragma unroll
        for (int j = 0; j < 32; ++j) { if ((j & 15) == 0) __builtin_amdgcn_sched_barrier(0); z[j] = conv3_at(vr, j * 512 + tid, w0, w1, w2, b); } }
#pragma unroll 1
      for (int o = 0; o < 2; ++o) {
        const bf16_t* hf = HT + (size_t)((o * 2 + 0) * 768 + c) * L; const bf16_t* hb = HT + (size_t)((o * 2 + 1) * 768 + c) * L;
        float ssum = 0.f;
asm volatile("" : "+v"(tid));
#pragma unroll
        for (int j = 0; j < 32; ++j) { if ((j & 15) == 0) __builtin_amdgcn_sched_barrier(0); const int n = j * 512 + tid; const int nb = (L - n) & (L - 1); const float f = bf2f(hf[(unsigned)n]) * __expf(-ad * (float)n); float b = bf2f(hb[(unsigned)nb]) * __expf(-ad * (float)nb);
          ssum += fabsf(f) + fabsf(b); b = n ? b : 0.f; cb[PADI(n)] = make_float2(z[j], f + b); }
        ssum = wave_sum(ssum); if ((tid & 63) == 0) red[tid >> 6] = ssum;
        __syncthreads();
        const float nrm = EPS + ((red[0] + red[1]) + (red[2] + red[3])) + ((red[4] + red[5]) + (red[6] + red[7]));
        fft_fwd(cb, twL, tid); fft_pointwise<false>(cb, tid); fft_inv(cb, twL, tid);
asm volatile("" : "+v"(tid));
#pragma unroll
        for (int j = 0; j < 32; ++j) { if ((j & 15) == 0) __builtin_amdgcn_sched_barrier(0); acc[j] = cb[PADI(j * 512 + tid)].x; }
        __syncthreads();
asm volatile("" : "+v"(tid));
#pragma unroll
        for (int j = 0; j < 32; ++j) { if ((j & 15) == 0) __builtin_amdgcn_sched_barrier(0); const int n = j * 512 + tid; const int nb = (L - n) & (L - 1); const float f = bf2f(hf[(unsigned)n]) * __expf(-ad * (float)n); float b = bf2f(hb[(unsigned)nb]) * __expf(-ad * (float)nb); b = n ? b : 0.f; const float kk = f - b; const float2 w = TW2[n];
          cb[PADI(n)] = make_float2(z[j] * w.x - kk * w.y, z[j] * w.y + kk * w.x); }
        __syncthreads();
        fft_fwd(cb, twL, tid); fft_pointwise<true>(cb, tid); fft_inv(cb, twL, tid);
        const bf16_t* gr = P1T + (size_t)((o + 1) * 768 + c) * L; const int gc = (o + 1) * 768 + c;
        const float w0 = cw[gc], w1 = cw[2304 + gc], w2 = cw[4608 + gc], b = cbias[gc], sk = skip[o * 768 + c], sc = (1.f / 32768.f) / nrm;
asm volatile("" : "+v"(tid));
#pragma unroll
        for (int j = 0; j < 32; ++j) { if ((j & 15) == 0) __builtin_amdgcn_sched_barrier(0); const int n = j * 512 + tid; const float2 r = cb[PADI(n)], w = TW2[n];
          const float cv = (acc[j] + r.x * w.x + r.y * w.y) * sc;
          z[j] = conv3_at(gr, n, w0, w1, w2, b) * (cv + sk * z[j]); }
        __syncthreads();
      }
      { const bf16_t* gt = P1T + (size_t)(2304 + c) * L; bf16_t* orow = P1T + (size_t)c * L;
asm volatile("" : "+v"(tid));
#pragma unroll
        for (int j = 0; j < 32; ++j) { if ((j & 15) == 0) __builtin_amdgcn_sched_barrier(0); const int n = j * 512 + tid; orow[n] = (bf16_t)f2bf(z[j] * bf2f(gt[n])); } }
#ifdef HY_EXTRA
      __syncthreads();
      for (int xr = 0; xr < 2; ++xr) { fft_fwd(cb, twL, tid); fft_pointwise<false>(cb, tid); fft_inv(cb, twL, tid); fft_fwd(cb, twL, tid); fft_pointwise<true>(cb, tid); fft_inv(cb, twL, tid); }
#endif
    } else {
      const int k = item - 768;
      const bf16_t* ar = P1T + (size_t)(3072 + k) * L; const bf16_t* ai = P1T + (size_t)(3328 + k) * L; const bf16_t* gt = P1T + (size_t)(3584 + k) * L;
asm volatile("" : "+v"(tid));
#pragma unroll
      for (int j = 0; j < 32; ++j) { if ((j & 15) == 0) __builtin_amdgcn_sched_barrier(0); const int n = j * 512 + tid; cb[PADI(n)] = make_float2(bf2f(ar[n]), bf2f(ai[n])); }
      __syncthreads();
      fft_fwd(cb, twL, tid);
      bf16_t* orow = P1T + (size_t)(3072 + k) * L;
asm volatile("" : "+v"(tid));
#pragma unroll
      for (int j = 0; j < 32; ++j) { if ((j & 15) == 0) __builtin_amdgcn_sched_barrier(0); const int n = j * 512 + tid; const int p = (int)(__brev((unsigned)n) >> 18); orow[n] = (bf16_t)f2bf(cb[PADI(p)].x * bf2f(gt[n])); }
      __syncthreads();
    }
  }
#if HY_MFMA
  __syncthreads();
  hyena_mfma_items(a, lds, tid);
#endif
}

__device__ __forceinline__ void transpose_phase(const bf16_t* __restrict__ P1T, bf16_t* __restrict__ MIX, char* lds, int tid) {
  bf16_t* tl = (bf16_t*)lds;
  for (int item = blockIdx.x; item < 16 * 256; item += gridDim.x) {
    const int ct = item & 15, tt = item >> 4, c0 = ct * 64, t0 = tt * 64;
    { const int ch = tid >> 3, tq = (tid & 7) * 8; const int srow = (c0 + ch) < 768 ? (c0 + ch) : (3072 + c0 + ch - 768);
      *(u32x4*)(tl + ch * 72 + tq) = *(const u32x4*)(P1T + (size_t)srow * L + t0 + tq); }
    __syncthreads();
    { const int tok = tid >> 3, cq = (tid & 7) * 8; unsigned short v[8];
#pragma unroll
      for (int e = 0; e < 8; ++e) v[e] = tl[(cq + e) * 72 + tok];
      u32x4 w; w.x = v[0] | ((unsigned)v[1] << 16); w.y = v[2] | ((unsigned)v[3] << 16); w.z = v[4] | ((unsigned)v[5] << 16); w.w = v[6] | ((unsigned)v[7] << 16);
      *(u32x4*)(MIX + (size_t)(t0 + tok) * 1024 + c0 + cq) = w; }
    __syncthreads();
  }
}

__device__ __forceinline__ void ht_phase(const bf16_t* __restrict__ W3T, const bf16_t* __restrict__ HD2, bf16_t* __restrict__ HT, int tid) {
  typedef short bf16x8 __attribute__((ext_vector_type(8)));
  typedef float f32x16 __attribute__((ext_vector_type(16)));
  const int lane = tid & 63, wid = tid >> 6, r32 = lane & 31, hi = lane >> 5;
  for (int item = blockIdx.x; item < 96 * 8; item += gridDim.x) {
    const int rb = item >> 3, tc = item & 7;
    bf16x8 af[4];
#pragma unroll
    for (int ks = 0; ks < 4; ++ks) af[ks] = *(const bf16x8*)(W3T + (size_t)(rb * 32 + r32) * 64 + ks * 16 + hi * 8);
#pragma unroll 2
    for (int tt = 0; tt < 8; ++tt) {
      const int t0 = tc * 2048 + wid * 256 + tt * 32;
      f32x16 acc = {};
#pragma unroll
      for (int ks = 0; ks < 4; ++ks) { const bf16x8 bfr = *(const bf16x8*)(HD2 + (size_t)(t0 + r32) * 64 + ks * 16 + hi * 8);
        acc = __builtin_amdgcn_mfma_f32_32x32x16_bf16(af[ks], bfr, acc, 0, 0, 0); }
#pragma unroll
      for (int r = 0; r < 16; ++r) { const int row = rb * 32 + (r & 3) + 8 * (r >> 2) + 4 * hi; HT[(size_t)row * L + t0 + r32] = (bf16_t)f2bf(acc[r]); }
    }
  }
}
#define LAS __attribute__((address_space(3)))
#define XB_TMO      128
#define XB_XCNT(j)  (256  + 64 * (j))
#define XB_XSUB(j)  (1280 + 64 * (j))
#define XB_XGEN(j)  (2304 + 64 * (j))
#define XB_TOP      3328
#define XB_TOPGEN   3392
#define XCD_BAR_WORDS 3456
#define XB_SPIN_CAP (1u << 18)

__device__ __forceinline__ unsigned xb_ld(unsigned* p)              { return __hip_atomic_load(p, __ATOMIC_RELAXED, __HIP_MEMORY_SCOPE_AGENT); }
__device__ __forceinline__ unsigned xb_add(unsigned* p, unsigned v) { return __hip_atomic_fetch_add(p, v, __ATOMIC_RELAXED, __HIP_MEMORY_SCOPE_AGENT); }
__device__ __forceinline__ unsigned xb_xcc_id() { return (unsigned)__builtin_amdgcn_s_getreg((3 << 11) | 20) & 0xFu; }
#define XB_SPIN(cond, bar) do { unsigned _sp = 0; while (cond) { __builtin_amdgcn_s_sleep(1); \
    if ((++_sp & 255u) == 0u) { if (xb_ld(&(bar)[XB_TMO])) break; if (_sp > XB_SPIN_CAP) { atomicAdd(&(bar)[XB_TMO], 1u); break; } } } } while (0)

struct XcdBarrier {
    unsigned* bar; unsigned x;
    volatile LAS unsigned* st;
};

__device__ __forceinline__ XcdBarrier xcd_barrier_post(unsigned* bar, volatile LAS unsigned* st, bool tid0) {
    XcdBarrier b; b.bar = bar; b.x = xb_xcc_id(); b.st = st;
    if (tid0) (void)xb_add(&bar[XB_XCNT(b.x)], 1u);
    return b;
}
__device__ __forceinline__ void xcd_barrier_complete(unsigned* bar, unsigned x, unsigned& nloc, unsigned& nx) {
    const unsigned G = gridDim.x * gridDim.y * gridDim.z;
    unsigned sum, cnt, mine, sp = 0u;
    for (;;) {
        sum = 0u; cnt = 0u; mine = 0u;
#pragma unroll
        for (unsigned j = 0; j < 16; ++j) { const unsigned c = xb_ld(&bar[XB_XCNT(j)]); sum += c; cnt += (c > 0u) ? 1u : 0u; mine = (j == x) ? c : mine; }
        if (sum == G) break;
        __builtin_amdgcn_s_sleep(1);
        if ((++sp & 255u) == 0u) { if (xb_ld(&bar[XB_TMO])) break; if (sp > XB_SPIN_CAP) { atomicAdd(&bar[XB_TMO], 1u); break; } }
    }
    nloc = mine > 0u ? mine : 1u; nx = cnt > 0u ? cnt : 1u;
}

__device__ __forceinline__ void xcd_barrier(const XcdBarrier& b, bool tid0) {
    asm volatile("s_waitcnt vmcnt(0)" ::: "memory");
    __syncthreads();
    if (tid0) {
        unsigned* bar = b.bar;
        __builtin_amdgcn_s_waitcnt(0);
        unsigned nloc = b.st[0], nx = b.st[1];
        if (nloc == 0u) { xcd_barrier_complete(bar, b.x, nloc, nx); b.st[0] = nloc; b.st[1] = nx; }
        const unsigned old = xb_add(&bar[XB_XSUB(b.x)], 1u);
        const unsigned gen = old / nloc;
        if (old + 1u == (gen + 1u) * nloc) {
            __builtin_amdgcn_fence(__ATOMIC_RELEASE, "agent");
            asm volatile("s_waitcnt vmcnt(0)" ::: "memory");
            const unsigned og = xb_add(&bar[XB_TOP], 1u);
            const unsigned tg = og / nx;
            if (og + 1u == (tg + 1u) * nx) xb_add(&bar[XB_TOPGEN], 1u);
            else XB_SPIN(xb_ld(&bar[XB_TOPGEN]) == tg, bar);
            __builtin_amdgcn_fence(__ATOMIC_ACQUIRE, "agent");
            xb_add(&bar[XB_XGEN(b.x)], 1u);
            asm volatile("s_waitcnt vmcnt(0)" ::: "memory");
        } else {
            XB_SPIN(xb_ld(&bar[XB_XGEN(b.x)]) == gen, bar);
            __builtin_amdgcn_fence(__ATOMIC_ACQUIRE, "agent");
            asm volatile("s_waitcnt vmcnt(0)" ::: "memory");
        }
    }
    __syncthreads();
}
__device__ __forceinline__ int lane_id_opaque() {
  int l; asm volatile("v_mbcnt_lo_u32_b32 %0, -1, 0\n\tv_mbcnt_hi_u32_b32 %0, -1, %0" : "=v"(l)); return l;
}
__global__ void __launch_bounds__(512, 2) mega_fwd(Args a) {
  extern __shared__ __attribute__((aligned(16))) unsigned char lds_raw[];
  const int wid_s = __builtin_amdgcn_readfirstlane((int)threadIdx.x >> 6);
#define MK_TID() (wid_s * 64 + lane_id_opaque())
  int tid;
  unsigned char* ws = a.ws;
  PG8_LAS unsigned char* ldsl = (PG8_LAS unsigned char*)lds_raw;
  float* xs = (float*)(lds_raw + XS_OFF);
  const float* MOD = (const float*)(ws + WS_MOD);
  const int lo = a.ph_lo, hi = a.ph_hi, G = gridDim.x, bc = blockIdx.x;
#ifndef MK_FUSE_NORM
#define MK_FUSE_NORM 0
#endif
  const bool fuse = MK_FUSE_NORM && (G == 256) && !MK_MULTI;
#ifndef PH_MASK
#define PH_MASK 0xFFF
#endif
#define IN(k) ((((PH_MASK) >> (k)) & 1) && lo <= (k) && (k) < hi)
#ifndef DBL_MASK
#define DBL_MASK 0
#endif
#define NREP(k) ((((DBL_MASK) >> (k)) & 1) ? 2 : 1)
  volatile LAS unsigned* xst = (volatile LAS unsigned*)((LAS unsigned char*)lds_raw + 155000);
  if (MK_TID() == 0) { xst[0] = 0u; xst[1] = 0u; }
  __syncthreads();
  XcdBarrier xbar = xcd_barrier_post((unsigned*)(ws + WS_BAR), xst, MK_TID() == 0);
  if (a.ph_hi < 0) cg::this_grid().sync();
#define SEAM(k) do { if (IN(k) && IN((k) + 1)) xcd_barrier(xbar, MK_TID() == 0); } while (0)
  if (IN(0)) for (int rep = 0; rep < NREP(0); ++rep) { tid = MK_TID(); asm volatile("" : "+v"(tid)); p0_prep(a, (float*)lds_raw, tid); } SEAM(0);
  if (IN(1)) for (int rep = 0; rep < NREP(1); ++rep) { tid = MK_TID(); asm volatile("" : "+v"(tid)); rows_norm_mod(a.in[0], a.in[2], CTX, LK, a.in[6], MOD, MOD + 3072, (bf16_t*)(ws + WS_H), tid); } SEAM(1);
  if (IN(2)) for (int rep = 0; rep < NREP(2); ++rep) { tid = MK_TID(); asm volatile("" : "+v"(tid));
    pg8::Gemm g; g.A = (const bf16_t*)(ws + WS_H); g.Bt = (const bf16_t*)(ws + WS_WIN0); g.M = LK; g.N = 2560; g.K = 1024;
    pg8::SchedIn0 S; S.G = G; S.c = bc;
    pg8::EpiIn0 E; E.AV = (float*)(ws + WS_AV); E.AG = (bf16_t*)(ws + WS_AG); E.Q = (bf16_t*)(ws + WS_Q); E.K = (bf16_t*)(ws + WS_K); E.V = (bf16_t*)(ws + WS_V); E.BG = (bf16_t*)(ws + WS_BG);
    E.qg = a.in[11]; E.kg = a.in[12]; E.rope = (const float2*)(ws + WS_ROPE); E.xs = xs;
    pg8::gemm_phase<pg8::EpiIn0, pg8::SchedIn0, true, false>(ldsl, g, S, E, tid);
    tid = MK_TID(); asm volatile("" : "+v"(tid));
    prep_queue(a, (unsigned*)(ws + WS_CNT) + 388 + rep, (volatile unsigned*)(lds_raw + 154000), (float*)lds_raw, tid);
  } SEAM(2);
  if (IN(3)) for (int rep = 0; rep < NREP(3); ++rep) { tid = MK_TID(); asm volatile("" : "+v"(tid));
    if (G == 256) {
      const int vb = ((bc & 7) >> 2) * 128 + (bc >> 3) * 4 + (bc & 3);
      const int kvh = vb >> 7, pk = (vb & 127) >> 1, side = vb & 1, cidx = vb >> 1;
      { const int w = 3 * pk + side, h = kvh * 3 + (w % 3), qb = w / 3;
        __syncthreads();
        attn::attn_dense_body<false>((const attn::bf16*)(ws + WS_Q) + (size_t)qb * 256 * 768 + h * 128, (const attn::bf16*)(ws + WS_K) + (size_t)kvh * LK * 128, (const attn::bf16*)(ws + WS_V) + (size_t)kvh * LK * 128,
                              (const bf16_t*)(ws + WS_BG) + (size_t)qb * 256 * 768 + h * 128, (bf16_t*)(ws + WS_H) + (size_t)qb * 256 * 1024 + 256 + h * 128, LK, (char*)lds_raw, nullptr, nullptr, nullptr, MK_TID()); }
      { const int w = 3 * pk + 2, h = kvh * 3 + (w % 3), qb = w / 3; const size_t koff = (size_t)side * (LK / 2) * 128;
        float* pbase = (float*)(ws + WS_PARTIAL) + (size_t)cidx * 2 * PARTIAL_FLOATS;
        __syncthreads();
        attn::attn_dense_body<true>((const attn::bf16*)(ws + WS_Q) + (size_t)qb * 256 * 768 + h * 128, (const attn::bf16*)(ws + WS_K) + koff + (size_t)kvh * LK * 128, (const attn::bf16*)(ws + WS_V) + koff + (size_t)kvh * LK * 128,
                              (const bf16_t*)(ws + WS_BG) + (size_t)qb * 256 * 768 + h * 128, (bf16_t*)(ws + WS_H) + (size_t)qb * 256 * 1024 + 256 + h * 128, LK / 2, (char*)lds_raw,
                              pbase + (size_t)side * PARTIAL_FLOATS, pbase + (size_t)(side ^ 1) * PARTIAL_FLOATS, (unsigned*)(ws + WS_CNT) + cidx, MK_TID()); }
    } else {
      for (int item = bc; item < 384; item += G) {
        const int h = item % 6, qb = item / 6, kvh = h / 3;
        __syncthreads();
        attn::attn_dense_body<false>((const attn::bf16*)(ws + WS_Q) + (size_t)qb * 256 * 768 + h * 128, (const attn::bf16*)(ws + WS_K) + (size_t)kvh * LK * 128, (const attn::bf16*)(ws + WS_V) + (size_t)kvh * LK * 128,
                              (const bf16_t*)(ws + WS_BG) + (size_t)qb * 256 * 768 + h * 128, (bf16_t*)(ws + WS_H) + (size_t)qb * 256 * 1024 + 256 + h * 128, LK, (char*)lds_raw, nullptr, nullptr, nullptr, MK_TID());
      }
    }
    tid = MK_TID(); asm volatile("" : "+v"(tid));
    pool_phase((const float*)(ws + WS_AV), (const bf16_t*)(ws + WS_AG), (bf16_t*)(ws + WS_H), (unsigned*)(ws + WS_CNT) + 384 + rep, (volatile unsigned*)(lds_raw + 70000), tid);
  } SEAM(3);
  if (IN(4)) for (int rep = 0; rep < NREP(4); ++rep) { tid = MK_TID(); asm volatile("" : "+v"(tid));
    pg8::Gemm g; g.A = (const bf16_t*)(ws + WS_H); g.Bt = (const bf16_t*)(ws + WS_WOUT0); g.M = L; g.N = 1024; g.K = 1024;
    pg8::SchedRow S; S.nN = 4; S.total = 256; S.G = G; S.c = bc;
    if (fuse) { pg8::EpiResNorm<2> E; E.base = a.in[0]; E.out = a.out; E.gate = MOD + 2048; E.g = a.in[6] + 1024; E.mod = MOD + 2 * 3072; E.H = (bf16_t*)(ws + WS_H2);
      E.psq = (float*)(ws + WS_PART); E.cnt = (unsigned*)(ws + WS_CNT) + 256; E.xs = xs;
      pg8::gemm_phase<pg8::EpiResNorm<2>, pg8::SchedRow, true, false>(ldsl, g, S, E, tid); }
    else { pg8::EpiRes E; E.base = a.in[0]; E.out = a.out; E.gate = MOD + 2048;
      pg8::gemm_phase<pg8::EpiRes, pg8::SchedRow, true, false>(ldsl, g, S, E, tid); }
  } SEAM(4);
  if (IN(5)) for (int rep = 0; rep < NREP(5); ++rep) { tid = MK_TID(); asm volatile("" : "+v"(tid)); if (!fuse) rows_norm_mod(a.out, a.out, 0, L, a.in[6] + 1024, MOD + 2 * 3072, MOD + 2 * 3072, (bf16_t*)(ws + WS_H2), tid); } SEAM(5);
  if (IN(6)) for (int rep = 0; rep < NREP(6); ++rep) { tid = MK_TID(); asm volatile("" : "+v"(tid));
    pg8::Gemm g; g.A = (const bf16_t*)(ws + WS_WIN1); g.Bt = (const bf16_t*)(ws + WS_H2); g.M = 3840; g.N = L; g.K = 1024;
    pg8::SchedCol S; S.nM = 15; S.total = 15 * 64; S.G = G; S.c = bc;
    pg8::EpiT E; E.O = (bf16_t*)(ws + WS_P1T); E.gated = 1;
    pg8::gemm_phase<pg8::EpiT, pg8::SchedCol, true, false>(ldsl, g, S, E, tid);
  } SEAM(6);
  if (IN(7)) for (int rep = 0; rep < NREP(7); ++rep) { tid = MK_TID(); asm volatile("" : "+v"(tid));
    ht_phase((const bf16_t*)(ws + WS_W3T), (const bf16_t*)(ws + WS_HD2B), (bf16_t*)(ws + WS_HT), tid);
  } SEAM(7);
  if (IN(8)) for (int rep = 0; rep < NREP(8); ++rep) { tid = MK_TID(); asm volatile("" : "+v"(tid)); hyena_fourier_phase(a, (char*)lds_raw, tid); } SEAM(8);
  if (IN(9)) for (int rep = 0; rep < NREP(9); ++rep) { tid = MK_TID(); asm volatile("" : "+v"(tid)); transpose_phase((const bf16_t*)(ws + WS_P1T), (bf16_t*)(ws + WS_H), (char*)lds_raw, tid); } SEAM(9);
  if (IN(10)) for (int rep = 0; rep < NREP(10); ++rep) { tid = MK_TID(); asm volatile("" : "+v"(tid));
    pg8::Gemm g; g.A = (const bf16_t*)(ws + WS_H); g.Bt = (const bf16_t*)(ws + WS_WOUT1); g.M = L; g.N = 1024; g.K = 1024;
    pg8::SchedRow S; S.nN = 4; S.total = 256; S.G = G; S.c = bc;
    if (fuse) { pg8::EpiResNorm<1> E; E.base = a.out; E.out = a.out; E.gate = MOD + 2 * 3072 + 2048; E.g = a.in[25]; E.mod = MOD; E.H = nullptr;
      E.psq = (float*)(ws + WS_PART) + 65536; E.cnt = (unsigned*)(ws + WS_CNT) + 320; E.xs = xs;
      pg8::gemm_phase<pg8::EpiResNorm<1>, pg8::SchedRow, true, false>(ldsl, g, S, E, tid); }
    else { pg8::EpiRes E; E.base = a.out; E.out = a.out; E.gate = MOD + 2 * 3072 + 2048;
      pg8::gemm_phase<pg8::EpiRes, pg8::SchedRow, true, false>(ldsl, g, S, E, tid); }
  } SEAM(10);
  if (IN(11)) for (int rep = 0; rep < NREP(11); ++rep) { tid = MK_TID(); asm volatile("" : "+v"(tid)); if (!fuse) rows_final(a.out, a.in[25], tid); }
#undef IN
#undef SEAM
}

extern "C" void kernel_launch(void* const* d_in, const int* in_sizes, int n_in, void* d_out, int out_size, void* d_ws, size_t ws_size, hipStream_t stream) {
  static int grid = 0;
  if (grid == 0) {
    if (n_in != 26 || in_sizes[0] != L * DM || out_size != L * DM || ws_size < WS_END) {
      fprintf(stderr, "kernel_launch: unexpected shapes: n_in %d in0 %d out %d ws %zu (need >= %zu)\n", n_in, n_in > 0 ? in_sizes[0] : -1, out_size, ws_size, (size_t)WS_END); grid = -1; return; }
    int dev = 0, cus = 0, per_cu = 0;
    if (hipGetDevice(&dev) != hipSuccess || hipDeviceGetAttribute(&cus, hipDeviceAttributeMultiprocessorCount, dev) != hipSuccess) { fprintf(stderr, "kernel_launch: device query failed\n"); grid = -1; return; }
    if (hipFuncSetAttribute((const void*)mega_fwd, hipFuncAttributeMaxDynamicSharedMemorySize, LDS_BYTES) != hipSuccess) { fprintf(stderr, "kernel_launch: hipFuncSetAttribute failed\n"); grid = -1; return; }
    if (hipOccupancyMaxActiveBlocksPerMultiprocessor(&per_cu, (const void*)mega_fwd, 512, LDS_BYTES) != hipSuccess || per_cu < 1) { fprintf(stderr, "kernel_launch: occupancy query says %d\n", per_cu); per_cu = 1; }
    (void)hipGetLastError();
    grid = cus * per_cu;
    fprintf(stderr, "kernel_launch: grid %d (cus %d x %d)\n", grid, cus, per_cu);
  }
  if (grid < 0) return;
  if (hipMemsetAsync((unsigned char*)d_ws + WS_BAR, 0, 16384, stream) != hipSuccess) { fprintf(stderr, "kernel_launch: memset failed\n"); return; }
  Args a{};
  for (int i = 0; i < 26; ++i) a.in[i] = (const float*)d_in[i];
  a.out = (float*)d_out; a.ws = (unsigned char*)d_ws;
#if MK_MULTI
  for (int ph = 0; ph < NPH; ++ph) { a.ph_lo = ph; a.ph_hi = ph + 1; hipLaunchKernelGGL(mega_fwd, dim3(grid), dim3(512), LDS_BYTES, stream, a); }
#else
  a.ph_lo = 0; a.ph_hi = NPH;
  void* args[] = {&a};
  hipError_t e = hipLaunchCooperativeKernel((const void*)mega_fwd, dim3(grid), dim3(512), args, LDS_BYTES, stream);
  if (e != hipSuccess) fprintf(stderr, "kernel_launch: cooperative launch failed: %s (grid %d)\n", hipGetErrorString(e), grid);
#endif
}
```

```cpp
#include <hip/hip_runtime.h>
#include <hip/hip_bf16.h>
#include <hip/hip_cooperative_groups.h>
#include <cstdio>
#include <cstdint>
namespace cg = cooperative_groups;

#ifndef MK_FUSE_NORM
#define MK_FUSE_NORM 0
#endif
#ifndef MK_MULTI
#define MK_MULTI 0
#endif

constexpr int L = 16384, DM = 1024, CTX = 256, LK = L + CTX;
constexpr int NPH = 12;
constexpr float EPS = 1e-6f;
constexpr size_t MiB = (size_t)1 << 20, KiB = 1024;
constexpr size_t WS_MOD = 0, WS_ROPE = 64 * KiB, WS_TW2 = 128 * KiB, WS_T = 256 * KiB, WS_PART = 768 * KiB;
constexpr size_t WS_WIN0 = 2 * MiB, WS_WOUT0 = 7 * MiB, WS_WIN1 = 9 * MiB, WS_WOUT1 = 17 * MiB, WS_W3T = 19 * MiB, WS_HD2B = 21 * MiB;
constexpr size_t WS_H = 30 * MiB, WS_AV = 63 * MiB, WS_AG = 79 * MiB, WS_Q = 87 * MiB, WS_K = 111 * MiB, WS_V = 120 * MiB, WS_BG = 129 * MiB;
constexpr size_t WS_BAR = 1600 * KiB; constexpr size_t WS_CNT = 1536 * KiB, WS_PARTIAL = 160 * MiB; constexpr size_t PARTIAL_FLOATS = 256 * 128 + 512;
constexpr size_t WS_H2 = MK_FUSE_NORM ? 63 * MiB : 30 * MiB;
constexpr size_t WS_P1T = 136 * MiB, WS_HT = 30 * MiB, WS_END = 256 * MiB;
constexpr int LDS_BYTES = 155648;
constexpr int XS_OFF = 131072;

typedef unsigned short bf16_t;
typedef float f32x4 __attribute__((ext_vector_type(4)));
typedef unsigned u32x4 __attribute__((ext_vector_type(4)));
typedef unsigned u32x2 __attribute__((ext_vector_type(2)));

struct Args { const float* in[26]; float* out; unsigned char* ws; int ph_lo, ph_hi; };

__device__ __forceinline__ float bf2f(bf16_t v) { return __uint_as_float((unsigned)v << 16); }
__device__ __forceinline__ unsigned f2bf(float f) { unsigned u = __float_as_uint(f); return (u + 0x7fffu + ((u >> 16) & 1u)) >> 16; }
__device__ __forceinline__ unsigned pk2(float lo, float hi) { return f2bf(lo) | (f2bf(hi) << 16); }
__device__ __forceinline__ float siluf(float v) { return v / (1.f + __expf(-v)); }
__device__ __forceinline__ float wave_sum(float v) {
#pragma unroll
  for (int o = 32; o >= 1; o >>= 1) v += __shfl_xor(v, o);
  return v;
}

__device__ __forceinline__ int qk_srccol(int j) {
  if (j < 512 || j >= 1536) return j;
  const int base = j & ~127, p = j & 127, g = p >> 3, e = p & 7;
  const int axis = g >> 3, f = 4 * (g & 7) + (e & 3), half = e >> 2;
  return base + axis * 64 + half * 32 + f;
}
template <int MODE>
__device__ __forceinline__ void wt_tile(const float* __restrict__ src, int ldn, int off, bf16_t* __restrict__ dst, int j0, int k0, float* tl, int tid) {
  const int cc = tid & 63, r0 = tid >> 6;
  const int sc = (MODE == 1) ? qk_srccol(j0 + cc) : (off + j0 + cc);
#pragma unroll
  for (int i = 0; i < 8; ++i) { const int r = r0 + 8 * i; tl[r * 65 + cc] = src[(size_t)(k0 + r) * ldn + sc]; }
  __syncthreads();
  const int n = tid >> 3, kq = (tid & 7) * 8;
  u32x4 w;
  w.x = pk2(tl[(kq + 0) * 65 + n], tl[(kq + 1) * 65 + n]); w.y = pk2(tl[(kq + 2) * 65 + n], tl[(kq + 3) * 65 + n]);
  w.z = pk2(tl[(kq + 4) * 65 + n], tl[(kq + 5) * 65 + n]); w.w = pk2(tl[(kq + 6) * 65 + n], tl[(kq + 7) * 65 + n]);
  *(u32x4*)(dst + (size_t)(j0 + n) * 1024 + k0 + kq) = w;
  __syncthreads();
}
template <int MODE>
__device__ __forceinline__ void wt_quad(const float* __restrict__ src, int ldn, int off, bf16_t* __restrict__ dst, int j0, int k0, float* tl, int tid) {
  const int cc = tid & 63, r0 = tid >> 6;
  const int sc = (MODE == 1) ? qk_srccol(j0 + cc) : (off + j0 + cc);
  float v[32];
#pragma unroll
  for (int i = 0; i < 32; ++i) v[i] = src[(size_t)(k0 + r0 + 8 * i) * ldn + sc];
#pragma unroll
  for (int i = 0; i < 32; ++i) tl[(r0 + 8 * i) * 65 + cc] = v[i];
  __syncthreads();
  const int n = tid >> 3, kq = (tid & 7) * 8;
#pragma unroll
  for (int s = 0; s < 4; ++s) { const float* t = tl + (s * 64 + kq) * 65 + n; u32x4 w;
    w.x = pk2(t[0], t[65]); w.y = pk2(t[130], t[195]); w.z = pk2(t[260], t[325]); w.w = pk2(t[390], t[455]);
    *(u32x4*)(dst + (size_t)(j0 + n) * 1024 + k0 + s * 64 + kq) = w; }
  __syncthreads();
}
__device__ __forceinline__ void wt_pool_tile(const float* __restrict__ src, const float* __restrict__ pw, const float* __restrict__ pscale, bf16_t* __restrict__ dst, int j0, int k0, float* lds, int tid) {
  float* A = lds; float* Bm = lds + 64 * 65; float* tl = lds + 2 * 64 * 65;
  const int cc = tid & 63, r0 = tid >> 6, g = j0 >> 6;
#pragma unroll
  for (int i = 0; i < 8; ++i) { const int r = r0 + 8 * i; A[r * 65 + cc] = src[(size_t)(k0 + r) * 2560 + g * 64 + cc]; Bm[r * 65 + cc] = pw[(g * 64 + r) * 64 + cc]; }
  __syncthreads();
  const float sc = pscale[j0 + cc];
#pragma unroll
  for (int i = 0; i < 8; ++i) { const int r = r0 + 8 * i; float s = 0.f;
    for (int q = 0; q < 64; ++q) s += A[r * 65 + q] * Bm[q * 65 + cc];
    tl[r * 65 + cc] = s * sc; }
  __syncthreads();
  const int n = tid >> 3, kq = (tid & 7) * 8;
  u32x4 w;
  w.x = pk2(tl[(kq + 0) * 65 + n], tl[(kq + 1) * 65 + n]); w.y = pk2(tl[(kq + 2) * 65 + n], tl[(kq + 3) * 65 + n]);
  w.z = pk2(tl[(kq + 4) * 65 + n], tl[(kq + 5) * 65 + n]); w.w = pk2(tl[(kq + 6) * 65 + n], tl[(kq + 7) * 65 + n]);
  *(u32x4*)(dst + (size_t)(j0 + n) * 1024 + k0 + kq) = w;
  __syncthreads();
}

namespace prep {
constexpr int N_MOD = 192, N_WIN0 = 208, N_WOUT = 64, N_WIN1A = 192, N_WIN1B = 16, N_T = 256, N_HD2 = 256, N_W3T = 48, N_ROPE = 16, N_TW2 = 32;
constexpr int O_WIN0 = N_MOD, O_WOUT0 = O_WIN0 + N_WIN0, O_WOUT1 = O_WOUT0 + N_WOUT, O_WIN1A = O_WOUT1 + N_WOUT, O_WIN1B = O_WIN1A + N_WIN1A,
                O_T = O_WIN1B + N_WIN1B, O_HD2 = O_T + N_T, O_W3T = O_HD2 + N_HD2, O_ROPE = O_W3T + N_W3T, O_TW2 = O_ROPE + N_ROPE, O_END = O_TW2 + N_TW2;
constexpr int N_EARLY = O_WOUT1 + N_T + N_ROPE + N_TW2, N_LATE = (O_T - O_WOUT1) + (O_ROPE - O_HD2);
__host__ __device__ constexpr int early_item(int e) { return e < O_WOUT1 ? e : (e < O_WOUT1 + N_T ? O_T + (e - O_WOUT1) : O_ROPE + (e - O_WOUT1 - N_T)); }
__host__ __device__ constexpr int late_item(int q) { return q < O_T - O_WOUT1 ? O_WOUT1 + q : O_HD2 + (q - (O_T - O_WOUT1)); }
}
__device__ __forceinline__ void prep_item(const Args& a, int item, float* lds, int tid) {
  using namespace prep;
  unsigned char* ws = a.ws;
  {
    asm volatile("" : "+v"(tid));
    if (item < O_WIN0) {
      const int layer = item / 96, chunk = item % 96, col = chunk * 32 + (tid & 31), rg = tid >> 5;
      const float* wm = a.in[4] + (size_t)layer * 1024 * 3072; const float* cv = a.in[1]; const float* cc = a.in[3];
      float s0 = 0.f, s1 = 0.f;
      for (int r = rg; r < 1024; r += 16) { const float w = wm[(size_t)r * 3072 + col]; s0 += siluf(cv[r]) * w; if (layer == 0) s1 += siluf(cc[r]) * w; }
      lds[tid] = s0; lds[512 + tid] = s1; __syncthreads();
      if (tid < 32) { float t0 = 0.f, t1 = 0.f; for (int q = 0; q < 16; ++q) { t0 += lds[q * 32 + tid]; t1 += lds[512 + q * 32 + tid]; }
        const float bm = a.in[5][layer * 3072 + col]; float* MOD = (float*)(ws + WS_MOD);
        if (layer == 0) { MOD[col] = t0 + bm; MOD[3072 + col] = t1 + bm; } else MOD[2 * 3072 + col] = t0 + bm; }
      __syncthreads();
    } else if (item < O_WOUT0) {
      const int ti = item - O_WIN0;
      if (ti < 64) wt_pool_tile(a.in[7], a.in[9], a.in[10], (bf16_t*)(ws + WS_WIN0), (ti / 16) * 64, (ti % 16) * 64, lds, tid);
      else { const int tq = ti - 64; wt_quad<1>(a.in[7], 2560, 0, (bf16_t*)(ws + WS_WIN0), (4 + tq / 4) * 64, (tq % 4) * 256, lds, tid); }
    } else if (item < O_WOUT1) { const int ti = item - O_WOUT0; wt_quad<0>(a.in[8], 1024, 0, (bf16_t*)(ws + WS_WOUT0), (ti / 4) * 64, (ti % 4) * 256, lds, tid);
    } else if (item < O_WIN1A) { const int ti = item - O_WOUT1; wt_quad<0>(a.in[14], 1024, 0, (bf16_t*)(ws + WS_WOUT1), (ti / 4) * 64, (ti % 4) * 256, lds, tid);
    } else if (item < O_WIN1B) { const int ti = item - O_WIN1A; wt_quad<0>(a.in[13], 3584, 0, (bf16_t*)(ws + WS_WIN1), (ti / 4) * 64, (ti % 4) * 256, lds, tid);
    } else if (item < O_T) {     const int ti = item - O_WIN1B; wt_quad<0>(a.in[13], 3584, 3328 - 3584, (bf16_t*)(ws + WS_WIN1), 3584 + (ti / 4) * 64, (ti % 4) * 256, lds, tid);
    } else if (item < O_HD2) {
      const int i = item - O_T;
      if (tid < 256) lds[tid] = cospif((float)tid / 128.f);
      __syncthreads();
      const int n = tid & 255, part = tid >> 8; const float* fw = a.in[24];
      float s = 0.f;
      for (int j = 0; j < 256; ++j) { const int m = (i * j) & 255; const float tr = part ? lds[(m - 64) & 255] : lds[m]; s += tr * fw[j * 256 + n]; }
      ((float*)(ws + WS_T))[(part * 256 + i) * 256 + n] = (part ? -s : s) * (1.f / 2048.f);
      __syncthreads();
    } else if (item < O_W3T) {
      const int t0 = (item - O_HD2) * 64;
      float* e = lds; float* h1 = lds + 64 * 34;
      for (int idx = tid; idx < 64 * 33; idx += 512) { const int tl = idx / 33, q = idx % 33, t = t0 + tl; float v;
        if (q == 0) v = (float)t / 16383.f;
        else { const int b = (q - 1) & 15; const float f = 1e-4f + (float)b * ((15.f - 1e-4f) / 15.f); const float w = 6.2831855f * (float)t / 16384.f; const float ar = f * w;
          v = (q <= 16) ? cosf(ar) : -sinf(ar); }
        e[tl * 34 + q] = v; }
      __syncthreads();
      const int j = tid & 63, r0 = tid >> 6; const float fr = a.in[22][j];
#pragma unroll
      for (int i = 0; i < 8; ++i) { const int tl = r0 + 8 * i; float s = a.in[18][j];
        for (int q = 0; q < 33; ++q) s += e[tl * 34 + q] * a.in[17][q * 64 + j];
        h1[tl * 65 + j] = sinf(fr * s); }
      __syncthreads();
      bf16_t* HD = (bf16_t*)(ws + WS_HD2B);
#pragma unroll
      for (int i = 0; i < 8; ++i) { const int tl = r0 + 8 * i; float s = a.in[20][j];
        for (int q = 0; q < 64; ++q) s += h1[tl * 65 + q] * a.in[19][q * 64 + j];
        HD[(size_t)(t0 + tl) * 64 + j] = (bf16_t)f2bf(sinf(fr * s)); }
      __syncthreads();
    } else if (item < O_ROPE) {
      const int row = (item - O_W3T) * 64 + (tid >> 3), kg = (tid & 7) * 8; u32x4 w = {0u, 0u, 0u, 0u};
      { const float* w3 = a.in[21]; float v[8];
#pragma unroll
        for (int q = 0; q < 8; ++q) v[q] = w3[(size_t)(kg + q) * 3072 + row];
        w.x = pk2(v[0], v[1]); w.y = pk2(v[2], v[3]); w.z = pk2(v[4], v[5]); w.w = pk2(v[6], v[7]); }
      *(u32x4*)((bf16_t*)(ws + WS_W3T) + (size_t)row * 64 + kg) = w;
    } else if (item < O_TW2) {
      const int idx = (item - O_ROPE) * 512 + tid, pos = idx >> 5, f = idx & 31;
      const float inv = powf(10000.f, -(float)f / 32.f), ang = (float)pos * inv;
      ((float2*)(ws + WS_ROPE))[idx] = make_float2(cosf(ang), sinf(ang));
    } else {
      if (item == O_TW2 && tid < 392) ((unsigned*)(ws + WS_CNT))[tid] = 0u;
      const int n = (item - O_TW2) * 512 + tid; float s, c; sincospif((float)n / 16384.f, &s, &c);
      ((float2*)(ws + WS_TW2))[n] = make_float2(c, -s);
    }
  }
}
__device__ __forceinline__ void p0_prep(const Args& a, float* lds, int tid) {
  for (int e = blockIdx.x; e < prep::N_EARLY; e += gridDim.x) prep_item(a, prep::early_item(e), lds, tid);
}

__device__ __forceinline__ void rows_norm_mod(const float* __restrict__ X, const float* __restrict__ C, int nctx, int nrows, const float* __restrict__ g,
                                              const float* __restrict__ modx, const float* __restrict__ modc, bf16_t* __restrict__ H, int tid) {
  const int lane = tid & 63, wid = tid >> 6;
  for (int row = blockIdx.x * 8 + wid; row < nrows; row += gridDim.x * 8) {
    const float* src = row < nctx ? C + (size_t)row * 1024 : X + (size_t)(row - nctx) * 1024; const float* md = row < nctx ? modc : modx;
    f32x4 v[4]; float ss = 0.f;
#pragma unroll
    for (int i = 0; i < 4; ++i) { v[i] = *(const f32x4*)(src + (lane + 64 * i) * 4); ss += v[i].x * v[i].x + v[i].y * v[i].y + v[i].z * v[i].z + v[i].w * v[i].w; }
    ss = wave_sum(ss); const float rinv = rsqrtf(ss * (1.f / 1024.f) + EPS);
#pragma unroll
    for (int i = 0; i < 4; ++i) { const int c = (lane + 64 * i) * 4; const f32x4 gg = *(const f32x4*)(g + c), sh = *(const f32x4*)(md + c), sc = *(const f32x4*)(md + 1024 + c);
      const f32x4 y = v[i] * rinv * gg * (sc + 1.f) + sh;
      u32x2 w; w.x = pk2(y.x, y.y); w.y = pk2(y.z, y.w); *(u32x2*)(H + (size_t)row * 1024 + c) = w; }
  }
}
__device__ __forceinline__ void rows_final(float* __restrict__ X, const float* __restrict__ g, int tid) {
  const int lane = tid & 63, wid = tid >> 6;
  for (int row = blockIdx.x * 8 + wid; row < L; row += gridDim.x * 8) {
    float* src = X + (size_t)row * 1024; f32x4 v[4]; float ss = 0.f;
#pragma unroll
    for (int i = 0; i < 4; ++i) { v[i] = *(const f32x4*)(src + (lane + 64 * i) * 4); ss += v[i].x * v[i].x + v[i].y * v[i].y + v[i].z * v[i].z + v[i].w * v[i].w; }
    ss = wave_sum(ss); const float rinv = rsqrtf(ss * (1.f / 1024.f) + EPS);
#pragma unroll
    for (int i = 0; i < 4; ++i) { const int c = (lane + 64 * i) * 4; const f32x4 gg = *(const f32x4*)(g + c); *(f32x4*)(src + c) = v[i] * rinv * gg; }
  }
}
__device__ __forceinline__ void fold_item(const Args& a, int item, float* lds, int tid) {
  float* A = lds; float* Bm = lds + 64 * 257; const float* T = (const float*)(a.ws + WS_T); bf16_t* W = (bf16_t*)(a.ws + WS_WIN1);
  {
    const int kt = item >> 3, nt = item & 7, part = nt >> 2, n0 = (nt & 3) * 64, k0 = kt * 64;
    for (int idx = tid; idx < 64 * 256; idx += 512) { const int k = idx >> 8, i = idx & 255; A[k * 257 + i] = a.in[13][(size_t)(k0 + k) * 3584 + 3072 + i]; }
    for (int idx = tid; idx < 256 * 64; idx += 512) { const int i = idx >> 6, n = idx & 63; Bm[i * 64 + n] = T[(part * 256 + i) * 256 + n0 + n]; }
    __syncthreads();
    const int n = tid & 63, r0 = tid >> 6; float s[8];
#pragma unroll
    for (int q = 0; q < 8; ++q) s[q] = 0.f;
    for (int i = 0; i < 256; ++i) { const float b = Bm[i * 64 + n];
#pragma unroll
      for (int q = 0; q < 8; ++q) s[q] += A[(r0 + 8 * q) * 257 + i] * b; }
#pragma unroll
    for (int q = 0; q < 8; ++q) W[(size_t)(3072 + part * 256 + n0 + n) * 1024 + k0 + r0 + 8 * q] = (bf16_t)f2bf(s[q]);
    __syncthreads();
  }
}

namespace pg8 {
#define PG8_LAS __attribute__((address_space(3)))
typedef unsigned short bf16_t;
typedef short bf16x8 __attribute__((ext_vector_type(8)));
typedef float f32x4 __attribute__((ext_vector_type(4)));
typedef unsigned u32x4 __attribute__((ext_vector_type(4)));
constexpr int BM = 256, BK = 64, HALF = 128, HTB = HALF * BK * 2  , STAGE_BYTES = 8 * HTB, NXCD = 8, WGM = 8;

__host__ __device__ __forceinline__ int lds_byte(int r, int c) { const int st = (r >> 4) * 2 + (c >> 5), rr = r & 15, cc = c & 31, ob = rr * 64 + cc * 2; return st * 1024 + (ob ^ (((ob >> 9) & 1) << 5)); }
__host__ __device__ __forceinline__ void stage_rc(int b, int& R, int& C) { const int st = b / 1024, sb = b % 1024, swz = sb ^ (((sb >> 9) & 1) << 5); R = (st >> 1) * 16 + swz / 64; C = (st & 1) * 32 + (swz % 64) / 2; }
__host__ __device__ __forceinline__ int perm32(int rho) { const int n = rho >> 4, i = rho & 15; return 8 * (i >> 2) + 4 * n + (i & 3); }

struct Unit { int pm, pn; };
struct Gemm { const bf16_t* A; const bf16_t* Bt; int M, N, K; };
__device__ __forceinline__ unsigned cvt_pk_bf16(float lo, float hi) { unsigned r; asm volatile("v_cvt_pk_bf16_f32 %0, %1, %2" : "=v"(r) : "v"(lo), "v"(hi)); return r; }
}

namespace pg8 {

struct StaticOrder {
    int nM, nN, nwg, G, c;
    __host__ __device__ void init(int M, int N, int G_, int c_) { nM = M / BM; nN = N / BM; nwg = nM * nN; G = G_; c = c_; }
    __host__ __device__ bool next(int i, Unit& u) const {
        const long L = (long)i * G + c; if (L >= nwg) return false;
        int wgid = (int)L; { const int q = nwg / NXCD, r = nwg % NXCD, xcd = wgid % NXCD, off = wgid / NXCD; wgid = (xcd < r ? xcd * (q + 1) : r * (q + 1) + (xcd - r) * q) + off; }
        const int nig = WGM * nN, gid = wgid / nig, fm = gid * WGM, gsz = (nM - fm) < WGM ? (nM - fm) : WGM;
        u.pm = fm + ((wgid % nig) % gsz); u.pn = (wgid % nig) / gsz; return true;
    }
    __device__ __forceinline__ void a_ready(const Unit&) const {}
    __device__ __forceinline__ void done(const Unit&) const {}
};

struct SchedIn0 {
  int G, c;
  __device__ __forceinline__ bool next(int i, Unit& u) const { const int l = i * G + c; if (l >= 642) return false;
    if (l < 2) { u.pm = 0; u.pn = 5 + l; } else { const int v = l - 2; u.pm = 1 + v / 10; u.pn = v % 10; } return true; }
  __device__ __forceinline__ void a_ready(const Unit&) const {}
  __device__ __forceinline__ void done(const Unit&) const {}
};
struct SchedRow {
  int nN, total, G, c;
  __device__ __forceinline__ bool next(int i, Unit& u) const { const int l = i * G + c; if (l >= total) return false; u.pm = l / nN; u.pn = l % nN; return true; }
  __device__ __forceinline__ void a_ready(const Unit&) const {}
  __device__ __forceinline__ void done(const Unit&) const {}
};
struct SchedCol {
  int nM, total, G, c;
  __device__ __forceinline__ bool next(int i, Unit& u) const { const int l = i * G + c; if (l >= total) return false; u.pn = l / nM; u.pm = l % nM; return true; }
  __device__ __forceinline__ void a_ready(const Unit&) const {}
  __device__ __forceinline__ void done(const Unit&) const {}
};
struct EpiIn0 {
  static constexpr bool PERM = true, AFTER_DRAIN = false;
  float* AV; bf16_t *AG, *Q, *K, *V, *BG; const float *qg, *kg; const float2* rope; float* xs;
  __device__ __forceinline__ void operator()(const f32x4 (&acc)[2][2][4][2], const Unit& u, int wr, int wc, int fr, int fq) const {
    const int pn = u.pn, rl0 = wr * 64 + fr, row0 = u.pm * 256 + rl0, cl = wc * 32 + 8 * fq;
    if (u.pm == 0 && pn != 5 && pn != 6) return;
    if (pn == 0) {
#pragma unroll
      for (int ai = 0; ai < 2; ++ai)
#pragma unroll
        for (int m = 0; m < 4; ++m) { float* p = AV + (size_t)(row0 + ai * 128 + m * 16 - 256) * 256 + cl;
#pragma unroll
          for (int bj = 0; bj < 2; ++bj) { *(f32x4*)(p + bj * 128) = acc[ai][bj][m][0]; *(f32x4*)(p + bj * 128 + 4) = acc[ai][bj][m][1]; } }
    } else if (pn == 1 || pn >= 6) {
      bf16_t* dst; int ld, roff = 256, coff = 0; bool act = true;
      size_t hstride = 128;
      if (pn == 1) { dst = AG; ld = 256; } else if (pn == 6) { dst = V; ld = 128; roff = 0; act = false; hstride = (size_t)LK * 128; } else { dst = BG; ld = 768; coff = (pn - 7) * 256; }
#pragma unroll
      for (int ai = 0; ai < 2; ++ai)
#pragma unroll
        for (int m = 0; m < 4; ++m) { bf16_t* p = dst + (size_t)(row0 + ai * 128 + m * 16 - roff) * ld + coff + cl;
#pragma unroll
          for (int bj = 0; bj < 2; ++bj) { f32x4 v0 = acc[ai][bj][m][0], v1 = acc[ai][bj][m][1];
            if (act) { v0.x = siluf(v0.x); v0.y = siluf(v0.y); v0.z = siluf(v0.z); v0.w = siluf(v0.w); v1.x = siluf(v1.x); v1.y = siluf(v1.y); v1.z = siluf(v1.z); v1.w = siluf(v1.w); }
            u32x4 w; w.x = pk2(v0.x, v0.y); w.y = pk2(v0.z, v0.w); w.z = pk2(v1.x, v1.y); w.w = pk2(v1.z, v1.w);
            *(u32x4*)(p + bj * hstride) = w; } }
    } else {
#pragma unroll
      for (int ai = 0; ai < 2; ++ai)
#pragma unroll
        for (int m = 0; m < 4; ++m)
#pragma unroll
          for (int bj = 0; bj < 2; ++bj) { const f32x4 x0 = acc[ai][bj][m][0], x1 = acc[ai][bj][m][1];
            float s = x0.x * x0.x + x0.y * x0.y + x0.z * x0.z + x0.w * x0.w + x1.x * x1.x + x1.y * x1.y + x1.z * x1.z + x1.w * x1.w;
            s += __shfl_xor(s, 16); s += __shfl_xor(s, 32);
            if (fq == 0) xs[(bj * 256 + ai * 128 + m * 16 + rl0) * 4 + wc] = s; }
      __syncthreads();
      const bool isk = (pn == 5); const float* gw = isk ? kg : qg;
      const int axis = wc >> 1, f0 = 4 * ((4 * wc + fq) & 7);
      const f32x4 g0 = *(const f32x4*)(gw + axis * 64 + f0), g1 = *(const f32x4*)(gw + axis * 64 + 32 + f0);
      bf16_t* dst = isk ? K : Q; const int ld = isk ? 128 : 768, coff = isk ? 0 : (pn - 2) * 256, roff = isk ? 0 : 256; const size_t hstride = isk ? (size_t)LK * 128 : 128;
#pragma unroll
      for (int ai = 0; ai < 2; ++ai)
#pragma unroll
        for (int m = 0; m < 4; ++m) { const int row = row0 + ai * 128 + m * 16, tok = row - 256;
          f32x4 cs0 = {1.f, 0.f, 1.f, 0.f}, cs1 = {1.f, 0.f, 1.f, 0.f};
          if (tok >= 0) { const int pos = axis ? (tok & 63) : (tok >> 6); const float* rp = (const float*)(rope + pos * 32 + f0); cs0 = *(const f32x4*)rp; cs1 = *(const f32x4*)(rp + 4); }
#pragma unroll
          for (int bj = 0; bj < 2; ++bj) { const f32x4 t = *(const f32x4*)(xs + (bj * 256 + ai * 128 + m * 16 + rl0) * 4);
            const float rinv = rsqrtf((t.x + t.y + t.z + t.w) * (1.f / 128.f) + EPS);
            const f32x4 av = acc[ai][bj][m][0] * rinv * g0, bv = acc[ai][bj][m][1] * rinv * g1;
            const float o00 = av.x * cs0.x - bv.x * cs0.y, o10 = bv.x * cs0.x + av.x * cs0.y;
            const float o01 = av.y * cs0.z - bv.y * cs0.w, o11 = bv.y * cs0.z + av.y * cs0.w;
            const float o02 = av.z * cs1.x - bv.z * cs1.y, o12 = bv.z * cs1.x + av.z * cs1.y;
            const float o03 = av.w * cs1.z - bv.w * cs1.w, o13 = bv.w * cs1.z + av.w * cs1.w;
            u32x4 w; w.x = pk2(o00, o01); w.y = pk2(o02, o03); w.z = pk2(o10, o11); w.w = pk2(o12, o13);
            *(u32x4*)(dst + (size_t)(row - roff) * ld + coff + bj * hstride + cl) = w; } }
    }
  }
};
struct EpiRes {
  static constexpr bool PERM = true, AFTER_DRAIN = false;
  const float* base; float* out; const float* gate;
  __device__ __forceinline__ void operator()(const f32x4 (&acc)[2][2][4][2], const Unit& u, int wr, int wc, int fr, int fq) const {
    const int row0 = u.pm * 256 + wr * 64 + fr, col0 = u.pn * 256 + wc * 32 + 8 * fq;
#pragma unroll
    for (int bj = 0; bj < 2; ++bj) { const f32x4 g0 = *(const f32x4*)(gate + col0 + bj * 128), g1 = *(const f32x4*)(gate + col0 + bj * 128 + 4);
#pragma unroll
      for (int ai = 0; ai < 2; ++ai)
#pragma unroll
        for (int m = 0; m < 4; ++m) { const size_t o = (size_t)(row0 + ai * 128 + m * 16) * 1024 + col0 + bj * 128;
          const f32x4 b0 = *(const f32x4*)(base + o), b1 = *(const f32x4*)(base + o + 4);
          *(f32x4*)(out + o) = b0 + g0 * acc[ai][bj][m][0]; *(f32x4*)(out + o + 4) = b1 + g1 * acc[ai][bj][m][1]; } }
  }
};
template <int MODE> struct EpiResNorm {
  static constexpr bool PERM = true, AFTER_DRAIN = false; static constexpr int mode = MODE;
  const float* base; float* out; const float* gate; const float* g; const float* mod; bf16_t* H; float* psq; unsigned* cnt; float* xs;
  __device__ __forceinline__ void operator()(const f32x4 (&acc)[2][2][4][2], const Unit& u, int wr, int wc, int fr, int fq) const {
    const int rl0 = wr * 64 + fr, row0 = u.pm * 256 + rl0, col0 = u.pn * 256 + wc * 32 + 8 * fq, tid = (wr * 4 + wc) * 64 + fq * 16 + fr;
#pragma unroll
    for (int ai = 0; ai < 2; ++ai)
#pragma unroll
      for (int m = 0; m < 4; ++m) { float s = 0.f;
#pragma unroll
        for (int bj = 0; bj < 2; ++bj) { int cc = col0 + bj * 128; asm volatile("" : "+v"(cc)); const size_t o = (size_t)(row0 + ai * 128 + m * 16) * 1024 + cc;
          const f32x4 x0 = *(const f32x4*)(base + o) + *(const f32x4*)(gate + cc) * acc[ai][bj][m][0], x1 = *(const f32x4*)(base + o + 4) + *(const f32x4*)(gate + cc + 4) * acc[ai][bj][m][1];
          if (mode == 2) { *(f32x4*)(out + o) = x0; *(f32x4*)(out + o + 4) = x1; }
          s += x0.x * x0.x + x0.y * x0.y + x0.z * x0.z + x0.w * x0.w + x1.x * x1.x + x1.y * x1.y + x1.z * x1.z + x1.w * x1.w; }
        s += __shfl_xor(s, 16); s += __shfl_xor(s, 32); if (fq == 0) xs[(ai * 128 + m * 16 + rl0) * 4 + wc] = s;
        __builtin_amdgcn_sched_barrier(0); }
    __syncthreads();
    if (tid < 256) { const f32x4 t = *(const f32x4*)(xs + tid * 4); psq[(size_t)(u.pm * 256 + tid) * 4 + u.pn] = (t.x + t.y) + (t.z + t.w); }
    asm volatile("s_waitcnt vmcnt(0)" ::: "memory"); __syncthreads();
    if (tid == 0) { __builtin_amdgcn_fence(__ATOMIC_RELEASE, "agent"); asm volatile("s_waitcnt vmcnt(0)" ::: "memory");
      __hip_atomic_fetch_add(cnt + u.pm, 1u, __ATOMIC_RELAXED, __HIP_MEMORY_SCOPE_AGENT);
      for (int it = 0; it < (1 << 22) && __hip_atomic_load(cnt + u.pm, __ATOMIC_RELAXED, __HIP_MEMORY_SCOPE_AGENT) < 4u; ++it) __builtin_amdgcn_s_sleep(1);
      __builtin_amdgcn_fence(__ATOMIC_ACQUIRE, "agent"); asm volatile("s_waitcnt vmcnt(0)" ::: "memory"); }
    __syncthreads();
#pragma unroll
    for (int ai = 0; ai < 2; ++ai)
#pragma unroll
      for (int m = 0; m < 4; ++m) { const float* pq = psq + (size_t)(row0 + ai * 128 + m * 16) * 4;
        const float t = (__builtin_nontemporal_load(pq) + __builtin_nontemporal_load(pq + 1)) + (__builtin_nontemporal_load(pq + 2) + __builtin_nontemporal_load(pq + 3));
        const float ri = rsqrtf(t * (1.f / 1024.f) + EPS);
#pragma unroll
        for (int bj = 0; bj < 2; ++bj) { int cc = col0 + bj * 128; asm volatile("" : "+v"(cc)); const size_t o = (size_t)(row0 + ai * 128 + m * 16) * 1024 + cc;
          const f32x4 x0 = *(const f32x4*)(base + o) + *(const f32x4*)(gate + cc) * acc[ai][bj][m][0], x1 = *(const f32x4*)(base + o + 4) + *(const f32x4*)(gate + cc + 4) * acc[ai][bj][m][1];
          f32x4 y0 = x0 * ri * *(const f32x4*)(g + cc), y1 = x1 * ri * *(const f32x4*)(g + cc + 4);
          if (mode == 2) { y0 = y0 * (*(const f32x4*)(mod + 1024 + cc) + 1.f) + *(const f32x4*)(mod + cc); y1 = y1 * (*(const f32x4*)(mod + 1024 + cc + 4) + 1.f) + *(const f32x4*)(mod + cc + 4);
            u32x4 w; w.x = pk2(y0.x, y0.y); w.y = pk2(y0.z, y0.w); w.z = pk2(y1.x, y1.y); w.w = pk2(y1.z, y1.w); *(u32x4*)(H + o) = w; }
          else { *(f32x4*)(out + o) = y0; *(f32x4*)(out + o + 4) = y1; } }
        __builtin_amdgcn_sched_barrier(0); }
  }
};
struct EpiT {
  static constexpr bool PERM = true, AFTER_DRAIN = false;
  bf16_t* O; int gated;
  __device__ __forceinline__ void operator()(const f32x4 (&acc)[2][2][4][2], const Unit& u, int wr, int wc, int fr, int fq) const {
    const int row0 = u.pm * 256 + wr * 64 + fr, col0 = u.pn * 256 + wc * 32 + 8 * fq; const bool act = gated && ((u.pm >= 9 && u.pm <= 11) || u.pm == 14);
#pragma unroll
    for (int ai = 0; ai < 2; ++ai)
#pragma unroll
      for (int m = 0; m < 4; ++m) { bf16_t* p = O + (size_t)(row0 + ai * 128 + m * 16) * L + col0;
#pragma unroll
        for (int bj = 0; bj < 2; ++bj) { f32x4 v0 = acc[ai][bj][m][0], v1 = acc[ai][bj][m][1];
          if (act) { v0.x = siluf(v0.x); v0.y = siluf(v0.y); v0.z = siluf(v0.z); v0.w = siluf(v0.w); v1.x = siluf(v1.x); v1.y = siluf(v1.y); v1.z = siluf(v1.z); v1.w = siluf(v1.w); }
          u32x4 w; w.x = pk2(v0.x, v0.y); w.y = pk2(v0.z, v0.w); w.z = pk2(v1.x, v1.y); w.w = pk2(v1.z, v1.w);
          *(u32x4*)(p + bj * 128) = w; } }
  }
};
}
namespace pg8 {
template <class Epi, class Sched, bool ALIGN_EPI = false, bool SP2 = false>
__device__ __forceinline__ void gemm_phase(PG8_LAS unsigned char* lds, const Gemm g, const Sched& S, const Epi& E, int tid_in) {
    const int tid = tid_in, wid = __builtin_amdgcn_readfirstlane(tid >> 6), lane = tid & 63, wr = wid >> 2, wc = wid & 3, fr = lane & 15, fq = lane >> 4;
    const int K = g.K, nt = K / BK;
    unsigned voffA[2], voffB[2];
#pragma unroll
    for (int i = 0; i < 2; ++i) { int R, C; stage_rc(tid * 16 + i * 8192, R, C); const int Rb = Epi::PERM ? ((R & ~31) + perm32(R & 31)) : R;
        voffA[i] = (unsigned)(R * K + C) * 2u; voffB[i] = (unsigned)(Rb * K + C) * 2u; }
    const size_t kstep = (size_t)(BK * 2);
    const size_t hstep = (size_t)HALF * K * 2;
    const size_t tstep = 2 * hstep;
    const unsigned ldsw = (unsigned)wid * 1024u;
    const int aoff = lds_byte(wr * 64 + fr, fq * 8), boff = lds_byte(wc * 32 + fr, fq * 8);
#define PG8_SA(b, h) (((b) * 2 + (h)) * HTB)
#define PG8_SB(b, h) ((4 + (b) * 2 + (h)) * HTB)
#define PG8_STAGE(bufoff, gbase, voff) do { _Pragma("unroll") for (int _i = 0; _i < 2; ++_i) \
        __builtin_amdgcn_global_load_lds((const unsigned*)((const char*)(gbase) + (voff)[_i]), (PG8_LAS unsigned*)(lds + (bufoff) + ldsw + _i * 8192), 16, 0, 0); } while (0)
#define PG8_LDA(dst, b, h) do { _Pragma("unroll") for (int m = 0; m < 4; ++m) _Pragma("unroll") for (int k = 0; k < 2; ++k) dst[m][k] = *(const PG8_LAS bf16x8*)(lds + PG8_SA(b, h) + aoff + m * 2048 + k * 1024); } while (0)
#define PG8_LDB(dst, b, h) do { _Pragma("unroll") for (int n = 0; n < 2; ++n) _Pragma("unroll") for (int k = 0; k < 2; ++k) dst[n][k] = *(const PG8_LAS bf16x8*)(lds + PG8_SB(b, h) + boff + n * 2048 + k * 1024); } while (0)
#define PG8_MMA(ai, bj, At, Bt) do { __builtin_amdgcn_s_setprio(1); _Pragma("unroll") for (int m = 0; m < 4; ++m) _Pragma("unroll") for (int n = 0; n < 2; ++n) _Pragma("unroll") for (int k = 0; k < 2; ++k) \
        acc[ai][bj][m][n] = __builtin_amdgcn_mfma_f32_16x16x32_bf16(Bt[n][k], At[m][k], acc[ai][bj][m][n], 0, 0, 0); __builtin_amdgcn_s_setprio(0); } while (0)
#define PG8_WAIT_V(n) asm volatile("s_waitcnt vmcnt(" #n ")" ::: "memory")
#define PG8_WAIT_L(n) asm volatile("s_waitcnt lgkmcnt(" #n ")" ::: "memory")
#define PG8_BAR __builtin_amdgcn_s_barrier()
#define PG8_SCHED __builtin_amdgcn_sched_barrier(0)
    Unit cur, nxt; int ui = 0;
    if (!S.next(0, cur)) return;
    f32x4 acc[2][2][4][2];
#pragma unroll
    for (int a = 0; a < 2; ++a)
#pragma unroll
        for (int b = 0; b < 2; ++b)
#pragma unroll
            for (int m = 0; m < 4; ++m)
#pragma unroll
                for (int n = 0; n < 2; ++n) acc[a][b][m][n] = (f32x4){0.f, 0.f, 0.f, 0.f};
    bf16x8 At[4][2], B0[2][2], B1[2][2];
    const char* cA = (const char*)g.A + (size_t)cur.pm * tstep; const char* cB = (const char*)g.Bt + (size_t)cur.pn * tstep;
    S.a_ready(cur);
    if constexpr (SP2) {
        PG8_STAGE(PG8_SB(0, 0), cB, voffB); PG8_STAGE(PG8_SB(0, 1), cB + hstep, voffB); PG8_STAGE(PG8_SA(0, 0), cA, voffA); PG8_STAGE(PG8_SA(0, 1), cA + hstep, voffA);
        if (wr == 1) PG8_BAR;
        PG8_WAIT_V(2); PG8_BAR;
        PG8_STAGE(PG8_SB(1, 0), cB + kstep, voffB); PG8_STAGE(PG8_SA(1, 0), cA + kstep, voffA); PG8_STAGE(PG8_SB(1, 1), cB + hstep + kstep, voffB);
        PG8_WAIT_V(6); PG8_BAR;
    } else {
        PG8_STAGE(PG8_SB(0, 0), cB, voffB); PG8_STAGE(PG8_SA(0, 0), cA, voffA); PG8_STAGE(PG8_SB(0, 1), cB + hstep, voffB); PG8_STAGE(PG8_SA(0, 1), cA + hstep, voffA);
        if (wr == 1) PG8_BAR;
        PG8_WAIT_V(4); PG8_BAR;
        PG8_STAGE(PG8_SB(1, 0), cB + kstep, voffB); PG8_STAGE(PG8_SA(1, 0), cA + kstep, voffA); PG8_STAGE(PG8_SB(1, 1), cB + hstep + kstep, voffB);
        PG8_WAIT_V(6); PG8_BAR;
    }
    for (;;) {
        const bool has_next = S.next(ui + 1, nxt);
        const char* nA = has_next ? (const char*)g.A + (size_t)nxt.pm * tstep : cA; const char* nB = has_next ? (const char*)g.Bt + (size_t)nxt.pn * tstep : cB;
        for (int t = 0; t < nt; t += 2) {
            const bool last = (t == nt - 2);
            const char* a1 = cA + (size_t)(t + 1) * kstep;
            const char* a2 = last ? nA : cA + (size_t)(t + 2) * kstep; const char* b2 = last ? nB : cB + (size_t)(t + 2) * kstep;
            const char* a3 = a2 + kstep; const char* b3 = b2 + kstep;
            if (last && has_next) S.a_ready(nxt);
            if constexpr (SP2) {
            PG8_LDB(B0, 0, 0); PG8_LDB(B1, 0, 1); PG8_SCHED; PG8_LDA(At, 0, 0); PG8_STAGE(PG8_SA(1, 1), a1 + hstep, voffA);
            PG8_WAIT_V(8); PG8_WAIT_L(0); PG8_BAR; PG8_MMA(0, 0, At, B0); PG8_MMA(0, 1, At, B1); PG8_BAR; PG8_SCHED;
            PG8_LDA(At, 0, 1); PG8_STAGE(PG8_SB(0, 0), b2, voffB); PG8_STAGE(PG8_SB(0, 1), b2 + hstep, voffB); PG8_STAGE(PG8_SA(0, 0), a2, voffA);
            PG8_WAIT_V(8); PG8_WAIT_L(0); PG8_BAR; PG8_MMA(1, 0, At, B0); PG8_MMA(1, 1, At, B1); PG8_BAR; PG8_SCHED;
            PG8_LDB(B0, 1, 0); PG8_LDB(B1, 1, 1); PG8_SCHED; PG8_LDA(At, 1, 0); PG8_STAGE(PG8_SA(0, 1), a2 + hstep, voffA);
            PG8_WAIT_V(8); PG8_WAIT_L(0); PG8_BAR; PG8_MMA(0, 0, At, B0); PG8_MMA(0, 1, At, B1); PG8_BAR; PG8_SCHED;
            PG8_LDA(At, 1, 1); PG8_STAGE(PG8_SB(1, 0), b3, voffB); PG8_STAGE(PG8_SB(1, 1), b3 + hstep, voffB); PG8_STAGE(PG8_SA(1, 0), a3, voffA);
            PG8_WAIT_V(8); PG8_WAIT_L(0); PG8_BAR; PG8_MMA(1, 0, At, B0); PG8_MMA(1, 1, At, B1); PG8_BAR; PG8_SCHED;
            } else {
            PG8_LDB(B0, 0, 0); PG8_SCHED; PG8_LDA(At, 0, 0); PG8_STAGE(PG8_SA(1, 1), a1 + hstep, voffA);
            PG8_WAIT_L(8); PG8_BAR; PG8_WAIT_L(0); PG8_MMA(0, 0, At, B0); PG8_BAR; PG8_SCHED;
            PG8_LDB(B1, 0, 1); PG8_STAGE(PG8_SB(0, 0), b2, voffB);
            PG8_BAR; PG8_WAIT_L(0); PG8_MMA(0, 1, At, B1); PG8_BAR;
            PG8_LDA(At, 0, 1); PG8_STAGE(PG8_SA(0, 0), a2, voffA);
            PG8_BAR; PG8_WAIT_L(0); PG8_MMA(1, 0, At, B0); PG8_BAR; PG8_SCHED;
            PG8_STAGE(PG8_SB(0, 1), b2 + hstep, voffB);
            PG8_WAIT_V(6); PG8_BAR; PG8_MMA(1, 1, At, B1); PG8_BAR;
            PG8_LDB(B0, 1, 0); PG8_SCHED; PG8_LDA(At, 1, 0); PG8_STAGE(PG8_SA(0, 1), a2 + hstep, voffA);
            PG8_WAIT_L(8); PG8_BAR; PG8_WAIT_L(0); PG8_MMA(0, 0, At, B0); PG8_BAR; PG8_SCHED;
            PG8_LDB(B1, 1, 1); PG8_STAGE(PG8_SB(1, 0), b3, voffB);
            PG8_BAR; PG8_WAIT_L(0); PG8_MMA(0, 1, At, B1); PG8_BAR;
            PG8_LDA(At, 1, 1); PG8_STAGE(PG8_SA(1, 0), a3, voffA);
            PG8_BAR; PG8_WAIT_L(0); PG8_MMA(1, 0, At, B0); PG8_BAR; PG8_SCHED;
            PG8_STAGE(PG8_SB(1, 1), b3 + hstep, voffB);
            PG8_WAIT_V(6); PG8_BAR; PG8_MMA(1, 1, At, B1); PG8_BAR;
            }
        }
        if constexpr (ALIGN_EPI) { if (wr == 0) PG8_BAR; }
        if constexpr (!Epi::AFTER_DRAIN) { E(acc, cur, wr, wc, fr, fq); S.done(cur); }
        if (!has_next) break;
#pragma unroll
        for (int a = 0; a < 2; ++a)
#pragma unroll
            for (int b = 0; b < 2; ++b)
#pragma unroll
                for (int m = 0; m < 4; ++m)
#pragma unroll
                    for (int n = 0; n < 2; ++n) acc[a][b][m][n] = (f32x4){0.f, 0.f, 0.f, 0.f};
        cur = nxt; cA = nA; cB = nB; ++ui;
        if constexpr (ALIGN_EPI) { if (wr == 1) PG8_BAR; }
    }
    PG8_WAIT_V(0);
    if constexpr (!ALIGN_EPI) { if (wr == 0) PG8_BAR; }
    PG8_BAR;
    if constexpr (Epi::AFTER_DRAIN) { E.fused(acc, cur, wr, wc, fr, fq, lds, wid, lane); S.done(cur); }
#undef PG8_SA
#undef PG8_SB
#undef PG8_STAGE
#undef PG8_LDA
#undef PG8_LDB
#undef PG8_MMA
#undef PG8_WAIT_V
#undef PG8_WAIT_L
#undef PG8_BAR
#undef PG8_SCHED
}
}

namespace attn {
using bf16 = __hip_bfloat16;
constexpr int   D = 128, NW = 8, QBLK = 32, KVBLK = 64;
constexpr float SCALE = 0.088388347648318440f;
constexpr float THR = 8.f;
constexpr int SDEPTH = 2;
constexpr int LDQ = 768, LDK = 128, LDO = 1024, LDG = 768;
constexpr size_t SHM_V = KVBLK * D * 2, SHM_K = KVBLK * D * 2, SHM_ATTN = 2 * SHM_V + 2 * SHM_K + NW * 64 * 4;
using bf16x8 = __attribute__((ext_vector_type(8))) short;
using s16x4  = __attribute__((ext_vector_type(4))) short;
using f32x16 = __attribute__((ext_vector_type(16))) float;
using f32x8  = __attribute__((ext_vector_type(8))) float;
using u32x4  = __attribute__((ext_vector_type(4))) unsigned;
#define KSWZ(row, colB) ((row) * 256 + ((colB) ^ (((row) & 7) << 4)))
#define SBAR() __builtin_amdgcn_sched_barrier(0)
__device__ __forceinline__ int crow(int r, int hi) { return (r & 3) + 8 * (r >> 2) + 4 * hi; }
__device__ __forceinline__ unsigned cvtpk(float lo, float hi) {
  unsigned r; asm volatile("v_cvt_pk_bf16_f32 %0, %1, %2" : "=v"(r) : "v"(lo), "v"(hi)); return r;
}
template <typename TIn> struct Stage;
template <> struct Stage<bf16>  { using T = bf16x8;
  __device__ static __forceinline__ T ld8(const bf16* p) { return *reinterpret_cast<const bf16x8*>(p); }
  __device__ static __forceinline__ bf16x8 tobf(T x) { return x; } };
template <> struct Stage<float> { using T = f32x8;
  __device__ static __forceinline__ T ld8(const float* p) { return *reinterpret_cast<const f32x8*>(p); }
  __device__ static __forceinline__ bf16x8 tobf(T x) {
    u32x4 w = {cvtpk(x[0], x[1]), cvtpk(x[2], x[3]), cvtpk(x[4], x[5]), cvtpk(x[6], x[7])}; return *reinterpret_cast<bf16x8*>(&w); } };

__device__ __forceinline__ void partialSM(f32x16& p0, f32x16& p1, float& m_reg, float& mn, float& alpha) {
  constexpr float C = SCALE * 1.4426950408889634f;
  float pmax = p0[0]; for (int r = 1; r < 16; ++r) pmax = fmaxf(pmax, p0[r]); for (int r = 0; r < 16; ++r) pmax = fmaxf(pmax, p1[r]);
  { auto rr = __builtin_amdgcn_permlane32_swap(__float_as_uint(pmax), __float_as_uint(pmax), false, false);
    pmax = fmaxf(__uint_as_float(rr[0]), __uint_as_float(rr[1])); }
  if (__builtin_expect(__all(pmax - m_reg <= THR / SCALE), 1)) { mn = m_reg; alpha = 1.f; }
  else { mn = fmaxf(m_reg, pmax); alpha = __builtin_amdgcn_exp2f((m_reg - mn) * C); m_reg = mn; }
  float mnC = -mn * C;
  for (int r = 0; r < 16; ++r) p0[r] = fmaf(p0[r], C, mnC); for (int r = 0; r < 16; ++r) p1[r] = fmaf(p1[r], C, mnC);
  for (int r = 0; r < 16; ++r) p0[r] = __builtin_amdgcn_exp2f(p0[r]);
}
__device__ __forceinline__ void finishSM(f32x16& p0, f32x16& p1, float alpha, float& l_reg, bf16x8& pa0, bf16x8& pa1, bf16x8& pa2, bf16x8& pa3) {
  for (int r = 0; r < 16; ++r) p1[r] = __builtin_amdgcn_exp2f(p1[r]);
  float ps = 0; for (int r = 0; r < 16; ++r) ps += p0[r]; for (int r = 0; r < 16; ++r) ps += p1[r];
  { auto rr = __builtin_amdgcn_permlane32_swap(__float_as_uint(ps), __float_as_uint(ps), false, false);
    ps = __uint_as_float(rr[0]) + __uint_as_float(rr[1]); }
  l_reg = l_reg * alpha + ps;
#define PK4(P, BASE, OUT) do { unsigned a0 = cvtpk(P[BASE + 0], P[BASE + 1]), a1 = cvtpk(P[BASE + 2], P[BASE + 3]);   \
    unsigned b0 = cvtpk(P[BASE + 4], P[BASE + 5]), b1 = cvtpk(P[BASE + 6], P[BASE + 7]);                              \
    auto r0 = __builtin_amdgcn_permlane32_swap(a0, b0, false, false); auto r1 = __builtin_amdgcn_permlane32_swap(a1, b1, false, false); \
    u32x4 w = {r0[0], r1[0], r0[1], r1[1]}; OUT = *reinterpret_cast<bf16x8*>(&w); } while (0)
  PK4(p0, 0, pa0); PK4(p0, 8, pa1); PK4(p1, 0, pa2); PK4(p1, 8, pa3);
#undef PK4
}
__device__ __forceinline__ void qkt(f32x16& p0, f32x16& p1, const bf16* Ks, const bf16x8* qr, int r32, int hi) {
  p0 = f32x16{}; p1 = f32x16{};
  for (int d0 = 0; d0 < 8; ++d0) { int cb = (d0 * 16 + hi * 8) * 2;
    bf16x8 b0 = *reinterpret_cast<const bf16x8*>((const char*)Ks + KSWZ(r32, cb));
    bf16x8 b1 = *reinterpret_cast<const bf16x8*>((const char*)Ks + KSWZ(32 + r32, cb));
    p0 = __builtin_amdgcn_mfma_f32_32x32x16_bf16(b0, qr[d0], p0, 0, 0, 0);
    p1 = __builtin_amdgcn_mfma_f32_32x32x16_bf16(b1, qr[d0], p1, 0, 0, 0); }
}
__device__ __forceinline__ int v_st(int k, int c) { const int kk = (k & ~0xC) | ((k & 4) << 1) | ((k & 8) >> 1); return ((kk >> 3) * 4 + (c >> 5)) * 512 + ((kk & 7) * 32 + (c & 31)) * 2; }
__device__ __forceinline__ int v_rd_base(int lane) { return ((lane & 3) << 3) | (((lane >> 2) & 3) << 6) | (((lane >> 4) & 1) << 5) | (((lane >> 5) & 1) << 8); }
constexpr int v_rd_off(int d0, int ks, int half) { return d0 * 512 + ks * 4096 + half * 2048; }
template <int OFF> __device__ __forceinline__ s16x4 tr_read(int vb) {
  s16x4 r; asm volatile("ds_read_b64_tr_b16 %0, %1 offset:%2" : "=&v"(r) : "v"(vb), "i"(OFF) : "memory"); return r;
}
template <int D0> __device__ __forceinline__ void pv_one(f32x16& od, int vb, bf16x8 pa0, bf16x8 pa1, bf16x8 pa2, bf16x8 pa3) {
  const s16x4 l0 = tr_read<v_rd_off(D0, 0, 0)>(vb), h0 = tr_read<v_rd_off(D0, 0, 1)>(vb), l1 = tr_read<v_rd_off(D0, 1, 0)>(vb), h1 = tr_read<v_rd_off(D0, 1, 1)>(vb);
  const s16x4 l2 = tr_read<v_rd_off(D0, 2, 0)>(vb), h2 = tr_read<v_rd_off(D0, 2, 1)>(vb), l3 = tr_read<v_rd_off(D0, 3, 0)>(vb), h3 = tr_read<v_rd_off(D0, 3, 1)>(vb);
  asm volatile("s_waitcnt lgkmcnt(0)" ::: "memory"); SBAR();
#define PK(L, H) (bf16x8){L[0], L[1], L[2], L[3], H[0], H[1], H[2], H[3]}
  od = __builtin_amdgcn_mfma_f32_32x32x16_bf16(pa0, PK(l0, h0), od, 0, 0, 0);
  od = __builtin_amdgcn_mfma_f32_32x32x16_bf16(pa1, PK(l1, h1), od, 0, 0, 0);
  od = __builtin_amdgcn_mfma_f32_32x32x16_bf16(pa2, PK(l2, h2), od, 0, 0, 0);
  od = __builtin_amdgcn_mfma_f32_32x32x16_bf16(pa3, PK(l3, h3), od, 0, 0, 0);
#undef PK
}
__device__ __forceinline__ void pv_d0(f32x16* o, int vb, bf16x8 pa0, bf16x8 pa1, bf16x8 pa2, bf16x8 pa3) {
  pv_one<0>(o[0], vb, pa0, pa1, pa2, pa3); pv_one<1>(o[1], vb, pa0, pa1, pa2, pa3); pv_one<2>(o[2], vb, pa0, pa1, pa2, pa3); pv_one<3>(o[3], vb, pa0, pa1, pa2, pa3);
}

template <bool PARTIAL>
__device__ __forceinline__ void attn_dense_body(const bf16* __restrict__ Qb, const bf16* __restrict__ Kh, const bf16* __restrict__ Vh,
                                                const bf16_t* __restrict__ Gb, bf16_t* __restrict__ Ob, int seq, char* lds,
                                                float* Pself, const float* Pother, unsigned* cnt, int tid_) {
  using TQ = bf16;
  using St = Stage<bf16>; using SQ = Stage<TQ>;
  asm volatile("" : "+v"(tid_));
  const int tid = tid_, wid = tid >> 6, lane = tid & 63, r32 = lane & 31, hi = lane >> 5;
  bf16* V_lds = (bf16*)lds; bf16* K_lds = (bf16*)(lds + 2 * SHM_V);
  float* ws = (float*)(lds + 2 * SHM_V + 2 * SHM_K) + wid * 64; float* li_l = ws; float* al_l = ws + 32;
  float m_reg = -1e30f, l_reg = 0; f32x16 o[4] = {}; bf16x8 qr[8];
  const TQ* Qw = Qb + (long)(wid * QBLK + r32) * LDQ + hi * 8;
#pragma unroll
  for (int d0 = 0; d0 < 8; ++d0) qr[d0] = SQ::tobf(SQ::ld8(Qw + d0 * 16));
  const int sr = tid >> 4, sc = (tid & 15) * 8, vst0 = v_st(sr, sc), vst1 = v_st(32 + sr, sc);
  const int vb0 = (int)(uintptr_t)V_lds + v_rd_base(lane);
  struct { typename St::T vs0, vs1, ks0, ks1; } sr_[SDEPTH];
  const unsigned so0 = (unsigned)(sr * LDK + sc), so1 = (unsigned)((32 + sr) * LDK + sc);
#define SLOAD(i, k0) do { const bf16* Vt_ = Vh + (long)(k0) * LDK; const bf16* Kt_ = Kh + (long)(k0) * LDK; \
    sr_[i].vs0 = St::ld8(Vt_ + so0); sr_[i].vs1 = St::ld8(Vt_ + so1); sr_[i].ks0 = St::ld8(Kt_ + so0); sr_[i].ks1 = St::ld8(Kt_ + so1); } while (0)
#define SWRITE(b, i) do { *(bf16x8*)((char*)V_lds + (b) * SHM_V + vst0) = St::tobf(sr_[i].vs0);          \
    *(bf16x8*)((char*)V_lds + (b) * SHM_V + vst1) = St::tobf(sr_[i].vs1); int kc = sc * 2;               \
    *(bf16x8*)((char*)K_lds + (b) * SHM_K + KSWZ(sr, kc)) = St::tobf(sr_[i].ks0);                       \
    *(bf16x8*)((char*)K_lds + (b) * SHM_K + KSWZ(32 + sr, kc)) = St::tobf(sr_[i].ks1); } while (0)
#define SWAIT() do { if constexpr (SDEPTH == 2) asm volatile("s_waitcnt vmcnt(4)" ::: "memory"); else asm volatile("s_waitcnt vmcnt(0)" ::: "memory"); } while (0)
#define RESC(a) do { if (__any((a) < 1.f)) { if (hi == 0) al_l[r32] = (a); asm volatile("s_waitcnt lgkmcnt(0)" ::: "memory"); \
    for (int d = 0; d < 4; ++d) for (int r = 0; r < 16; ++r) o[d][r] *= al_l[crow(r, hi)]; } } while (0)
  f32x16 pA0, pA1, pB0, pB1; float mnA, mnB, alA, alB; bf16x8 pa0, pa1, pa2, pa3; const int NT = seq / KVBLK;
  constexpr int SE = 0, SO = SDEPTH - 1;
  SLOAD(SE, 0); asm volatile("s_waitcnt vmcnt(0)" ::: "memory"); SWRITE(0, SE); __syncthreads();
  qkt(pA0, pA1, K_lds, qr, r32, hi); partialSM(pA0, pA1, m_reg, mnA, alA);
  SLOAD(SO, KVBLK); if constexpr (SDEPTH == 2) { if (2 < NT) SLOAD(SE, 2 * KVBLK); }
  SWAIT(); SWRITE(1, SO); __syncthreads();
  for (int j = 1; j + 1 < NT; j += 2) {
    SBAR(); qkt(pB0, pB1, (bf16*)((char*)K_lds + SHM_K), qr, r32, hi);
    finishSM(pA0, pA1, alA, l_reg, pa0, pa1, pa2, pa3); SBAR();
    SLOAD(SO, (j + SDEPTH) * KVBLK); SBAR();
    pv_d0(o, vb0, pa0, pa1, pa2, pa3); partialSM(pB0, pB1, m_reg, mnB, alB);
    __syncthreads(); SWAIT(); SWRITE(0, SE);
    RESC(alB); __syncthreads();
    SBAR(); qkt(pA0, pA1, K_lds, qr, r32, hi);
    finishSM(pB0, pB1, alB, l_reg, pa0, pa1, pa2, pa3); SBAR();
    if (SDEPTH == 1 || j + 3 < NT) SLOAD(SE, (j + 1 + SDEPTH) * KVBLK); SBAR();
    pv_d0(o, vb0 + (int)SHM_V, pa0, pa1, pa2, pa3); partialSM(pA0, pA1, m_reg, mnA, alA);
    __syncthreads(); SWAIT(); SWRITE(1, SO);
    RESC(alA); __syncthreads();
  }
  SBAR(); qkt(pB0, pB1, (bf16*)((char*)K_lds + SHM_K), qr, r32, hi);
  finishSM(pA0, pA1, alA, l_reg, pa0, pa1, pa2, pa3); SBAR();
  pv_d0(o, vb0, pa0, pa1, pa2, pa3); partialSM(pB0, pB1, m_reg, mnB, alB);
  __syncthreads(); RESC(alB);
  finishSM(pB0, pB1, alB, l_reg, pa0, pa1, pa2, pa3); SBAR();
  pv_d0(o, vb0 + (int)SHM_V, pa0, pa1, pa2, pa3);
  if constexpr (!PARTIAL) {
  if (hi == 0) li_l[r32] = l_reg; asm volatile("s_waitcnt lgkmcnt(0)" ::: "memory");
  float rli[16];
#pragma unroll
  for (int r = 0; r < 16; ++r) rli[r] = __builtin_amdgcn_rcpf(li_l[crow(r, hi)]);
  const bf16_t* Gw = Gb + (long)(wid * QBLK) * LDG; bf16_t* Ow = Ob + (long)(wid * QBLK) * LDO;
#pragma unroll
  for (int r = 0; r < 16; ++r) { int orow = crow(r, hi);
    for (int d0 = 0; d0 < 4; ++d0) { const float gt = bf2f(Gw[(long)orow * LDG + d0 * 32 + r32]); Ow[(long)orow * LDO + d0 * 32 + r32] = (bf16_t)f2bf(o[d0][r] * rli[r] * gt); }
    if ((r & 3) == 3) __builtin_amdgcn_sched_barrier(0); }
  } else {
    constexpr float C = SCALE * 1.4426950408889634f;
    { float* Pw = Pself + (long)(wid * QBLK) * 128;
#pragma unroll
      for (int r = 0; r < 16; ++r) { const int orow = crow(r, hi);
        for (int d0 = 0; d0 < 4; ++d0) Pw[orow * 128 + d0 * 32 + r32] = o[d0][r];
        if ((r & 3) == 3) __builtin_amdgcn_sched_barrier(0); }
      if (hi == 0) { Pself[256 * 128 + wid * QBLK + r32] = m_reg; Pself[256 * 128 + 256 + wid * QBLK + r32] = l_reg; } }
    __builtin_amdgcn_fence(__ATOMIC_RELEASE, "agent"); asm volatile("s_waitcnt vmcnt(0)" ::: "memory"); __syncthreads();
    volatile unsigned* flag = (volatile unsigned*)(lds + SHM_ATTN);
    if (tid == 0) *flag = atomicAdd(cnt, 1u);
    __syncthreads();
    if (*flag == 1u) {
      __builtin_amdgcn_fence(__ATOMIC_ACQUIRE, "agent");
      const float m2 = __builtin_nontemporal_load(Pother + 256 * 128 + wid * QBLK + r32), l2 = __builtin_nontemporal_load(Pother + 256 * 128 + 256 + wid * QBLK + r32);
      const float M = fmaxf(m_reg, m2), a1 = __builtin_amdgcn_exp2f((m_reg - M) * C), a2 = __builtin_amdgcn_exp2f((m2 - M) * C), inv = __builtin_amdgcn_rcpf(l_reg * a1 + l2 * a2);
      if (hi == 0) { li_l[r32] = a1 * inv; al_l[r32] = a2 * inv; } asm volatile("s_waitcnt lgkmcnt(0)" ::: "memory");
      const float* Po = Pother + (long)(wid * QBLK) * 128; const bf16_t* Gw = Gb + (long)(wid * QBLK) * LDG; bf16_t* Ow = Ob + (long)(wid * QBLK) * LDO;
#pragma unroll
      for (int r = 0; r < 16; ++r) { const int orow = crow(r, hi); const float w1 = li_l[orow], w2 = al_l[orow];
        for (int d0 = 0; d0 < 4; ++d0) { const float gt = bf2f(Gw[(long)orow * LDG + d0 * 32 + r32]); const float ov = __builtin_nontemporal_load(Po + orow * 128 + d0 * 32 + r32);
          Ow[(long)orow * LDO + d0 * 32 + r32] = (bf16_t)f2bf((o[d0][r] * w1 + ov * w2) * gt); }
        if ((r & 3) == 3) __builtin_amdgcn_sched_barrier(0); }
    }
    __syncthreads();
  }
#undef SLOAD
#undef SWRITE
#undef SWAIT
#undef RESC
}

#undef KSWZ
#undef SBAR
}

__device__ __forceinline__ void pool_phase(const float* __restrict__ AV, const bf16_t* __restrict__ AG, bf16_t* __restrict__ MIX, unsigned* ctr, volatile unsigned* slot, int tid) {
  const int c4 = (tid & 63) * 4, tg = tid >> 6, w2 = 1 << (c4 >> 6);
  for (;;) {
    __syncthreads();
    if (tid == 0) *slot = atomicAdd(ctr, 1u);
    __syncthreads();
    const int item = (int)*slot;
    if (item >= L / 32) break;
#pragma unroll 1
    for (int q = 0; q < 4; ++q) { const int t = item * 32 + tg * 4 + q;
      const int lo = max(t - w2, 0), hi = min(t + w2, L);
      f32x4 s = {0.f, 0.f, 0.f, 0.f};
      for (int u = lo; u < hi; ++u) s += *(const f32x4*)(AV + (size_t)u * 256 + c4);
      const f32x4 me = *(const f32x4*)(AV + (size_t)t * 256 + c4); const float ic = 1.f / (float)(hi - lo);
      const u32x2 gw = *(const u32x2*)(AG + (size_t)t * 256 + c4);
      const float g0 = __uint_as_float(gw.x << 16), g1 = __uint_as_float(gw.x & 0xffff0000u), g2 = __uint_as_float(gw.y << 16), g3 = __uint_as_float(gw.y & 0xffff0000u);
      u32x2 w; w.x = pk2((s.x * ic - me.x) * g0, (s.y * ic - me.y) * g1); w.y = pk2((s.z * ic - me.z) * g2, (s.w * ic - me.w) * g3);
      *(u32x2*)(MIX + (size_t)t * 1024 + c4) = w; }
  }
}

__device__ __forceinline__ void prep_queue(const Args& a, unsigned* ctr, volatile unsigned* slot, float* lds, int tid) {
  for (;;) {
    __syncthreads();
    if (tid == 0) *slot = atomicAdd(ctr, 1u);
    __syncthreads();
    int item = (int)*slot;
    if (item < 128) { fold_item(a, item, lds, tid); continue; }
    item -= 128;
    if (item >= prep::N_LATE) break;
    prep_item(a, prep::late_item(item), lds, tid);
  }
}

#define PADI(i) ((i) + ((i) >> 5))
__device__ __forceinline__ float2 cadd(float2 a, float2 b) { return make_float2(a.x + b.x, a.y + b.y); }
__device__ __forceinline__ float2 csub(float2 a, float2 b) { return make_float2(a.x - b.x, a.y - b.y); }
__device__ __forceinline__ float2 cmul(float2 a, float2 b) { return make_float2(a.x * b.x - a.y * b.y, a.x * b.y + a.y * b.x); }
__device__ constexpr float W32C[16] = {1.f, 0.98078528040323043f, 0.92387953251128674f, 0.83146961230254524f, 0.70710678118654752f, 0.55557023301960218f, 0.38268343236508977f, 0.19509032201612825f,
                                       0.f, -0.19509032201612825f, -0.38268343236508977f, -0.55557023301960218f, -0.70710678118654752f, -0.83146961230254524f, -0.92387953251128674f, -0.98078528040323043f};
__device__ constexpr float W32S[16] = {0.f, 0.19509032201612825f, 0.38268343236508977f, 0.55557023301960218f, 0.70710678118654752f, 0.83146961230254524f, 0.92387953251128674f, 0.98078528040323043f,
                                       1.f, 0.98078528040323043f, 0.92387953251128674f, 0.83146961230254524f, 0.70710678118654752f, 0.55557023301960218f, 0.38268343236508977f, 0.19509032201612825f};
template <int S, bool INV>
__device__ __forceinline__ void fft_pass8(float2* cb, const float2* twL, int tid) {
  static_assert(S % 32 == 0, "constant LDS offsets need S % 32 == 0");
  constexpr float R = 0.70710678118654752f;
  constexpr int ES = S + S / 32;
#pragma unroll 2
  for (int it = 0; it < 4; ++it) {
    const int u = it * 512 + tid, j = u & (S - 1), base = ((u & ~(S - 1)) << 3) + j;
    float2* p = cb + PADI(base);
    float2 x[8];
#pragma unroll
    for (int e = 0; e < 8; ++e) x[e] = p[e * ES];
    float2 t1 = twL[j * (2048 / S)]; if (INV) t1.y = -t1.y;
    const float2 t2 = cmul(t1, t1), t3 = cmul(t2, t2);
    float2 w8[4]; w8[0] = t1;
    if (!INV) { w8[1] = cmul(t1, make_float2(R, -R)); w8[2] = make_float2(t1.y, -t1.x); w8[3] = cmul(t1, make_float2(-R, -R)); }
    else      { w8[1] = cmul(t1, make_float2(R, R));  w8[2] = make_float2(-t1.y, t1.x); w8[3] = cmul(t1, make_float2(-R, R)); }
    float2 w4[2]; w4[0] = t2; w4[1] = INV ? make_float2(-t2.y, t2.x) : make_float2(t2.y, -t2.x);
    if (!INV) {
#pragma unroll
      for (int e = 0; e < 4; ++e) { const float2 a = x[e], c = x[e + 4]; x[e] = cadd(a, c); x[e + 4] = cmul(csub(a, c), w8[e]); }
#pragma unroll
      for (int q = 0; q < 8; q += 4)
#pragma unroll
        for (int e = 0; e < 2; ++e) { const float2 a = x[q + e], c = x[q + e + 2]; x[q + e] = cadd(a, c); x[q + e + 2] = cmul(csub(a, c), w4[e]); }
#pragma unroll
      for (int q = 0; q < 8; q += 2) { const float2 a = x[q], c = x[q + 1]; x[q] = cadd(a, c); x[q + 1] = cmul(csub(a, c), t3); }
    } else {
#pragma unroll
      for (int q = 0; q < 8; q += 2) { const float2 a = x[q], c = cmul(x[q + 1], t3); x[q] = cadd(a, c); x[q + 1] = csub(a, c); }
#pragma unroll
      for (int q = 0; q < 8; q += 4)
#pragma unroll
        for (int e = 0; e < 2; ++e) { const float2 a = x[q + e], c = cmul(x[q + e + 2], w4[e]); x[q + e] = cadd(a, c); x[q + e + 2] = csub(a, c); }
#pragma unroll
      for (int e = 0; e < 4; ++e) { const float2 a = x[e], c = cmul(x[e + 4], w8[e]); x[e] = cadd(a, c); x[e + 4] = csub(a, c); }
    }
#pragma unroll
    for (int e = 0; e < 8; ++e) p[e * ES] = x[e];
  }
  __syncthreads();
}
template <bool INV>
__device__ __forceinline__ void fft_pass32(float2* cb, int tid) {
  float2* p = cb + 33 * tid;
  float2 x[32];
#pragma unroll
  for (int e = 0; e < 32; ++e) x[e] = p[e];
  if (!INV) {
#pragma unroll
    for (int h = 16; h >= 1; h >>= 1)
#pragma unroll
      for (int b = 0; b < 32; b += 2 * h)
#pragma unroll
        for (int q = 0; q < h; ++q) { const float2 a = x[b + q], c = x[b + q + h], d = csub(a, c); x[b + q] = cadd(a, c);
          const int k = q * (16 / h);
          if (k == 0) x[b + q + h] = d; else if (k == 8) x[b + q + h] = make_float2(d.y, -d.x); else x[b + q + h] = cmul(d, make_float2(W32C[k], -W32S[k])); }
  } else {
#pragma unroll
    for (int h = 1; h <= 16; h <<= 1)
#pragma unroll
      for (int b = 0; b < 32; b += 2 * h)
#pragma unroll
        for (int q = 0; q < h; ++q) { const float2 a = x[b + q], c0 = x[b + q + h]; float2 c;
          const int k = q * (16 / h);
          if (k == 0) c = c0; else if (k == 8) c = make_float2(-c0.y, c0.x); else c = cmul(c0, make_float2(W32C[k], W32S[k]));
          x[b + q] = cadd(a, c); x[b + q + h] = csub(a, c); }
  }
#pragma unroll
  for (int e = 0; e < 32; ++e) p[e] = x[e];
  __syncthreads();
}
__device__ __forceinline__ void fft_fwd(float2* cb, const float2* twL, int tid) {
  fft_pass8<2048, false>(cb, twL, tid); fft_pass8<256, false>(cb, twL, tid); fft_pass8<32, false>(cb, twL, tid); fft_pass32<false>(cb, tid);
}
__device__ __forceinline__ void fft_inv(float2* cb, const float2* twL, int tid) {
  fft_pass32<true>(cb, tid); fft_pass8<32, true>(cb, twL, tid); fft_pass8<256, true>(cb, twL, tid); fft_pass8<2048, true>(cb, twL, tid);
}
template <bool ODD>
__device__ __forceinline__ void fft_pointwise(float2* cb, int tid) {
#pragma unroll 1
  for (int j = 0; j < (ODD ? 16 : 32); ++j) {
    const int p = j * 512 + tid;
    int pp;
    if (ODD) pp = 16383 - p; else pp = (p < 2) ? p : (p ^ ((1 << (31 - __clz(p))) - 1));
    if (p <= pp) {
      const float2 C = cb[PADI(p)], C2 = cb[PADI(pp)];
      const float2 Z = make_float2(0.5f * (C.x + C2.x), 0.5f * (C.y - C2.y)), K = make_float2(0.5f * (C.y + C2.y), -0.5f * (C.x - C2.x));
      const float2 Y = cmul(Z, K);
      cb[PADI(p)] = Y; cb[PADI(pp)] = make_float2(Y.x, -Y.y);
    }
  }
  __syncthreads();
}
__device__ __forceinline__ float conv3_at(const bf16_t* __restrict__ row, int t, float w0, float w1, float w2, float b) {
  const unsigned tm = (unsigned)max(t - 1, 0), tp = (unsigned)min(t + 1, L - 1); float um = bf2f(row[tm]), up = bf2f(row[tp]); const float u0 = bf2f(row[(unsigned)t]);
  um = t > 0 ? um : 0.f; up = t < L - 1 ? up : 0.f;
  return w0 * um + w1 * u0 + w2 * up + b;
}


namespace mf {
typedef short bf16x8 __attribute__((ext_vector_type(8)));
typedef short bf16x4 __attribute__((ext_vector_type(4)));
constexpr int RS = 272, PL = 128 * RS;
constexpr int O_DRE = 0, O_DIM = PL, O_FRE = 2 * PL, O_FIM = 3 * PL, O_TWA = 4 * PL, O_TWB = 4 * PL + 1024, O_RED = 4 * PL + 2048;
__device__ __forceinline__ bf16x4 tr_rd(unsigned addr) { bf16x4 r; asm volatile("ds_read_b64_tr_b16 %0, %1" : "=&v"(r) : "v"(addr) : "memory"); return r; }
__device__ __forceinline__ bf16x8 negv(bf16x8 v) { u32x4 t = __builtin_bit_cast(u32x4, v); t.x ^= 0x80008000u; t.y ^= 0x80008000u; t.z ^= 0x80008000u; t.w ^= 0x80008000u; return __builtin_bit_cast(bf16x8, t); }
__device__ __forceinline__ bf16x8 cat(bf16x4 a, bf16x4 b) { return (bf16x8){a[0], a[1], a[2], a[3], b[0], b[1], b[2], b[3]}; }
__device__ __forceinline__ float2 twid(const char* lds, int idx, bool inv) {
  const float2 ta = ((const float2*)(lds + O_TWA))[idx >> 7], tb = ((const float2*)(lds + O_TWB))[idx & 127];
  float2 w = make_float2(ta.x * tb.x - ta.y * tb.y, ta.x * tb.y + ta.y * tb.x); if (inv) w.y = -w.y; return w;
}
template <bool INV, bool TW, int OUT>
__device__ __forceinline__ void dft_cols(char* lds, const float2* __restrict__ TW2, int tid) {
  const int lane = tid & 63, w = tid >> 6, g = lane >> 4, n16 = lane & 15, q = n16 >> 2, p = lane & 3;
  const unsigned base = (unsigned)(uintptr_t)lds;
  bf16x8 bre[4], bim[4];
  { bf16x4 t0[4], t1[4], u0[4], u1[4];
#pragma unroll
    for (int ks = 0; ks < 4; ++ks) { const unsigned a0 = base + RS * (32 * ks + 8 * g + q) + 16 * (2 * w + (p >> 1)) + 8 * (p & 1), a1 = a0 + 4 * RS;
      t0[ks] = tr_rd(a0 + O_DRE); t1[ks] = tr_rd(a1 + O_DRE); u0[ks] = tr_rd(a0 + O_DIM); u1[ks] = tr_rd(a1 + O_DIM); }
    asm volatile("s_waitcnt lgkmcnt(0)" ::: "memory"); __builtin_amdgcn_sched_barrier(0);
#pragma unroll
    for (int ks = 0; ks < 4; ++ks) { bre[ks] = cat(t0[ks], t1[ks]); bim[ks] = cat(u0[ks], u1[ks]); } }
  if (OUT != 0) __syncthreads();
  bf16x8 x2[4], x3[4];
#pragma unroll
  for (int ks = 0; ks < 4; ++ks) { x2[ks] = INV ? bim[ks] : negv(bim[ks]); x3[ks] = INV ? negv(bre[ks]) : bre[ks]; }
#pragma unroll 2
  for (int rb = 0; rb < 8; ++rb) {
    f32x4 dre = {0.f, 0.f, 0.f, 0.f}, dim = {0.f, 0.f, 0.f, 0.f};
    const char* fr = lds + O_FRE + RS * (n16 + 16 * rb) + 16 * g; const char* fi = fr + PL;
#pragma unroll
    for (int ks = 0; ks < 4; ++ks) { const bf16x8 afr = *(const bf16x8*)(fr + 64 * ks), afi = *(const bf16x8*)(fi + 64 * ks);
      dre = __builtin_amdgcn_mfma_f32_16x16x32_bf16(bre[ks], afr, dre, 0, 0, 0); dre = __builtin_amdgcn_mfma_f32_16x16x32_bf16(x2[ks], afi, dre, 0, 0, 0);
      if (OUT != 1) { dim = __builtin_amdgcn_mfma_f32_16x16x32_bf16(bim[ks], afr, dim, 0, 0, 0); dim = __builtin_amdgcn_mfma_f32_16x16x32_bf16(x3[ks], afi, dim, 0, 0, 0); } }
    const int row = 16 * rb + n16, c0 = 16 * w + 4 * g;
    float vr[4], vi[4];
#pragma unroll
    for (int r = 0; r < 4; ++r) { vr[r] = dre[r]; vi[r] = dim[r];
      if (TW) { const float2 t = twid(lds, row * (c0 + r), INV); const float a = vr[r] * t.x - vi[r] * t.y, b = vr[r] * t.y + vi[r] * t.x; vr[r] = a; vi[r] = b; } }
    if (OUT == 0) { u32x2 wr_, wi_; wr_.x = pk2(vr[0], vr[1]); wr_.y = pk2(vr[2], vr[3]); wi_.x = pk2(vi[0], vi[1]); wi_.y = pk2(vi[2], vi[3]);
      *(u32x2*)(lds + O_DRE + RS * row + 2 * c0) = wr_; *(u32x2*)(lds + O_DIM + RS * row + 2 * c0) = wi_; }
    else if (OUT == 1) { *(f32x4*)((float*)lds + 128 * row + c0) = (f32x4){vr[0], vr[1], vr[2], vr[3]}; }
    else { const f32x4 ta = *(const f32x4*)(TW2 + 128 * row + c0), tb = *(const f32x4*)(TW2 + 128 * row + c0 + 2);
      *(f32x4*)((float*)lds + 128 * row + c0) = (f32x4){vr[0] * ta.x + vi[0] * ta.y, vr[1] * ta.z + vi[1] * ta.w, vr[2] * tb.x + vi[2] * tb.y, vr[3] * tb.z + vi[3] * tb.w}; }
  }
  __syncthreads();
}
template <bool INV, bool TW>
__device__ __forceinline__ void dft_rows(char* lds, int tid) {
  const int lane = tid & 63, w = tid >> 6, g = lane >> 4, n16 = lane & 15;
  bf16x8 are[4], aim[4], x2[4], x3[4];
  { const char* pr = lds + O_DRE + RS * (n16 + 16 * w) + 16 * g; const char* pi = pr + PL;
#pragma unroll
    for (int ks = 0; ks < 4; ++ks) { are[ks] = *(const bf16x8*)(pr + 64 * ks); aim[ks] = *(const bf16x8*)(pi + 64 * ks); x2[ks] = INV ? aim[ks] : negv(aim[ks]); x3[ks] = INV ? negv(are[ks]) : are[ks]; } }
#pragma unroll 2
  for (int cbk = 0; cbk < 8; ++cbk) {
    f32x4 dre = {0.f, 0.f, 0.f, 0.f}, dim = {0.f, 0.f, 0.f, 0.f};
    const char* fr = lds + O_FRE + RS * (n16 + 16 * cbk) + 16 * g; const char* fi = fr + PL;
#pragma unroll
    for (int ks = 0; ks < 4; ++ks) { const bf16x8 bfr = *(const bf16x8*)(fr + 64 * ks), bfi = *(const bf16x8*)(fi + 64 * ks);
      dre = __builtin_amdgcn_mfma_f32_16x16x32_bf16(bfr, are[ks], dre, 0, 0, 0); dre = __builtin_amdgcn_mfma_f32_16x16x32_bf16(bfi, x2[ks], dre, 0, 0, 0);
      dim = __builtin_amdgcn_mfma_f32_16x16x32_bf16(bfi, x3[ks], dim, 0, 0, 0); dim = __builtin_amdgcn_mfma_f32_16x16x32_bf16(bfr, aim[ks], dim, 0, 0, 0); }
    const int row = 16 * w + n16, c0 = 16 * cbk + 4 * g;
    float vr[4], vi[4];
#pragma unroll
    for (int r = 0; r < 4; ++r) { vr[r] = dre[r]; vi[r] = dim[r];
      if (TW) { const float2 t = twid(lds, row * (c0 + r), INV); const float a = vr[r] * t.x - vi[r] * t.y, b = vr[r] * t.y + vi[r] * t.x; vr[r] = a; vi[r] = b; } }
    u32x2 wr_, wi_; wr_.x = pk2(vr[0], vr[1]); wr_.y = pk2(vr[2], vr[3]); wi_.x = pk2(vi[0], vi[1]); wi_.y = pk2(vi[2], vi[3]);
    *(u32x2*)(lds + O_DRE + RS * row + 2 * c0) = wr_; *(u32x2*)(lds + O_DIM + RS * row + 2 * c0) = wi_;
  }
  __syncthreads();
}
template <bool ODD>
__device__ __forceinline__ void pointwise(char* lds, int tid) {
#pragma unroll 1
  for (int j = 0; j < (ODD ? 16 : 17); ++j) {
    const int pq = j * 512 + tid;
    int k1, k2, q1, q2; bool act = true;
    if (ODD) { k1 = pq >> 7; k2 = pq & 127; q1 = 127 - k1; q2 = 127 - k2; }
    else if (pq < 8064) { k1 = 1 + (pq >> 7); k2 = pq & 127; q1 = 128 - k1; q2 = 127 - k2; }
    else if (pq < 8192) { k1 = 0; k2 = pq - 8064; q1 = 0; q2 = (128 - k2) & 127; act = k2 <= q2; }
    else if (pq < 8320) { k1 = 64; k2 = pq - 8192; q1 = 64; q2 = 127 - k2; act = k2 <= q2; }
    else { k1 = k2 = q1 = q2 = 0; act = false; }
    if (act) {
      bf16_t* r0 = (bf16_t*)(lds + O_DRE + RS * k1 + 2 * k2); bf16_t* i0 = (bf16_t*)(lds + O_DIM + RS * k1 + 2 * k2);
      bf16_t* r1 = (bf16_t*)(lds + O_DRE + RS * q1 + 2 * q2); bf16_t* i1 = (bf16_t*)(lds + O_DIM + RS * q1 + 2 * q2);
      const float cx = bf2f(*r0), cy = bf2f(*i0), dx = bf2f(*r1), dy = bf2f(*i1);
      const float zx = 0.5f * (cx + dx), zy = 0.5f * (cy - dy), kx = 0.5f * (cy + dy), ky = -0.5f * (cx - dx);
      const float yx = zx * kx - zy * ky, yy = zx * ky + zy * kx;
      *r0 = (bf16_t)f2bf(yx); *i0 = (bf16_t)f2bf(yy); *r1 = (bf16_t)f2bf(yx); *i1 = (bf16_t)f2bf(-yy);
    }
  }
  __syncthreads();
}
}

__device__ __forceinline__ void conv3_pair(const bf16_t* __restrict__ row, int n0, float w0, float w1, float w2, float b, float& o0, float& o1) {
  const unsigned pr = *(const unsigned*)(row + (unsigned)n0); const float u0 = __uint_as_float(pr << 16), u1 = __uint_as_float(pr & 0xffff0000u);
  float um = bf2f(row[(unsigned)max(n0 - 1, 0)]), up = bf2f(row[(unsigned)min(n0 + 2, L - 1)]); um = n0 > 0 ? um : 0.f; up = (n0 + 2 < L) ? up : 0.f;
  o0 = w0 * um + w1 * u0 + w2 * u1 + b; o1 = w0 * u0 + w1 * u1 + w2 * up + b;
}
__device__ __forceinline__ void hyena_mfma_items(const Args& a, char* lds, int tid) {
  bf16_t* P1T = (bf16_t*)(a.ws + WS_P1T); const bf16_t* HT = (const bf16_t*)(a.ws + WS_HT);
  const float2* TW2 = (const float2*)(a.ws + WS_TW2);
  float* red = (float*)(lds + mf::O_RED); float* outf = (float*)lds;
  for (int idx = tid; idx < 16384; idx += 512) { const int r = idx >> 7, c = idx & 127, m = (r * c) & 127; float s, co; sincospif((float)m / 64.f, &s, &co);
    *(bf16_t*)(lds + mf::O_FRE + mf::RS * r + 2 * c) = (bf16_t)f2bf(co); *(bf16_t*)(lds + mf::O_FIM + mf::RS * r + 2 * c) = (bf16_t)f2bf(-s); }
  if (tid < 128) { float s, co; sincospif((float)tid / 64.f, &s, &co); ((float2*)(lds + mf::O_TWA))[tid] = make_float2(co, -s); ((float2*)(lds + mf::O_TWB))[tid] = TW2[2 * tid]; }
  __syncthreads();
  const float* cw = a.in[15]; const float* cbias = a.in[16]; const float* skip = a.in[23];
#ifndef HY_PROBE
#define HY_PROBE 0
#endif
#pragma unroll 1
  for (int pass = HY_PROBE ? 0 : 1; pass < 2; ++pass)
  for (int item = blockIdx.x; item < (pass ? 768 : 256); item += gridDim.x) {
    asm volatile("" : "+v"(tid));
    const int c = item;
    const float ad = fabsf(-3.0701134573f + (-15.350567286f + 3.0701134573f) * ((float)c * (1.f / 767.f))) * (1.f / 16383.f);
    const float dr1 = __expf(-ad);
    float z[32], acc[32];
    { const bf16_t* vr = P1T + (size_t)c * L; const float w0 = cw[c], w1 = cw[2304 + c], w2 = cw[4608 + c], b = cbias[c];
asm volatile("" : "+v"(tid));
#pragma unroll
      for (int jp = 0; jp < 16; ++jp) { if ((jp & 15) == 0) __builtin_amdgcn_sched_barrier(0); conv3_pair(vr, jp * 1024 + 2 * tid, w0, w1, w2, b, z[2 * jp], z[2 * jp + 1]); } }
#pragma unroll 1
    for (int o = 0; o < 2; ++o) {
      const bf16_t* hf = HT + (size_t)((o * 2 + 0) * 768 + c) * L; const bf16_t* hb = HT + (size_t)((o * 2 + 1) * 768 + c) * L;
      float ssum = 0.f; unsigned kst[16];
asm volatile("" : "+v"(tid));
#pragma unroll
      for (int jp = 0; jp < 16; ++jp) { if ((jp & 15) == 0) __builtin_amdgcn_sched_barrier(0); const int n0 = jp * 1024 + 2 * tid; const int nb0 = (L - n0) & (L - 1), nb1 = L - 1 - n0;
        const unsigned pf = *(const unsigned*)(hf + (unsigned)n0); const float e0 = __expf(-ad * (float)n0);
        const float f0 = __uint_as_float(pf << 16) * e0, f1 = __uint_as_float(pf & 0xffff0000u) * (e0 * dr1);
        float b0 = bf2f(hb[(unsigned)nb0]) * __expf(-ad * (float)nb0); const float b1 = bf2f(hb[(unsigned)nb1]) * __expf(-ad * (float)nb1);
        ssum += (fabsf(f0) + fabsf(b0)) + (fabsf(f1) + fabsf(b1)); b0 = n0 ? b0 : 0.f; const int off = mf::RS * (n0 >> 7) + 2 * (n0 & 127);
        *(unsigned*)(lds + mf::O_DRE + off) = pk2(z[2 * jp], z[2 * jp + 1]); *(unsigned*)(lds + mf::O_DIM + off) = pk2(f0 + b0, f1 + b1); kst[jp] = pk2(f0 - b0, f1 - b1); }
      ssum = wave_sum(ssum); if ((tid & 63) == 0) red[tid >> 6] = ssum;
      __syncthreads();
      const float nrm = EPS + ((red[0] + red[1]) + (red[2] + red[3])) + ((red[4] + red[5]) + (red[6] + red[7]));
      mf::dft_cols<false, true, 0>(lds, TW2, tid); mf::dft_rows<false, false>(lds, tid); mf::pointwise<false>(lds, tid);
      mf::dft_rows<true, true>(lds, tid); mf::dft_cols<true, false, 1>(lds, TW2, tid);
asm volatile("" : "+v"(tid));
#pragma unroll
      for (int jp = 0; jp < 16; ++jp) { if ((jp & 15) == 0) __builtin_amdgcn_sched_barrier(0); const float2 v = *(const float2*)(outf + jp * 1024 + 2 * tid); acc[2 * jp] = v.x; acc[2 * jp + 1] = v.y; }
      __syncthreads();
asm volatile("" : "+v"(tid));
#pragma unroll
      for (int jp = 0; jp < 16; ++jp) { if ((jp & 15) == 0) __builtin_amdgcn_sched_barrier(0); const int n0 = jp * 1024 + 2 * tid;
        const float k0 = __uint_as_float(kst[jp] << 16), k1 = __uint_as_float(kst[jp] & 0xffff0000u); const f32x4 w = *(const f32x4*)(TW2 + n0);
        const int off = mf::RS * (n0 >> 7) + 2 * (n0 & 127);
        *(unsigned*)(lds + mf::O_DRE + off) = pk2(z[2 * jp] * w.x - k0 * w.y, z[2 * jp + 1] * w.z - k1 * w.w);
        *(unsigned*)(lds + mf::O_DIM + off) = pk2(z[2 * jp] * w.y + k0 * w.x, z[2 * jp + 1] * w.w + k1 * w.z); }
      __syncthreads();
      mf::dft_cols<false, true, 0>(lds, TW2, tid); mf::dft_rows<false, false>(lds, tid); mf::pointwise<true>(lds, tid);
      mf::dft_rows<true, true>(lds, tid); mf::dft_cols<true, false, 2>(lds, TW2, tid);
      const bf16_t* gr = P1T + (size_t)((o + 1) * 768 + c) * L; const int gc = (o + 1) * 768 + c;
      const float w0 = cw[gc], w1 = cw[2304 + gc], w2 = cw[4608 + gc], b = cbias[gc], sk = skip[o * 768 + c], sc = (1.f / 32768.f) / nrm;
asm volatile("" : "+v"(tid));
#pragma unroll
      for (int jp = 0; jp < 16; ++jp) { if ((jp & 15) == 0) __builtin_amdgcn_sched_barrier(0); const int n0 = jp * 1024 + 2 * tid; const float2 v = *(const float2*)(outf + n0);
        float g0, g1; conv3_pair(gr, n0, w0, w1, w2, b, g0, g1);
        z[2 * jp] = g0 * ((acc[2 * jp] + v.x) * sc + sk * z[2 * jp]); z[2 * jp + 1] = g1 * ((acc[2 * jp + 1] + v.y) * sc + sk * z[2 * jp + 1]); }
      __syncthreads();
    }
    { const bf16_t* gt = P1T + (size_t)(2304 + c) * L; bf16_t* orow = pass ? P1T + (size_t)c * L : (bf16_t*)(a.ws + 126 * MiB) + (size_t)c * L;
asm volatile("" : "+v"(tid));
#pragma unroll
      for (int jp = 0; jp < 16; ++jp) { if ((jp & 15) == 0) __builtin_amdgcn_sched_barrier(0); const int n0 = jp * 1024 + 2 * tid; const unsigned pg = *(const unsigned*)(gt + (unsigned)n0);
        *(unsigned*)(orow + (unsigned)n0) = pk2(z[2 * jp] * __uint_as_float(pg << 16), z[2 * jp + 1] * __uint_as_float(pg & 0xffff0000u)); } }
#ifdef HY_EXTRA
    __syncthreads();
    for (int xr = 0; xr < HY_EXTRA; ++xr) { mf::dft_cols<false, true, 0>(lds, TW2, tid); mf::dft_rows<false, false>(lds, tid); mf::pointwise<false>(lds, tid); mf::dft_rows<true, true>(lds, tid); mf::dft_cols<true, false, 1>(lds, TW2, tid); }
#endif
  }
}

__device__ __forceinline__ void hyena_fourier_phase(const Args& a, char* lds, int tid) {
  float2* cb = (float2*)lds; float2* twL = (float2*)(lds + 135168); float* red = (float*)(lds + 135168 + 16384);
  bf16_t* P1T = (bf16_t*)(a.ws + WS_P1T); const bf16_t* HT = (const bf16_t*)(a.ws + WS_HT);
  const float2* TW2 = (const float2*)(a.ws + WS_TW2);
  for (int i = tid; i < 2048; i += 512) twL[i] = TW2[2 * i];
  __syncthreads();
  const float* cw = a.in[15]; const float* cbias = a.in[16]; const float* skip = a.in[23];
#ifndef HY_MFMA
#define HY_MFMA 1
#endif
  for (int item = (HY_MFMA ? 768 : 0) + blockIdx.x; item < 1024; item += gridDim.x) {
    asm volatile("" : "+v"(tid));
    if (item < 768) {
      const int c = item;
      const float ad = fabsf(-3.0701134573f + (-15.350567286f + 3.0701134573f) * ((float)c * (1.f / 767.f))) * (1.f / 16383.f);
      float z[32], acc[32];
      { const bf16_t* vr = P1T + (size_t)c * L; const float w0 = cw[c], w1 = cw[2304 + c], w2 = cw[4608 + c], b = cbias[c];
asm volatile("" : "+v"(tid));
#pragma unroll
        for (int j = 0; j < 32; ++j) { if ((j & 15) == 0) __builtin_amdgcn_sched_barrier(0); z[j] = conv3_at(vr, j * 512 + tid, w0, w1, w2, b); } }
#pragma unroll 1
      for (int o = 0; o < 2; ++o) {
        const bf16_t* hf = HT + (size_t)((o * 2 + 0) * 768 + c) * L; const bf16_t* hb = HT + (size_t)((o * 2 + 1) * 768 + c) * L;
        float ssum = 0.f;
asm volatile("" : "+v"(tid));
#pragma unroll
        for (int j = 0; j < 32; ++j) { if ((j & 15) == 0) __builtin_amdgcn_sched_barrier(0); const int n = j * 512 + tid; const int nb = (L - n) & (L - 1); const float f = bf2f(hf[(unsigned)n]) * __expf(-ad * (float)n); float b = bf2f(hb[(unsigned)nb]) * __expf(-ad * (float)nb);
          ssum += fabsf(f) + fabsf(b); b = n ? b : 0.f; cb[PADI(n)] = make_float2(z[j], f + b); }
        ssum = wave_sum(ssum); if ((tid & 63) == 0) red[tid >> 6] = ssum;
        __syncthreads();
        const float nrm = EPS + ((red[0] + red[1]) + (red[2] + red[3])) + ((red[4] + red[5]) + (red[6] + red[7]));
        fft_fwd(cb, twL, tid); fft_pointwise<false>(cb, tid); fft_inv(cb, twL, tid);
asm volatile("" : "+v"(tid));
#pragma unroll
        for (int j = 0; j < 32; ++j) { if ((j & 15) == 0) __builtin_amdgcn_sched_barrier(0); acc[j] = cb[PADI(j * 512 + tid)].x; }
        __syncthreads();
asm volatile("" : "+v"(tid));
#pragma unroll
        for (int j = 0; j < 32; ++j) { if ((j & 15) == 0) __builtin_amdgcn_sched_barrier(0); const int n = j * 512 + tid; const int nb = (L - n) & (L - 1); const float f = bf2f(hf[(unsigned)n]) * __expf(-ad * (float)n); float b = bf2f(hb[(unsigned)nb]) * __expf(-ad * (float)nb); b = n ? b : 0.f; const float kk = f - b; const float2 w = TW2[n];
          cb[PADI(n)] = make_float2(z[j] * w.x - kk * w.y, z[j] * w.y + kk * w.x); }
        __syncthreads();
        fft_fwd(cb, twL, tid); fft_pointwise<true>(cb, tid); fft_inv(cb, twL, tid);
        const bf16_t* gr = P1T + (size_t)((o + 1) * 768 + c) * L; const int gc = (o + 1) * 768 + c;
        const float w0 = cw[gc], w1 = cw[2304 + gc], w2 = cw[4608 + gc], b = cbias[gc], sk = skip[o * 768 + c], sc = (1.f / 32768.f) / nrm;
asm volatile("" : "+v"(tid));
#pragma unroll
        for (int j = 0; j < 32; ++j) { if ((j & 15) == 0) __builtin_amdgcn_sched_barrier(0); const int n = j * 512 + tid; const float2 r = cb[PADI(n)], w = TW2[n];
          const float cv = (acc[j] + r.x * w.x + r.y * w.y) * sc;
          z[j] = conv3_at(gr, n, w0, w1, w2, b) * (cv + sk * z[j]); }
        __syncthreads();
      }
      { const bf16_t* gt = P1T + (size_t)(2304 + c) * L; bf16_t* orow = P1T + (size_t)c * L;
asm volatile("" : "+v"(tid));
#pragma unroll
        for (int j = 0; j < 32; ++j) { if ((j & 15) == 0) __builtin_amdgcn_sched_barrier(0); const int n = j * 512 + tid; orow[n] = (bf16_t)f2bf(z[j] * bf2f(gt[n])); } }
#ifdef HY_EXTRA
      __syncthreads();
      for (int xr = 0; xr < 2; ++xr) { fft_fwd(cb, twL, tid); fft_pointwise<false>(cb, tid); fft_inv(cb, twL, tid); fft_fwd(cb, twL, tid); fft_pointwise<true>(cb, tid); fft_inv(cb, twL, tid); }
#endif
    } else {
      const int k = item - 768;
      const bf16_t* ar = P1T + (size_t)(3072 + k) * L; const bf16_t* ai = P1T + (size_t)(3328 + k) * L; const bf16_t* gt = P1T + (size_t)(3584 + k) * L;
asm volatile("" : "+v"(tid));
#pragma unroll
      for (int j = 0; j < 32; ++j) { if ((j & 15) == 0) __builtin_amdgcn_sched_barrier(0); const int n = j * 512 + tid; cb[PADI(n)] = make_float2(bf2f(ar[n]), bf2f(ai[n])); }
      __syncthreads();
      fft_fwd(cb, twL, tid);
      bf16_t* orow = P1T + (size_t)(3072 + k) * L;
asm volatile("" : "+v"(tid));
#pragma unroll
      for (int j = 0; j < 32; ++j) { if ((j & 15) == 0) __builtin_amdgcn_sched_barrier(0); const int n = j * 512 + tid; const int p = (int)(__brev((unsigned)n) >> 18); orow[n] = (bf16_t)f2bf(cb[PADI(p)].x * bf2f(gt[n])); }
      __syncthreads();
    }
  }
#if HY_MFMA
  __syncthreads();
  hyena_mfma_items(a, lds, tid);
#endif
}

__device__ __forceinline__ void transpose_phase(const bf16_t* __restrict__ P1T, bf16_t* __restrict__ MIX, char* lds, int tid) {
  bf16_t* tl = (bf16_t*)lds;
  for (int item = blockIdx.x; item < 16 * 256; item += gridDim.x) {
    const int ct = item & 15, tt = item >> 4, c0 = ct * 64, t0 = tt * 64;
    { const int ch = tid >> 3, tq = (tid & 7) * 8; const int srow = (c0 + ch) < 768 ? (c0 + ch) : (3072 + c0 + ch - 768);
      *(u32x4*)(tl + ch * 72 + tq) = *(const u32x4*)(P1T + (size_t)srow * L + t0 + tq); }
    __syncthreads();
    { const int tok = tid >> 3, cq = (tid & 7) * 8; unsigned short v[8];
#pragma unroll
      for (int e = 0; e < 8; ++e) v[e] = tl[(cq + e) * 72 + tok];
      u32x4 w; w.x = v[0] | ((unsigned)v[1] << 16); w.y = v[2] | ((unsigned)v[3] << 16); w.z = v[4] | ((unsigned)v[5] << 16); w.w = v[6] | ((unsigned)v[7] << 16);
      *(u32x4*)(MIX + (size_t)(t0 + tok) * 1024 + c0 + cq) = w; }
    __syncthreads();
  }
}

__device__ __forceinline__ void ht_phase(const bf16_t* __restrict__ W3T, const bf16_t* __restrict__ HD2, bf16_t* __restrict__ HT, int tid) {
  typedef short bf16x8 __attribute__((ext_vector_type(8)));
  typedef float f32x16 __attribute__((ext_vector_type(16)));
  const int lane = tid & 63, wid = tid >> 6, r32 = lane & 31, hi = lane >> 5;
  for (int item = blockIdx.x; item < 96 * 8; item += gridDim.x) {
    const int rb = item >> 3, tc = item & 7;
    bf16x8 af[4];
#pragma unroll
    for (int ks = 0; ks < 4; ++ks) af[ks] = *(const bf16x8*)(W3T + (size_t)(rb * 32 + r32) * 64 + ks * 16 + hi * 8);
#pragma unroll 2
    for (int tt = 0; tt < 8; ++tt) {
      const int t0 = tc * 2048 + wid * 256 + tt * 32;
      f32x16 acc = {};
#pragma unroll
      for (int ks = 0; ks < 4; ++ks) { const bf16x8 bfr = *(const bf16x8*)(HD2 + (size_t)(t0 + r32) * 64 + ks * 16 + hi * 8);
        acc = __builtin_amdgcn_mfma_f32_32x32x16_bf16(af[ks], bfr, acc, 0, 0, 0); }
#pragma unroll
      for (int r = 0; r < 16; ++r) { const int row = rb * 32 + (r & 3) + 8 * (r >> 2) + 4 * hi; HT[(size_t)row * L + t0 + r32] = (bf16_t)f2bf(acc[r]); }
    }
  }
}
#define LAS __attribute__((address_space(3)))
#define XB_TMO      128
#define XB_XCNT(j)  (256  + 64 * (j))
#define XB_XSUB(j)  (1280 + 64 * (j))
#define XB_XGEN(j)  (2304 + 64 * (j))
#define XB_TOP      3328
#define XB_TOPGEN   3392
#define XCD_BAR_WORDS 3456
#define XB_SPIN_CAP (1u << 18)

__device__ __forceinline__ unsigned xb_ld(unsigned* p)              { return __hip_atomic_load(p, __ATOMIC_RELAXED, __HIP_MEMORY_SCOPE_AGENT); }
__device__ __forceinline__ unsigned xb_add(unsigned* p, unsigned v) { return __hip_atomic_fetch_add(p, v, __ATOMIC_RELAXED, __HIP_MEMORY_SCOPE_AGENT); }
__device__ __forceinline__ unsigned xb_xcc_id() { return (unsigned)__builtin_amdgcn_s_getreg((3 << 11) | 20) & 0xFu; }
#define XB_SPIN(cond, bar) do { unsigned _sp = 0; while (cond) { __builtin_amdgcn_s_sleep(1); \
    if ((++_sp & 255u) == 0u) { if (xb_ld(&(bar)[XB_TMO])) break; if (_sp > XB_SPIN_CAP) { atomicAdd(&(bar)[XB_TMO], 1u); break; } } } } while (0)

struct XcdBarrier {
    unsigned* bar; unsigned x;
    volatile LAS unsigned* st;
};

__device__ __forceinline__ XcdBarrier xcd_barrier_post(unsigned* bar, volatile LAS unsigned* st, bool tid0) {
    XcdBarrier b; b.bar = bar; b.x = xb_xcc_id(); b.st = st;
    if (tid0) (void)xb_add(&bar[XB_XCNT(b.x)], 1u);
    return b;
}
__device__ __forceinline__ void xcd_barrier_complete(unsigned* bar, unsigned x, unsigned& nloc, unsigned& nx) {
    const unsigned G = gridDim.x * gridDim.y * gridDim.z;
    unsigned sum, cnt, mine, sp = 0u;
    for (;;) {
        sum = 0u; cnt = 0u; mine = 0u;
#pragma unroll
        for (unsigned j = 0; j < 16; ++j) { const unsigned c = xb_ld(&bar[XB_XCNT(j)]); sum += c; cnt += (c > 0u) ? 1u : 0u; mine = (j == x) ? c : mine; }
        if (sum == G) break;
        __builtin_amdgcn_s_sleep(1);
        if ((++sp & 255u) == 0u) { if (xb_ld(&bar[XB_TMO])) break; if (sp > XB_SPIN_CAP) { atomicAdd(&bar[XB_TMO], 1u); break; } }
    }
    nloc = mine > 0u ? mine : 1u; nx = cnt > 0u ? cnt : 1u;
}

__device__ __forceinline__ void xcd_barrier(const XcdBarrier& b, bool tid0) {
    asm volatile("s_waitcnt vmcnt(0)" ::: "memory");
    __syncthreads();
    if (tid0) {
        unsigned* bar = b.bar;
        __builtin_amdgcn_s_waitcnt(0);
        unsigned nloc = b.st[0], nx = b.st[1];
        if (nloc == 0u) { xcd_barrier_complete(bar, b.x, nloc, nx); b.st[0] = nloc; b.st[1] = nx; }
        const unsigned old = xb_add(&bar[XB_XSUB(b.x)], 1u);
        const unsigned gen = old / nloc;
        if (old + 1u == (gen + 1u) * nloc) {
            __builtin_amdgcn_fence(__ATOMIC_RELEASE, "agent");
            asm volatile("s_waitcnt vmcnt(0)" ::: "memory");
            const unsigned og = xb_add(&bar[XB_TOP], 1u);
            const unsigned tg = og / nx;
            if (og + 1u == (tg + 1u) * nx) xb_add(&bar[XB_TOPGEN], 1u);
            else XB_SPIN(xb_ld(&bar[XB_TOPGEN]) == tg, bar);
            __builtin_amdgcn_fence(__ATOMIC_ACQUIRE, "agent");
            xb_add(&bar[XB_XGEN(b.x)], 1u);
            asm volatile("s_waitcnt vmcnt(0)" ::: "memory");
        } else {
            XB_SPIN(xb_ld(&bar[XB_XGEN(b.x)]) == gen, bar);
            __builtin_amdgcn_fence(__ATOMIC_ACQUIRE, "agent");
            asm volatile("s_waitcnt vmcnt(0)" ::: "memory");
        }
    }
    __syncthreads();
}
__device__ __forceinline__ int lane_id_opaque() {
  int l; asm volatile("v_mbcnt_lo_u32_b32 %0, -1, 0\n\tv_mbcnt_hi_u32_b32 %0, -1, %0" : "=v"(l)); return l;
}
__global__ void __launch_bounds__(512, 2) mega_fwd(Args a) {
  extern __shared__ __attribute__((aligned(16))) unsigned char lds_raw[];
  const int wid_s = __builtin_amdgcn_readfirstlane((int)threadIdx.x >> 6);
#define MK_TID() (wid_s * 64 + lane_id_opaque())
  int tid;
  unsigned char* ws = a.ws;
  PG8_LAS unsigned char* ldsl = (PG8_LAS unsigned char*)lds_raw;
  float* xs = (float*)(lds_raw + XS_OFF);
  const float* MOD = (const float*)(ws + WS_MOD);
  const int lo = a.ph_lo, hi = a.ph_hi, G = gridDim.x, bc = blockIdx.x;
#ifndef MK_FUSE_NORM
#define MK_FUSE_NORM 0
#endif
  const bool fuse = MK_FUSE_NORM && (G == 256) && !MK_MULTI;
#ifndef PH_MASK
#define PH_MASK 0xFFF
#endif
#define IN(k) ((((PH_MASK) >> (k)) & 1) && lo <= (k) && (k) < hi)
#ifndef DBL_MASK
#define DBL_MASK 0
#endif
#define NREP(k) ((((DBL_MASK) >> (k)) & 1) ? 2 : 1)
  volatile LAS unsigned* xst = (volatile LAS unsigned*)((LAS unsigned char*)lds_raw + 155000);
  if (MK_TID() == 0) { xst[0] = 0u; xst[1] = 0u; }
  __syncthreads();
  XcdBarrier xbar = xcd_barrier_post((unsigned*)(ws + WS_BAR), xst, MK_TID() == 0);
  if (a.ph_hi < 0) cg::this_grid().sync();
#define SEAM(k) do { if (IN(k) && IN((k) + 1)) xcd_barrier(xbar, MK_TID() == 0); } while (0)
  if (IN(0)) for (int rep = 0; rep < NREP(0); ++rep) { tid = MK_TID(); asm volatile("" : "+v"(tid)); p0_prep(a, (float*)lds_raw, tid); } SEAM(0);
  if (IN(1)) for (int rep = 0; rep < NREP(1); ++rep) { tid = MK_TID(); asm volatile("" : "+v"(tid)); rows_norm_mod(a.in[0], a.in[2], CTX, LK, a.in[6], MOD, MOD + 3072, (bf16_t*)(ws + WS_H), tid); } SEAM(1);
  if (IN(2)) for (int rep = 0; rep < NREP(2); ++rep) { tid = MK_TID(); asm volatile("" : "+v"(tid));
    pg8::Gemm g; g.A = (const bf16_t*)(ws + WS_H); g.Bt = (const bf16_t*)(ws + WS_WIN0); g.M = LK; g.N = 2560; g.K = 1024;
    pg8::SchedIn0 S; S.G = G; S.c = bc;
    pg8::EpiIn0 E; E.AV = (float*)(ws + WS_AV); E.AG = (bf16_t*)(ws + WS_AG); E.Q = (bf16_t*)(ws + WS_Q); E.K = (bf16_t*)(ws + WS_K); E.V = (bf16_t*)(ws + WS_V); E.BG = (bf16_t*)(ws + WS_BG);
    E.qg = a.in[11]; E.kg = a.in[12]; E.rope = (const float2*)(ws + WS_ROPE); E.xs = xs;
    pg8::gemm_phase<pg8::EpiIn0, pg8::SchedIn0, true, true>(ldsl, g, S, E, tid);
    tid = MK_TID(); asm volatile("" : "+v"(tid));
    prep_queue(a, (unsigned*)(ws + WS_CNT) + 388 + rep, (volatile unsigned*)(lds_raw + 154000), (float*)lds_raw, tid);
  } SEAM(2);
  if (IN(3)) for (int rep = 0; rep < NREP(3); ++rep) { tid = MK_TID(); asm volatile("" : "+v"(tid));
    if (G == 256) {
      const int vb = ((bc & 7) >> 2) * 128 + (bc >> 3) * 4 + (bc & 3);
      const int kvh = vb >> 7, pk = (vb & 127) >> 1, side = vb & 1, cidx = vb >> 1;
      { const int w = 3 * pk + side, h = kvh * 3 + (w % 3), qb = w / 3;
        __syncthreads();
        attn::attn_dense_body<false>((const attn::bf16*)(ws + WS_Q) + (size_t)qb * 256 * 768 + h * 128, (const attn::bf16*)(ws + WS_K) + (size_t)kvh * LK * 128, (const attn::bf16*)(ws + WS_V) + (size_t)kvh * LK * 128,
                              (const bf16_t*)(ws + WS_BG) + (size_t)qb * 256 * 768 + h * 128, (bf16_t*)(ws + WS_H) + (size_t)qb * 256 * 1024 + 256 + h * 128, LK, (char*)lds_raw, nullptr, nullptr, nullptr, MK_TID()); }
      { const int w = 3 * pk + 2, h = kvh * 3 + (w % 3), qb = w / 3; const size_t koff = (size_t)side * (LK / 2) * 128;
        float* pbase = (float*)(ws + WS_PARTIAL) + (size_t)cidx * 2 * PARTIAL_FLOATS;
        __syncthreads();
        attn::attn_dense_body<true>((const attn::bf16*)(ws + WS_Q) + (size_t)qb * 256 * 768 + h * 128, (const attn::bf16*)(ws + WS_K) + koff + (size_t)kvh * LK * 128, (const attn::bf16*)(ws + WS_V) + koff + (size_t)kvh * LK * 128,
                              (const bf16_t*)(ws + WS_BG) + (size_t)qb * 256 * 768 + h * 128, (bf16_t*)(ws + WS_H) + (size_t)qb * 256 * 1024 + 256 + h * 128, LK / 2, (char*)lds_raw,
                              pbase + (size_t)side * PARTIAL_FLOATS, pbase + (size_t)(side ^ 1) * PARTIAL_FLOATS, (unsigned*)(ws + WS_CNT) + cidx, MK_TID()); }
    } else {
      for (int item = bc; item < 384; item += G) {
        const int h = item % 6, qb = item / 6, kvh = h / 3;
        __syncthreads();
        attn::attn_dense_body<false>((const attn::bf16*)(ws + WS_Q) + (size_t)qb * 256 * 768 + h * 128, (const attn::bf16*)(ws + WS_K) + (size_t)kvh * LK * 128, (const attn::bf16*)(ws + WS_V) + (size_t)kvh * LK * 128,
                              (const bf16_t*)(ws + WS_BG) + (size_t)qb * 256 * 768 + h * 128, (bf16_t*)(ws + WS_H) + (size_t)qb * 256 * 1024 + 256 + h * 128, LK, (char*)lds_raw, nullptr, nullptr, nullptr, MK_TID());
      }
    }
    tid = MK_TID(); asm volatile("" : "+v"(tid));
    pool_phase((const float*)(ws + WS_AV), (const bf16_t*)(ws + WS_AG), (bf16_t*)(ws + WS_H), (unsigned*)(ws + WS_CNT) + 384 + rep, (volatile unsigned*)(lds_raw + 70000), tid);
  } SEAM(3);
  if (IN(4)) for (int rep = 0; rep < NREP(4); ++rep) { tid = MK_TID(); asm volatile("" : "+v"(tid));
    pg8::Gemm g; g.A = (const bf16_t*)(ws + WS_H); g.Bt = (const bf16_t*)(ws + WS_WOUT0); g.M = L; g.N = 1024; g.K = 1024;
    pg8::SchedRow S; S.nN = 4; S.total = 256; S.G = G; S.c = bc;
    if (fuse) { pg8::EpiResNorm<2> E; E.base = a.in[0]; E.out = a.out; E.gate = MOD + 2048; E.g = a.in[6] + 1024; E.mod = MOD + 2 * 3072; E.H = (bf16_t*)(ws + WS_H2);
      E.psq = (float*)(ws + WS_PART); E.cnt = (unsigned*)(ws + WS_CNT) + 256; E.xs = xs;
      pg8::gemm_phase<pg8::EpiResNorm<2>, pg8::SchedRow, true, true>(ldsl, g, S, E, tid); }
    else { pg8::EpiRes E; E.base = a.in[0]; E.out = a.out; E.gate = MOD + 2048;
      pg8::gemm_phase<pg8::EpiRes, pg8::SchedRow, true, true>(ldsl, g, S, E, tid); }
  } SEAM(4);
  if (IN(5)) for (int rep = 0; rep < NREP(5); ++rep) { tid = MK_TID(); asm volatile("" : "+v"(tid)); if (!fuse) rows_norm_mod(a.out, a.out, 0, L, a.in[6] + 1024, MOD + 2 * 3072, MOD + 2 * 3072, (bf16_t*)(ws + WS_H2), tid); } SEAM(5);
  if (IN(6)) for (int rep = 0; rep < NREP(6); ++rep) { tid = MK_TID(); asm volatile("" : "+v"(tid));
    pg8::Gemm g; g.A = (const bf16_t*)(ws + WS_WIN1); g.Bt = (const bf16_t*)(ws + WS_H2); g.M = 3840; g.N = L; g.K = 1024;
    pg8::SchedCol S; S.nM = 15; S.total = 15 * 64; S.G = G; S.c = bc;
    pg8::EpiT E; E.O = (bf16_t*)(ws + WS_P1T); E.gated = 1;
    pg8::gemm_phase<pg8::EpiT, pg8::SchedCol, true, true>(ldsl, g, S, E, tid);
  } SEAM(6);
  if (IN(7)) for (int rep = 0; rep < NREP(7); ++rep) { tid = MK_TID(); asm volatile("" : "+v"(tid));
    ht_phase((const bf16_t*)(ws + WS_W3T), (const bf16_t*)(ws + WS_HD2B), (bf16_t*)(ws + WS_HT), tid);
  } SEAM(7);
  if (IN(8)) for (int rep = 0; rep < NREP(8); ++rep) { tid = MK_TID(); asm volatile("" : "+v"(tid)); hyena_fourier_phase(a, (char*)lds_raw, tid); } SEAM(8);
  if (IN(9)) for (int rep = 0; rep < NREP(9); ++rep) { tid = MK_TID(); asm volatile("" : "+v"(tid)); transpose_phase((const bf16_t*)(ws + WS_P1T), (bf16_t*)(ws + WS_H), (char*)lds_raw, tid); } SEAM(9);
  if (IN(10)) for (int rep = 0; rep < NREP(10); ++rep) { tid = MK_TID(); asm volatile("" : "+v"(tid));
    pg8::Gemm g; g.A = (const bf16_t*)(ws + WS_H); g.Bt = (const bf16_t*)(ws + WS_WOUT1); g.M = L; g.N = 1024; g.K = 1024;
    pg8::SchedRow S; S.nN = 4; S.total = 256; S.G = G; S.c = bc;
    if (fuse) { pg8::EpiResNorm<1> E; E.base = a.out; E.out = a.out; E.gate = MOD + 2 * 3072 + 2048; E.g = a.in[25]; E.mod = MOD; E.H = nullptr;
      E.psq = (float*)(ws + WS_PART) + 65536; E.cnt = (unsigned*)(ws + WS_CNT) + 320; E.xs = xs;
      pg8::gemm_phase<pg8::EpiResNorm<1>, pg8::SchedRow, true, true>(ldsl, g, S, E, tid); }
    else { pg8::EpiRes E; E.base = a.out; E.out = a.out; E.gate = MOD + 2 * 3072 + 2048;
      pg8::gemm_phase<pg8::EpiRes, pg8::SchedRow, true, true>(ldsl, g, S, E, tid); }
  } SEAM(10);
  if (IN(11)) for (int rep = 0; rep < NREP(11); ++rep) { tid = MK_TID(); asm volatile("" : "+v"(tid)); if (!fuse) rows_final(a.out, a.in[25], tid); }
#undef IN
#undef SEAM
}

extern "C" void kernel_launch(void* const* d_in, const int* in_sizes, int n_in, void* d_out, int out_size, void* d_ws, size_t ws_size, hipStream_t stream) {
  static int grid = 0;
  if (grid == 0) {
    if (n_in != 26 || in_sizes[0] != L * DM || out_size != L * DM || ws_size < WS_END) {
      fprintf(stderr, "kernel_launch: unexpected shapes: n_in %d in0 %d out %d ws %zu (need >= %zu)\n", n_in, n_in > 0 ? in_sizes[0] : -1, out_size, ws_size, (size_t)WS_END); grid = -1; return; }
    int dev = 0, cus = 0, per_cu = 0;
    if (hipGetDevice(&dev) != hipSuccess || hipDeviceGetAttribute(&cus, hipDeviceAttributeMultiprocessorCount, dev) != hipSuccess) { fprintf(stderr, "kernel_launch: device query failed\n"); grid = -1; return; }
    if (hipFuncSetAttribute((const void*)mega_fwd, hipFuncAttributeMaxDynamicSharedMemorySize, LDS_BYTES) != hipSuccess) { fprintf(stderr, "kernel_launch: hipFuncSetAttribute failed\n"); grid = -1; return; }
    if (hipOccupancyMaxActiveBlocksPerMultiprocessor(&per_cu, (const void*)mega_fwd, 512, LDS_BYTES) != hipSuccess || per_cu < 1) { fprintf(stderr, "kernel_launch: occupancy query says %d\n", per_cu); per_cu = 1; }
    (void)hipGetLastError();
    grid = cus * per_cu;
    fprintf(stderr, "kernel_launch: grid %d (cus %d x %d)\n", grid, cus, per_cu);
  }
  if (grid < 0) return;
  if (hipMemsetAsync((unsigned char*)d_ws + WS_BAR, 0, 16384, stream) != hipSuccess) { fprintf(stderr, "kernel_launch: memset failed\n"); return; }
  Args a{};
  for (int i = 0; i < 26; ++i) a.in[i] = (const float*)d_in[i];
  a.out = (float*)d_out; a.ws = (unsigned char*)d_ws;
#if MK_MULTI
  for (int ph = 0; ph < NPH; ++ph) { a.ph_lo = ph; a.ph_hi = ph + 1; hipLaunchKernelGGL(mega_fwd, dim3(grid), dim3(512), LDS_BYTES, stream, a); }
#else
  a.ph_lo = 0; a.ph_hi = NPH;
  void* args[] = {&a};
  hipError_t e = hipLaunchCooperativeKernel((const void*)mega_fwd, dim3(grid), dim3(512), args, LDS_BYTES, stream);
  if (e != hipSuccess) fprintf(stderr, "kernel_launch: cooperative launch failed: %s (grid %d)\n", hipGetErrorString(e), grid);
#endif
}
```
